# Optimizing an MI355X kernel written in HIP

```python
import jax, jax.numpy as jnp
from jax import lax
import numpy as np


D_MODEL = 2048
BATCH = 8
SEQ = 2048
DEPTH = 1

D_MIX = D_MODEL
NSA_HEADS = 8
NSA_KV_GROUPS = 2
NSA_GROUP_HEADS = NSA_HEADS // NSA_KV_GROUPS
NSA_HEAD_DIM = 128
RET_HEADS = 8
RET_HEAD_DIM = 128
CMP_BLOCK = 32
CMP_STRIDE = 16
SEL_BLOCK = 64
SEL_TOPK = 8
WINDOW = 512
Q_BLOCK = 128
SEL_Q_BLOCK = 64
RET_CHUNK = 128
ROPE_BASE = 10000.0
N_GROUPS = 4
EXPERTS_PER_GROUP = 8
N_EXPERTS = N_GROUPS * EXPERTS_PER_GROUP
TOPK_IN_GROUP = 2
D_EXPERT = 512
MOE_BLOCK = 256
RMS_EPS = 1e-6
GN_EPS = 1e-5
NEG_INF = -1e30
FORCED_SCORE = 1e6
NSA_Q_WIDTH = NSA_HEADS * NSA_HEAD_DIM
NSA_KV_WIDTH = NSA_KV_GROUPS * NSA_HEAD_DIM
NSA_GATE_WIDTH = 3 * NSA_HEADS
RET_WIDTH = RET_HEADS * RET_HEAD_DIM
IN_PROJ_WIDTH = NSA_Q_WIDTH + 6 * NSA_KV_WIDTH + NSA_GATE_WIDTH + 4 * RET_WIDTH

kernel_name = 'hymba_nsa_retnet_hmoe_block'


def rms_norm(x, g, eps=RMS_EPS):
    xf = x.astype(jnp.float32)
    y = xf * lax.rsqrt(jnp.mean(xf * xf, axis=-1, keepdims=True) + eps)
    return (y * g.astype(jnp.float32)).astype(x.dtype)


def masked_softmax(s, mask):
    return jax.nn.softmax(jnp.where(mask, s, NEG_INF), axis=-1)


def nsa_attention(q, k_cmp, v_cmp, k_slc, v_slc, k_win, v_win, gate_logits,
                  cmp_pos, cmp_w1, cmp_w2, q_norm_g, k_norm_g):
    B, S = q.shape[0], q.shape[1]
    G, HG, hd = NSA_KV_GROUPS, NSA_GROUP_HEADS, NSA_HEAD_DIM
    dt = q.dtype
    scale = hd ** -0.5
    pos = jnp.arange(S)
    qg = rms_norm(q, q_norm_g).reshape(B, S, G, HG, hd).transpose(0, 2, 3, 1, 4)

    n_cmp = (S - CMP_BLOCK) // CMP_STRIDE + 1
    cmp_start = jnp.arange(n_cmp) * CMP_STRIDE
    blk_idx = cmp_start[:, None] + jnp.arange(CMP_BLOCK)[None, :]

    def compress(t, i):
        tb = t[:, blk_idx] + cmp_pos[i][None, None, :, None, :]
        hid = jax.nn.silu(jnp.einsum('bnlgd,lde->bnge', tb, cmp_w1[i]))
        return jnp.einsum('bnge,ef->bgnf', hid, cmp_w2[i])

    kc = rms_norm(compress(k_cmp, 0), k_norm_g[0])
    vc = compress(v_cmp, 1)
    s_cmp = jnp.einsum('bghsd,bgnd->bghsn', qg, kc).astype(jnp.float32) * scale
    cmask = (cmp_start + CMP_BLOCK - 1)[None, :] <= pos[:, None]
    p_cmp = masked_softmax(s_cmp, cmask) * cmask
    o_cmp = jnp.einsum('bghsn,bgnd->bghsd', p_cmp.astype(dt), vc)

    n_sblk = S // SEL_BLOCK
    n_sel = min(SEL_TOPK, n_sblk)
    sel_start = jnp.arange(n_sblk) * SEL_BLOCK
    overlap = ((cmp_start[:, None] < (sel_start + SEL_BLOCK)[None, :]) &
               ((cmp_start + CMP_BLOCK)[:, None] > sel_start[None, :])).astype(jnp.float32)
    importance = jnp.einsum('bghsn,nj->bgsj', p_cmp, overlap)
    jb = jnp.arange(n_sblk)[None, :]
    cur = (pos // SEL_BLOCK)[:, None]
    sel_valid = sel_start[None, :] <= pos[:, None]
    forced = (jb == 0) | (jb == cur) | (jb == cur - 1)
    score = jnp.where(sel_valid, jnp.where(forced, FORCED_SCORE, importance), -jnp.inf)
    _, sel_idx = lax.top_k(score, n_sel)

    k_blocks = rms_norm(k_slc, k_norm_g[1]).transpose(0, 2, 1, 3).reshape(B, G, n_sblk, SEL_BLOCK, hd)
    v_blocks = v_slc.transpose(0, 2, 1, 3).reshape(B, G, n_sblk, SEL_BLOCK, hd)
    n_sqc = S // SEL_Q_BLOCK
    q_chunks = qg.reshape(B, G, HG, n_sqc, SEL_Q_BLOCK, hd).transpose(3, 0, 1, 2, 4, 5)
    idx_chunks = sel_idx.reshape(B, G, n_sqc, SEL_Q_BLOCK, n_sel).transpose(2, 0, 1, 3, 4)
    pos_chunks = pos.reshape(n_sqc, SEL_Q_BLOCK)
    bi = jnp.arange(B)[:, None, None, None]
    gi = jnp.arange(G)[None, :, None, None]

    def sel_chunk(args):
        qc, ic, tc = args
        kg = k_blocks[bi, gi, ic].reshape(B, G, SEL_Q_BLOCK, n_sel * SEL_BLOCK, hd)
        vg = v_blocks[bi, gi, ic].reshape(B, G, SEL_Q_BLOCK, n_sel * SEL_BLOCK, hd)
        kpos = (ic[..., None] * SEL_BLOCK + jnp.arange(SEL_BLOCK)).reshape(B, G, SEL_Q_BLOCK, -1)
        m = (kpos <= tc[None, None, :, None])[:, :, None]
        s = jnp.einsum('bghqd,bgqkd->bghqk', qc, kg).astype(jnp.float32) * scale
        p = masked_softmax(s, m)
        return jnp.einsum('bghqk,bgqkd->bghqd', p.astype(dt), vg)

    o_slc = lax.map(sel_chunk, (q_chunks, idx_chunks, pos_chunks))
    o_slc = o_slc.transpose(1, 2, 3, 0, 4, 5).reshape(B, G, HG, S, hd)

    n_qc = S // Q_BLOCK
    n_wb = WINDOW // Q_BLOCK + 1
    kw = rms_norm(k_win, k_norm_g[2]).transpose(0, 2, 1, 3)
    vw = v_win.transpose(0, 2, 1, 3)
    pad = ((0, 0), (0, 0), (WINDOW, 0), (0, 0))
    kp = jnp.pad(kw, pad).reshape(B, G, (S + WINDOW) // Q_BLOCK, Q_BLOCK, hd)
    vp = jnp.pad(vw, pad).reshape(B, G, (S + WINDOW) // Q_BLOCK, Q_BLOCK, hd)
    kband = jnp.concatenate([kp[:, :, i:i + n_qc] for i in range(n_wb)], axis=3)
    vband = jnp.concatenate([vp[:, :, i:i + n_qc] for i in range(n_wb)], axis=3)
    kpos = jnp.arange(n_qc)[:, None] * Q_BLOCK - WINDOW + jnp.arange(n_wb * Q_BLOCK)[None, :]
    qpos = pos.reshape(n_qc, Q_BLOCK)
    kpb, qpb = kpos[:, None, :], qpos[:, :, None]
    wmask = (kpb <= qpb) & (kpb > qpb - WINDOW) & (kpb >= 0)
    qb = qg.reshape(B, G, HG, n_qc, Q_BLOCK, hd)
    s_win = jnp.einsum('bghcqd,bgckd->bghcqk', qb, kband).astype(jnp.float32) * scale
    p_win = masked_softmax(s_win, wmask)
    o_win = jnp.einsum('bghcqk,bgckd->bghcqd', p_win.astype(dt), vband).reshape(B, G, HG, S, hd)

    g = jax.nn.sigmoid(gate_logits).reshape(B, S, G, HG, 3).transpose(0, 2, 3, 1, 4)
    o = o_cmp * g[..., 0:1] + o_slc * g[..., 1:2] + o_win * g[..., 2:3]
    return o.transpose(0, 3, 1, 2, 4).reshape(B, S, NSA_Q_WIDTH)


def retention(q, k, v, gate, gn_g, gn_b):
    B, S, H, hd = q.shape
    dt = gate.dtype
    half = hd // 2
    inv_freq = ROPE_BASE ** (-jnp.arange(half, dtype=jnp.float32) / half)
    ang = jnp.arange(S, dtype=jnp.float32)[:, None] * inv_freq[None, :]
    cos = jnp.cos(ang)[None, :, None, :]
    sin = jnp.sin(ang)[None, :, None, :]

    def rot(t):
        t = t.astype(jnp.float32)
        t1, t2 = t[..., :half], t[..., half:]
        return jnp.concatenate([t1 * cos - t2 * sin, t1 * sin + t2 * cos], axis=-1)

    qf = rot(q)
    kf = rot(k) * (hd ** -0.5)
    vf = v.astype(jnp.float32)
    C = RET_CHUNK
    n_ch = S // C
    log_g = jnp.log1p(-jnp.exp2(-5.0 - jnp.arange(H, dtype=jnp.float32)))
    n = jnp.arange(C, dtype=jnp.float32)
    diff = n[:, None] - n[None, :]
    inner_decay = jnp.where(diff >= 0, jnp.exp(log_g[:, None, None] * jnp.maximum(diff, 0.0)), 0.0)
    xi = jnp.exp(log_g[:, None] * (n + 1.0))[None, :, :, None]
    zeta = jnp.exp(log_g[:, None] * (C - 1.0 - n))[None, :, :, None]
    chunk_decay = jnp.exp(log_g * C)[None, :, None, None]

    def to_chunks(t):
        return t.reshape(B, n_ch, C, H, hd).transpose(1, 0, 3, 2, 4)

    def step(R, qkv):
        qc, kc, vc = qkv
        a = jnp.einsum('bhnd,bhmd->bhnm', qc, kc) * inner_decay
        o = jnp.einsum('bhnm,bhme->bhne', a, vc) + jnp.einsum('bhnd,bhde->bhne', qc, R) * xi
        R = R * chunk_decay + jnp.einsum('bhmd,bhme->bhde', kc * zeta, vc)
        return R, o

    R0 = jnp.zeros((B, H, hd, hd), jnp.float32)
    _, o = lax.scan(step, R0, (to_chunks(qf), to_chunks(kf), to_chunks(vf)))
    o = o.transpose(1, 0, 3, 2, 4)
    mu = jnp.mean(o, axis=-1, keepdims=True)
    var = jnp.mean(jnp.square(o - mu), axis=-1, keepdims=True)
    y = (o - mu) * lax.rsqrt(var + GN_EPS) * gn_g.astype(jnp.float32) + gn_b.astype(jnp.float32)
    y = y.reshape(B, S, H * hd).astype(dt)
    return jax.nn.silu(gate) * y


def hier_moe(h, w_rg, b_rg, w_re, b_re, w_gate, w_up, w_down):
    B, S, D = h.shape
    T = B * S
    xt = h.reshape(T, D)
    pg = jax.nn.softmax((xt @ w_rg + b_rg).astype(jnp.float32), axis=-1)
    g_top, g_idx = lax.top_k(pg, 1)
    le = (xt @ w_re + b_re).astype(jnp.float32).reshape(T, N_GROUPS, EXPERTS_PER_GROUP)
    le_sel = jnp.take_along_axis(le, g_idx[:, :, None], axis=1)[:, 0]
    pe = jax.nn.softmax(le_sel, axis=-1)
    e_top, e_loc = lax.top_k(pe, TOPK_IN_GROUP)
    w = g_top * e_top / jnp.sum(e_top, axis=-1, keepdims=True)
    e_glob = g_idx * EXPERTS_PER_GROUP + e_loc

    n_assign = T * TOPK_IN_GROUP
    e_flat = e_glob.reshape(-1)
    tok_flat = jnp.repeat(jnp.arange(T, dtype=jnp.int32), TOPK_IN_GROUP)
    w_flat = w.reshape(-1)
    order = jnp.argsort(e_flat)
    e_sorted = e_flat[order]
    counts = jnp.bincount(e_flat, length=N_EXPERTS)
    padded = (counts + MOE_BLOCK - 1) // MOE_BLOCK * MOE_BLOCK
    pad_end = jnp.cumsum(padded)
    pad_start = pad_end - padded
    start = jnp.cumsum(counts) - counts
    dest = pad_start[e_sorted] + (jnp.arange(n_assign) - start[e_sorted])
    n_rows = (n_assign + N_EXPERTS * (MOE_BLOCK - 1) + MOE_BLOCK - 1) // MOE_BLOCK * MOE_BLOCK
    n_blocks = n_rows // MOE_BLOCK
    row_tok = jnp.zeros((n_rows,), jnp.int32).at[dest].set(tok_flat[order])
    row_w = jnp.zeros((n_rows,), w_flat.dtype).at[dest].set(w_flat[order])
    block_expert = jnp.minimum(
        jnp.searchsorted(pad_end, jnp.arange(n_blocks) * MOE_BLOCK, side='right'), N_EXPERTS - 1)

    def expert_block(args):
        tok, wt, e = args
        xb = xt[tok]
        hb = jax.nn.silu(xb @ w_gate[e]) * (xb @ w_up[e])
        return (hb @ w_down[e]) * wt[:, None].astype(xb.dtype)

    y_rows = lax.map(expert_block, (row_tok.reshape(n_blocks, MOE_BLOCK),
                                    row_w.reshape(n_blocks, MOE_BLOCK), block_expert))
    out = jnp.zeros((T, D), h.dtype).at[row_tok].add(y_rows.reshape(n_rows, D))
    return out.reshape(B, S, D)


def setup_inputs(seed: int = 0) -> dict:
    key = jax.random.key(seed)
    ks = jax.random.split(key, 20)
    f32 = jnp.float32
    L = DEPTH
    hd = NSA_HEAD_DIM

    def nrm(k, shape, scale):
        return jax.random.normal(k, shape, f32) * scale

    return {
        'x': nrm(ks[0], (BATCH, SEQ, D_MODEL), 1.0),
        'norm1_g': 1.0 + nrm(ks[1], (L, D_MODEL), 0.02),
        'w_in': nrm(ks[2], (L, D_MODEL, IN_PROJ_WIDTH), D_MODEL ** -0.5),
        'cmp_pos': nrm(ks[3], (L, 2, CMP_BLOCK, hd), 0.02),
        'cmp_w1': nrm(ks[4], (L, 2, CMP_BLOCK, hd, hd), (CMP_BLOCK * hd) ** -0.5),
        'cmp_w2': nrm(ks[5], (L, 2, hd, hd), hd ** -0.5),
        'q_norm_g': 1.0 + nrm(ks[6], (L, hd), 0.02),
        'k_norm_g': 1.0 + nrm(ks[7], (L, 3, hd), 0.02),
        'ret_gn_g': 1.0 + nrm(ks[8], (L, RET_HEADS, RET_HEAD_DIM), 0.02),
        'ret_gn_b': nrm(ks[9], (L, RET_HEADS, RET_HEAD_DIM), 0.02),
        'w_out': nrm(ks[10], (L, D_MIX, D_MODEL), D_MIX ** -0.5),
        'norm2_g': 1.0 + nrm(ks[11], (L, D_MODEL), 0.02),
        'w_router_group': nrm(ks[12], (L, D_MODEL, N_GROUPS), D_MODEL ** -0.5),
        'b_router_group': nrm(ks[13], (L, N_GROUPS), 0.01),
        'w_router_expert': nrm(ks[14], (L, D_MODEL, N_EXPERTS), D_MODEL ** -0.5),
        'b_router_expert': nrm(ks[15], (L, N_EXPERTS), 0.01),
        'w_exp_gate': nrm(ks[16], (L, N_EXPERTS, D_MODEL, D_EXPERT), D_MODEL ** -0.5),
        'w_exp_up': nrm(ks[17], (L, N_EXPERTS, D_MODEL, D_EXPERT), D_MODEL ** -0.5),
        'w_exp_down': nrm(ks[18], (L, N_EXPERTS, D_EXPERT, D_MODEL), D_EXPERT ** -0.5),
    }


def reference(x, norm1_g, w_in, cmp_pos, cmp_w1, cmp_w2, q_norm_g, k_norm_g, ret_gn_g, ret_gn_b,
              w_out, norm2_g, w_router_group, b_router_group, w_router_expert, b_router_expert,
              w_exp_gate, w_exp_up, w_exp_down):
    B, S, _ = x.shape
    sizes = [NSA_Q_WIDTH] + [NSA_KV_WIDTH] * 6 + [NSA_GATE_WIDTH] + [RET_WIDTH] * 4
    offsets = np.cumsum(sizes)[:-1].tolist()
    for l in range(DEPTH):
        h = rms_norm(x, norm1_g[l])
        proj = h @ w_in[l]
        (nq, nkc, nvc, nks, nvs, nkw, nvw, ngate, rq, rk, rv, rg) = jnp.split(proj, offsets, axis=-1)
        kv = lambda t: t.reshape(B, S, NSA_KV_GROUPS, NSA_HEAD_DIM)
        o_nsa = nsa_attention(nq.reshape(B, S, NSA_HEADS, NSA_HEAD_DIM), kv(nkc), kv(nvc), kv(nks), kv(nvs),
                              kv(nkw), kv(nvw), ngate, cmp_pos[l], cmp_w1[l], cmp_w2[l],
                              q_norm_g[l], k_norm_g[l])
        rh = lambda t: t.reshape(B, S, RET_HEADS, RET_HEAD_DIM)
        o_ret = retention(rh(rq), rh(rk), rh(rv), rg, ret_gn_g[l], ret_gn_b[l])
        x = x + jnp.concatenate([o_nsa, o_ret], axis=-1) @ w_out[l]
        h2 = rms_norm(x, norm2_g[l])
        x = x + hier_moe(h2, w_router_group[l], b_router_group[l], w_router_expert[l], b_router_expert[l],
                         w_exp_gate[l], w_exp_up[l], w_exp_down[l])
    return x
```

```cpp
#include <hip/hip_runtime.h>
#include <hip/hip_cooperative_groups.h>
#include <cstdio>
#include <cstdint>
namespace cg = cooperative_groups;

constexpr int BATCH = 8, SEQ = 2048, DM = 2048, T = BATCH * SEQ;
constexpr int NSA_H = 8, NSA_G = 2, NSA_HG = 4, HD = 128;
constexpr int RET_H = 8;
constexpr int CMP_BLOCK = 32, CMP_STRIDE = 16, NCMP = 127, SEL_BLOCK = 64, NSBLK = 32, NSEL = 8, WINDOW = 512;
constexpr int NGROUPS = 4, EPG = 8, NEXP = 32, DEXP = 512;
constexpr int IN_W = 6680;
constexpr int PW = 6656;
constexpr int NIN_PAD = 6912;
constexpr int PC_Q = 0, PC_KCMP = 1024, PC_VCMP = 1280, PC_KSLC = 1536, PC_VSLC = 1792, PC_KWIN = 2048, PC_VWIN = 2304, PC_RQ = 2560, PC_RK = 3584, PC_RV = 4608, PC_RG = 5632;
constexpr float RMS_EPS = 1e-6f, GN_EPS = 1e-5f;
constexpr float QK_SCALE = 0.08838834764831845f;
constexpr int NTHREADS = 512;
constexpr int MAXTILES = 160;

namespace pg8 {
#define PG8_LAS __attribute__((address_space(3)))
typedef unsigned short bf16_t;
typedef short bf16x8 __attribute__((ext_vector_type(8)));
typedef float f32x4 __attribute__((ext_vector_type(4)));
typedef unsigned u32x4 __attribute__((ext_vector_type(4)));
constexpr int BM = 256, BK = 64, HALF = 128, HTB = HALF * BK * 2, STAGE_BYTES = 8 * HTB, NXCD = 8, WGM = 8;

__host__ __device__ __forceinline__ int lds_byte(int r, int c) { const int st = (r >> 4) * 2 + (c >> 5), rr = r & 15, cc = c & 31, ob = rr * 64 + cc * 2; return st * 1024 + (ob ^ (((ob >> 9) & 1) << 5)); }
__host__ __device__ __forceinline__ void stage_rc(int b, int& R, int& C) { const int st = b / 1024, sb = b % 1024, swz = sb ^ (((sb >> 9) & 1) << 5); R = (st >> 1) * 16 + swz / 64; C = (st & 1) * 32 + (swz % 64) / 2; }
__host__ __device__ __forceinline__ int perm32(int rho) { const int n = rho >> 4, i = rho & 15; return 8 * (i >> 2) + 4 * n + (i & 3); }

struct Unit { int pm, pn; };
struct Gemm { const bf16_t* A; const bf16_t* Bt; int M, N, K; };

struct StaticOrder {
    int nM, nN, nwg, G, c;
    __host__ __device__ void init(int M, int N, int G_, int c_) { nM = M / BM; nN = N / BM; nwg = nM * nN; G = G_; c = c_; }
    __host__ __device__ bool next(int i, Unit& u) const {
        const long L = (long)i * G + c; if (L >= nwg) return false;
        int wgid = (int)L; { const int q = nwg / NXCD, r = nwg % NXCD, xcd = wgid % NXCD, off = wgid / NXCD; wgid = (xcd < r ? xcd * (q + 1) : r * (q + 1) + (xcd - r) * q) + off; }
        const int nig = WGM * nN, gid = wgid / nig, fm = gid * WGM, gsz = (nM - fm) < WGM ? (nM - fm) : WGM;
        u.pm = fm + ((wgid % nig) % gsz); u.pn = (wgid % nig) / gsz; return true;
    }
    __device__ __forceinline__ void a_ready(const Unit&) const {}
    __device__ __forceinline__ void done(const Unit&) const {}
};

__device__ __forceinline__ unsigned cvt_pk_bf16(float lo, float hi) { unsigned r; asm volatile("v_cvt_pk_bf16_f32 %0, %1, %2" : "=v"(r) : "v"(lo), "v"(hi)); return r; }

template <class Epi, class Sched, bool ALIGN_EPI = false, bool SP2 = false>
__device__ __forceinline__ void gemm_phase(PG8_LAS unsigned char* lds, const Gemm g, const Sched& S, const Epi& E) {
    const int tid = threadIdx.x, wid = __builtin_amdgcn_readfirstlane(tid >> 6), lane = tid & 63, wr = wid >> 2, wc = wid & 3, fr = lane & 15, fq = lane >> 4;
    const int K = g.K, nt = K / BK;
    unsigned voffA[2], voffB[2];
#pragma unroll
    for (int i = 0; i < 2; ++i) { int R, C; stage_rc(tid * 16 + i * 8192, R, C); const int Rb = Epi::PERM ? ((R & ~31) + perm32(R & 31)) : R;
        voffA[i] = (unsigned)(R * K + C) * 2u; voffB[i] = (unsigned)(Rb * K + C) * 2u; }
    const size_t kstep = (size_t)(BK * 2);
    const size_t hstep = (size_t)HALF * K * 2;
    const size_t tstep = 2 * hstep;
    const unsigned ldsw = (unsigned)wid * 1024u;
    const int aoff = lds_byte(wr * 64 + fr, fq * 8), boff = lds_byte(wc * 32 + fr, fq * 8);
#define PG8_SA(b, h) (((b) * 2 + (h)) * HTB)
#define PG8_SB(b, h) ((4 + (b) * 2 + (h)) * HTB)
#define PG8_STAGE(bufoff, gbase, voff) do { _Pragma("unroll") for (int _i = 0; _i < 2; ++_i) \
        __builtin_amdgcn_global_load_lds((const unsigned*)((const char*)(gbase) + (voff)[_i]), (PG8_LAS unsigned*)(lds + (bufoff) + ldsw + _i * 8192), 16, 0, 0); } while (0)
#define PG8_LDA(dst, b, h) do { _Pragma("unroll") for (int m = 0; m < 4; ++m) _Pragma("unroll") for (int k = 0; k < 2; ++k) dst[m][k] = *(const PG8_LAS bf16x8*)(lds + PG8_SA(b, h) + aoff + m * 2048 + k * 1024); } while (0)
#define PG8_LDB(dst, b, h) do { _Pragma("unroll") for (int n = 0; n < 2; ++n) _Pragma("unroll") for (int k = 0; k < 2; ++k) dst[n][k] = *(const PG8_LAS bf16x8*)(lds + PG8_SB(b, h) + boff + n * 2048 + k * 1024); } while (0)
#define PG8_MMA(ai, bj, At, Bt) do { __builtin_amdgcn_s_setprio(1); _Pragma("unroll") for (int m = 0; m < 4; ++m) _Pragma("unroll") for (int n = 0; n < 2; ++n) _Pragma("unroll") for (int k = 0; k < 2; ++k) \
        acc[ai][bj][m][n] = __builtin_amdgcn_mfma_f32_16x16x32_bf16(Bt[n][k], At[m][k], acc[ai][bj][m][n], 0, 0, 0); __builtin_amdgcn_s_setprio(0); } while (0)
#define PG8_WAIT_V(n) asm volatile("s_waitcnt vmcnt(" #n ")" ::: "memory")
#define PG8_WAIT_L(n) asm volatile("s_waitcnt lgkmcnt(" #n ")" ::: "memory")
#define PG8_BAR __builtin_amdgcn_s_barrier()
#define PG8_SCHED __builtin_amdgcn_sched_barrier(0)
    Unit cur, nxt; int ui = 0;
    if (!S.next(0, cur)) return;
    f32x4 acc[2][2][4][2];
#pragma unroll
    for (int a = 0; a < 2; ++a)
#pragma unroll
        for (int b = 0; b < 2; ++b)
#pragma unroll
            for (int m = 0; m < 4; ++m)
#pragma unroll
                for (int n = 0; n < 2; ++n) acc[a][b][m][n] = (f32x4){0.f, 0.f, 0.f, 0.f};
    bf16x8 At[4][2], B0[2][2], B1[2][2];
    const char* cA = (const char*)g.A + (size_t)cur.pm * tstep; const char* cB = (const char*)g.Bt + (size_t)cur.pn * tstep;
    S.a_ready(cur);
    if constexpr (SP2) {
        PG8_STAGE(PG8_SB(0, 0), cB, voffB); PG8_STAGE(PG8_SB(0, 1), cB + hstep, voffB); PG8_STAGE(PG8_SA(0, 0), cA, voffA); PG8_STAGE(PG8_SA(0, 1), cA + hstep, voffA);
        if (wr == 1) PG8_BAR;
        PG8_WAIT_V(2); PG8_BAR;
        PG8_STAGE(PG8_SB(1, 0), cB + kstep, voffB); PG8_STAGE(PG8_SA(1, 0), cA + kstep, voffA); PG8_STAGE(PG8_SB(1, 1), cB + hstep + kstep, voffB);
        PG8_WAIT_V(6); PG8_BAR;
    } else {
        PG8_STAGE(PG8_SB(0, 0), cB, voffB); PG8_STAGE(PG8_SA(0, 0), cA, voffA); PG8_STAGE(PG8_SB(0, 1), cB + hstep, voffB); PG8_STAGE(PG8_SA(0, 1), cA + hstep, voffA);
        if (wr == 1) PG8_BAR;
        PG8_WAIT_V(4); PG8_BAR;
        PG8_STAGE(PG8_SB(1, 0), cB + kstep, voffB); PG8_STAGE(PG8_SA(1, 0), cA + kstep, voffA); PG8_STAGE(PG8_SB(1, 1), cB + hstep + kstep, voffB);
        PG8_WAIT_V(6); PG8_BAR;
    }
    for (;;) {
        const bool has_next = S.next(ui + 1, nxt);
        const char* nA = has_next ? (const char*)g.A + (size_t)nxt.pm * tstep : cA; const char* nB = has_next ? (const char*)g.Bt + (size_t)nxt.pn * tstep : cB;
        for (int t = 0; t < nt; t += 2) {
            const bool last = (t == nt - 2);
            const char* a1 = cA + (size_t)(t + 1) * kstep;
            const char* a2 = last ? nA : cA + (size_t)(t + 2) * kstep; const char* b2 = last ? nB : cB + (size_t)(t + 2) * kstep;
            const char* a3 = a2 + kstep; const char* b3 = b2 + kstep;
            if (last && has_next) S.a_ready(nxt);
            if constexpr (SP2) {
            PG8_LDB(B0, 0, 0); PG8_LDB(B1, 0, 1); PG8_SCHED; PG8_LDA(At, 0, 0); PG8_STAGE(PG8_SA(1, 1), a1 + hstep, voffA);
            PG8_WAIT_V(8); PG8_WAIT_L(0); PG8_BAR; PG8_MMA(0, 0, At, B0); PG8_MMA(0, 1, At, B1); PG8_BAR; PG8_SCHED;
            PG8_LDA(At, 0, 1); PG8_STAGE(PG8_SB(0, 0), b2, voffB); PG8_STAGE(PG8_SB(0, 1), b2 + hstep, voffB); PG8_STAGE(PG8_SA(0, 0), a2, voffA);
            PG8_WAIT_V(8); PG8_WAIT_L(0); PG8_BAR; PG8_MMA(1, 0, At, B0); PG8_MMA(1, 1, At, B1); PG8_BAR; PG8_SCHED;
            PG8_LDB(B0, 1, 0); PG8_LDB(B1, 1, 1); PG8_SCHED; PG8_LDA(At, 1, 0); PG8_STAGE(PG8_SA(0, 1), a2 + hstep, voffA);
            PG8_WAIT_V(8); PG8_WAIT_L(0); PG8_BAR; PG8_MMA(0, 0, At, B0); PG8_MMA(0, 1, At, B1); PG8_BAR; PG8_SCHED;
            PG8_LDA(At, 1, 1); PG8_STAGE(PG8_SB(1, 0), b3, voffB); PG8_STAGE(PG8_SB(1, 1), b3 + hstep, voffB); PG8_STAGE(PG8_SA(1, 0), a3, voffA);
            PG8_WAIT_V(8); PG8_WAIT_L(0); PG8_BAR; PG8_MMA(1, 0, At, B0); PG8_MMA(1, 1, At, B1); PG8_BAR; PG8_SCHED;
            } else {
            PG8_LDB(B0, 0, 0); PG8_SCHED; PG8_LDA(At, 0, 0); PG8_STAGE(PG8_SA(1, 1), a1 + hstep, voffA);
            PG8_WAIT_L(8); PG8_BAR; PG8_WAIT_L(0); PG8_MMA(0, 0, At, B0); PG8_BAR; PG8_SCHED;
            PG8_LDB(B1, 0, 1); PG8_STAGE(PG8_SB(0, 0), b2, voffB);
            PG8_BAR; PG8_WAIT_L(0); PG8_MMA(0, 1, At, B1); PG8_BAR;
            PG8_LDA(At, 0, 1); PG8_STAGE(PG8_SA(0, 0), a2, voffA);
            PG8_BAR; PG8_WAIT_L(0); PG8_MMA(1, 0, At, B0); PG8_BAR; PG8_SCHED;
            PG8_STAGE(PG8_SB(0, 1), b2 + hstep, voffB);
            PG8_WAIT_V(6); PG8_BAR; PG8_MMA(1, 1, At, B1); PG8_BAR;
            PG8_LDB(B0, 1, 0); PG8_SCHED; PG8_LDA(At, 1, 0); PG8_STAGE(PG8_SA(0, 1), a2 + hstep, voffA);
            PG8_WAIT_L(8); PG8_BAR; PG8_WAIT_L(0); PG8_MMA(0, 0, At, B0); PG8_BAR; PG8_SCHED;
            PG8_LDB(B1, 1, 1); PG8_STAGE(PG8_SB(1, 0), b3, voffB);
            PG8_BAR; PG8_WAIT_L(0); PG8_MMA(0, 1, At, B1); PG8_BAR;
            PG8_LDA(At, 1, 1); PG8_STAGE(PG8_SA(1, 0), a3, voffA);
            PG8_BAR; PG8_WAIT_L(0); PG8_MMA(1, 0, At, B0); PG8_BAR; PG8_SCHED;
            PG8_STAGE(PG8_SB(1, 1), b3 + hstep, voffB);
            PG8_WAIT_V(6); PG8_BAR; PG8_MMA(1, 1, At, B1); PG8_BAR;
            }
        }
        if constexpr (ALIGN_EPI) { if (wr == 0) PG8_BAR; }
        if constexpr (!Epi::AFTER_DRAIN) { E(acc, cur, wr, wc, fr, fq); S.done(cur); }
        if (!has_next) break;
#pragma unroll
        for (int a = 0; a < 2; ++a)
#pragma unroll
            for (int b = 0; b < 2; ++b)
#pragma unroll
                for (int m = 0; m < 4; ++m)
#pragma unroll
                    for (int n = 0; n < 2; ++n) acc[a][b][m][n] = (f32x4){0.f, 0.f, 0.f, 0.f};
        cur = nxt; cA = nA; cB = nB; ++ui;
        if constexpr (ALIGN_EPI) { if (wr == 1) PG8_BAR; }
    }
    PG8_WAIT_V(0);
    if constexpr (!ALIGN_EPI) { if (wr == 0) PG8_BAR; }
    PG8_BAR;
    if constexpr (Epi::AFTER_DRAIN) { E.fused(acc, cur, wr, wc, fr, fq, lds, wid, lane); S.done(cur); }
#undef PG8_SA
#undef PG8_SB
#undef PG8_STAGE
#undef PG8_LDA
#undef PG8_LDB
#undef PG8_MMA
#undef PG8_WAIT_V
#undef PG8_WAIT_L
#undef PG8_BAR
#undef PG8_SCHED
}
}

typedef unsigned short bf16_t;
typedef short bf16x8 __attribute__((ext_vector_type(8)));
typedef float f32x4 __attribute__((ext_vector_type(4)));
typedef float f32x16 __attribute__((ext_vector_type(16)));
typedef unsigned u32x4 __attribute__((ext_vector_type(4)));
typedef unsigned u32x2 __attribute__((ext_vector_type(2)));
#define LAS __attribute__((address_space(3)))

__device__ __forceinline__ float bf2f(bf16_t v) { return __uint_as_float((unsigned)v << 16); }
__device__ __forceinline__ bf16_t f2bf(float f) { unsigned u = __float_as_uint(f); return (bf16_t)((u + 0x7fffu + ((u >> 16) & 1u)) >> 16); }
__device__ __forceinline__ unsigned pk2(float lo, float hi) { return (unsigned)f2bf(lo) | ((unsigned)f2bf(hi) << 16); }
__device__ __forceinline__ float wave_sum(float v) {
#pragma unroll
    for (int o = 32; o >= 1; o >>= 1) v += __shfl_xor(v, o);
    return v;
}
__device__ __forceinline__ float wave_max(float v) {
#pragma unroll
    for (int o = 32; o >= 1; o >>= 1) v = fmaxf(v, __shfl_xor(v, o));
    return v;
}
__device__ __forceinline__ float silu_f(float x) { return x / (1.f + __expf(-x)); }
__device__ __forceinline__ float sigmoid_f(float x) { return 1.f / (1.f + __expf(-x)); }

constexpr size_t MiB = 1u << 20;
constexpr size_t WS_ROWSCALE = 0;
constexpr size_t WS_CNT      = 64 * 1024;
constexpr size_t WS_RS2      = 128 * 1024;
constexpr size_t WS_SINCOS   = 1 * MiB;
constexpr size_t WS_GATES    = 2 * MiB;
constexpr size_t WS_KC       = 4 * MiB;
constexpr size_t WS_VC       = 5 * MiB;
constexpr size_t WS_LTOK     = 6 * MiB;
constexpr size_t WS_LW       = 8 * MiB;
constexpr size_t WS_SELMASK  = 10 * MiB;
constexpr size_t WS_WIN_T    = 12 * MiB;
constexpr size_t WS_WOUT_T   = 39 * MiB;
constexpr size_t WS_WGU_T    = 47 * MiB;
constexpr size_t WS_WD_T     = 175 * MiB;
constexpr size_t WS_XB       = 239 * MiB;
constexpr size_t WS_ATT      = 303 * MiB;
constexpr size_t WS_Y        = 239 * MiB;
constexpr size_t WS_P        = 367 * MiB;
constexpr size_t WS_XG       = 367 * MiB;
constexpr size_t WS_HB       = 527 * MiB;
constexpr size_t WS_END      = 575 * MiB;
constexpr size_t WS_H2       = WS_XB;

struct Args { const float* in[19]; float* out; unsigned char* ws; int ph_lo, ph_hi; };
enum { I_X = 0, I_N1G, I_WIN, I_CPOS, I_CW1, I_CW2, I_QNG, I_KNG, I_GNG, I_GNB, I_WOUT, I_N2G, I_WRG, I_BRG, I_WRE, I_BRE, I_WEG, I_WEU, I_WED };

constexpr int LDS_BYTES = 147456;
constexpr int LDS_TAB = 131072;

using pg8::Unit;
struct EpiInProj {
    static constexpr bool PERM = true, AFTER_DRAIN = false;
    bf16_t* P; float* gates; const float* rowscale;
    __device__ __forceinline__ void operator()(const f32x4 (&acc)[2][2][4][2], const Unit& u, int wr, int wc, int fr, int fq) const {
        const int row0 = u.pm * 256 + wr * 64 + fr;
        if (u.pn < 26) {
            const int col0 = u.pn * 256 + wc * 32 + 8 * fq;
#pragma unroll
            for (int ai = 0; ai < 2; ++ai)
#pragma unroll
                for (int m = 0; m < 4; ++m) {
                    const int row = row0 + ai * 128 + m * 16; const float rs = rowscale[row];
                    bf16_t* rowp = P + (size_t)row * PW + col0;
#pragma unroll
                    for (int bj = 0; bj < 2; ++bj) {
                        const f32x4 v0 = acc[ai][bj][m][0] * rs, v1 = acc[ai][bj][m][1] * rs;
                        u32x4 w; w.x = pg8::cvt_pk_bf16(v0[0], v0[1]); w.y = pg8::cvt_pk_bf16(v0[2], v0[3]); w.z = pg8::cvt_pk_bf16(v1[0], v1[1]); w.w = pg8::cvt_pk_bf16(v1[2], v1[3]);
                        *(u32x4*)(rowp + bj * 128) = w;
                    }
                }
        } else {
            if (wc == 0 && fq < 3) {
#pragma unroll
                for (int ai = 0; ai < 2; ++ai)
#pragma unroll
                    for (int m = 0; m < 4; ++m) {
                        const int row = row0 + ai * 128 + m * 16; const float rs = rowscale[row];
                        float* gp = gates + (size_t)row * 24 + 8 * fq;
                        *(f32x4*)gp = acc[ai][0][m][0] * rs; *(f32x4*)(gp + 4) = acc[ai][0][m][1] * rs;
                    }
            }
        }
    }
};
struct EpiOutProj {
    static constexpr bool PERM = true, AFTER_DRAIN = false;
    const float* x; float* x1;
    __device__ __forceinline__ void operator()(const f32x4 (&acc)[2][2][4][2], const Unit& u, int wr, int wc, int fr, int fq) const {
        const int row0 = u.pm * 256 + wr * 64 + fr, col0 = u.pn * 256 + wc * 32 + 8 * fq;
#pragma unroll
        for (int ai = 0; ai < 2; ++ai)
#pragma unroll
            for (int m = 0; m < 4; ++m) {
                const size_t off = (size_t)(row0 + ai * 128 + m * 16) * DM + col0;
#pragma unroll
                for (int bj = 0; bj < 2; ++bj) {
                    const f32x4 a0 = *(const f32x4*)(x + off + bj * 128), a1 = *(const f32x4*)(x + off + bj * 128 + 4);
                    *(f32x4*)(x1 + off + bj * 128) = a0 + acc[ai][bj][m][0]; *(f32x4*)(x1 + off + bj * 128 + 4) = a1 + acc[ai][bj][m][1];
                }
            }
    }
};
struct EpiGateUp {
    static constexpr bool PERM = true, AFTER_DRAIN = false;
    bf16_t* hb;
    __device__ __forceinline__ void operator()(const f32x4 (&acc)[2][2][4][2], const Unit& u, int wr, int wc, int fr, int fq) const {
        const int row0 = u.pm * 256 + wr * 64 + fr, col0 = (u.pn & 3) * 128 + wc * 32 + 8 * fq;
#pragma unroll
        for (int ai = 0; ai < 2; ++ai)
#pragma unroll
            for (int m = 0; m < 4; ++m) {
                bf16_t* rowp = hb + (size_t)(row0 + ai * 128 + m * 16) * DEXP + col0;
                const f32x4 g0 = acc[ai][0][m][0], g1 = acc[ai][0][m][1], u0 = acc[ai][1][m][0], u1 = acc[ai][1][m][1];
                float r[8];
#pragma unroll
                for (int j = 0; j < 4; ++j) { r[j] = silu_f(g0[j]) * u0[j]; r[4 + j] = silu_f(g1[j]) * u1[j]; }
                u32x4 w; w.x = pg8::cvt_pk_bf16(r[0], r[1]); w.y = pg8::cvt_pk_bf16(r[2], r[3]); w.z = pg8::cvt_pk_bf16(r[4], r[5]); w.w = pg8::cvt_pk_bf16(r[6], r[7]);
                *(u32x4*)rowp = w;
            }
    }
};
struct EpiDown {
    static constexpr bool PERM = true, AFTER_DRAIN = false;
    bf16_t* y; const int* ltok; const float* lw; const LAS int* tile_e; const LAS int* tile_i; const LAS int* cnt;
    __device__ __forceinline__ void operator()(const f32x4 (&acc)[2][2][4][2], const Unit& u, int wr, int wc, int fr, int fq) const {
        const int e = tile_e[u.pm], li0 = tile_i[u.pm] * 256, n = cnt[e];
        const int col0 = (u.pn & 7) * 256 + wc * 32 + 8 * fq;
#pragma unroll
        for (int ai = 0; ai < 2; ++ai)
#pragma unroll
            for (int m = 0; m < 4; ++m) {
                const int li = li0 + wr * 64 + fr + ai * 128 + m * 16;
                if (li < n) {
                    const int tr = ltok[e * T + li]; const float w = lw[e * T + li];
                    bf16_t* rowp = y + ((size_t)(tr & 1) * T + (tr >> 1)) * DM + col0;
#pragma unroll
                    for (int bj = 0; bj < 2; ++bj) {
                        const f32x4 v0 = acc[ai][bj][m][0] * w, v1 = acc[ai][bj][m][1] * w;
                        u32x4 q; q.x = pg8::cvt_pk_bf16(v0[0], v0[1]); q.y = pg8::cvt_pk_bf16(v0[2], v0[3]); q.z = pg8::cvt_pk_bf16(v1[0], v1[1]); q.w = pg8::cvt_pk_bf16(v1[2], v1[3]);
                        *(u32x4*)(rowp + bj * 128) = q;
                    }
                }
            }
    }
};
template <int NPN> struct MoeOrder {
    int G, c, ntiles; const LAS int* tile_e;
    __device__ __forceinline__ bool next(int i, Unit& u) const {
        const int L = i * G + c; if (L >= ntiles * NPN) return false;
        const int tile = L / NPN; u.pm = tile; u.pn = tile_e[tile] * NPN + (L % NPN); return true;
    }
    __device__ __forceinline__ void a_ready(const Unit&) const {}
    __device__ __forceinline__ void done(const Unit&) const {}
};

struct MoeTab { LAS int* cnt; LAS int* tstart; LAS int* tile_e; LAS int* tile_i; };
__device__ __forceinline__ MoeTab moe_tab(unsigned char* lds) {
    MoeTab t; LAS int* base = (LAS int*)(lds + LDS_TAB); t.cnt = base; t.tstart = base + 32; t.tile_e = base + 72; t.tile_i = base + 72 + MAXTILES; return t;
}
__device__ __forceinline__ int moe_build_tab(const MoeTab& t, const unsigned* gcnt) {
    __syncthreads();
    if (threadIdx.x == 0) {
        int acc = 0;
        for (int e = 0; e < NEXP; ++e) {
            const int n = (int)__hip_atomic_load(gcnt + e, __ATOMIC_RELAXED, __HIP_MEMORY_SCOPE_AGENT);
            t.cnt[e] = n; t.tstart[e] = acc; const int nt = (n + 255) >> 8;
            for (int i = 0; i < nt; ++i) { t.tile_e[acc + i] = e; t.tile_i[acc + i] = i; }
            acc += nt;
        }
        t.tstart[NEXP] = acc;
    }
    __syncthreads();
    return t.tstart[NEXP];
}

__device__ __forceinline__ void transpose_item(const float* __restrict__ src, int ldn, int k0, int n0, int nvalid, bf16_t* __restrict__ dst, int ldk,
                                               const float* __restrict__ gs, float* tile) {
    const int tid = threadIdx.x;
    { const int r = tid >> 4, c4 = (tid & 15) * 4;
#pragma unroll
      for (int h = 0; h < 2; ++h) { const int rr = r + 32 * h;
        f32x4 v = {0.f, 0.f, 0.f, 0.f};
        if (c4 < nvalid) v = *(const f32x4*)(src + (size_t)(k0 + rr) * ldn + n0 + c4);
        if (gs) v = v * gs[k0 + rr];
        float* tp = tile + rr * 65 + c4; tp[0] = v[0]; tp[1] = v[1]; tp[2] = v[2]; tp[3] = v[3]; } }
    __syncthreads();
    { const int n = tid >> 3, kc = (tid & 7) * 8; float v[8];
#pragma unroll
      for (int j = 0; j < 8; ++j) v[j] = tile[(kc + j) * 65 + n];
      u32x4 w; w.x = pk2(v[0], v[1]); w.y = pk2(v[2], v[3]); w.z = pk2(v[4], v[5]); w.w = pk2(v[6], v[7]);
      *(u32x4*)(dst + (size_t)n * ldk + k0 + kc) = w; }
    __syncthreads();
}

__device__ __forceinline__ void p0_prepass(const Args& a, unsigned char* lds) {
    const int tid = threadIdx.x, lane = tid & 63, wave = tid >> 6;
    unsigned char* ws = a.ws;
    { const float* x = a.in[I_X]; bf16_t* xb = (bf16_t*)(ws + WS_XB); float* rsc = (float*)(ws + WS_ROWSCALE);
      for (int row = blockIdx.x * 8 + wave; row < T; row += gridDim.x * 8) {
        const float* xr = x + (size_t)row * DM; f32x4 v[8]; float ss = 0.f;
#pragma unroll
        for (int i = 0; i < 8; ++i) { v[i] = *(const f32x4*)(xr + i * 256 + lane * 4); ss += v[i][0] * v[i][0] + v[i][1] * v[i][1] + v[i][2] * v[i][2] + v[i][3] * v[i][3]; }
        ss = wave_sum(ss);
        if (lane == 0) rsc[row] = rsqrtf(ss * (1.f / DM) + RMS_EPS);
#pragma unroll
        for (int i = 0; i < 8; ++i) { u32x2 w; w.x = pk2(v[i][0], v[i][1]); w.y = pk2(v[i][2], v[i][3]); *(u32x2*)(xb + (size_t)row * DM + i * 256 + lane * 4) = w; }
      } }
    { float* tile = (float*)lds;
      bf16_t* WinT = (bf16_t*)(ws + WS_WIN_T); bf16_t* WoT = (bf16_t*)(ws + WS_WOUT_T); bf16_t* WguT = (bf16_t*)(ws + WS_WGU_T); bf16_t* WdT = (bf16_t*)(ws + WS_WD_T);
      constexpr int N_A = (NIN_PAD / 64) * 32, N_B = 32 * 32, N_E = 768, NITEMS = N_A + N_B + NEXP * N_E;
      for (int it = blockIdx.x; it < NITEMS; it += gridDim.x) {
        if (it < N_A) { const int nb = it >> 5, kb = it & 31, nd = nb * 64; int c0, nv;
            if (nd < 2560) { c0 = nd; nv = 64; } else if (nd < PW) { c0 = nd + 24; nv = 64; } else if (nd == PW) { c0 = 2560; nv = 24; } else { c0 = 0; nv = 0; }
            transpose_item(a.in[I_WIN], IN_W, kb * 64, c0, nv, WinT + (size_t)nd * DM, DM, a.in[I_N1G], tile); }
        else if (it < N_A + N_B) { const int j = it - N_A, nb = j >> 5, kb = j & 31;
            transpose_item(a.in[I_WOUT], DM, kb * 64, nb * 64, 64, WoT + (size_t)nb * 64 * DM, DM, nullptr, tile); }
        else { const int j = it - N_A - N_B, e = j / N_E, r = j % N_E;
            if (r < 512) { const int up = r >> 8, rr = r & 255, nb = rr >> 5, kb = rr & 31, n0 = nb * 64, drow = 256 * (n0 >> 7) + (n0 & 127) + 128 * up;
                transpose_item(a.in[up ? I_WEU : I_WEG] + (size_t)e * DM * DEXP, DEXP, kb * 64, n0, 64, WguT + ((size_t)e * 1024 + drow) * DM, DM, nullptr, tile); }
            else { const int r2 = r - 512, nb = r2 >> 3, kb = r2 & 7;
                transpose_item(a.in[I_WED] + (size_t)e * DEXP * DM, DM, kb * 64, nb * 64, 64, WdT + ((size_t)e * DM + nb * 64) * DEXP, DEXP, nullptr, tile); } }
      } }
    { float* ct = (float*)(ws + WS_SINCOS); float* st = ct + SEQ * 64;
      for (int idx = blockIdx.x * NTHREADS + tid; idx < SEQ * 64; idx += gridDim.x * NTHREADS) {
        const int pos = idx >> 6, i = idx & 63;
        const float inv_freq = exp2f(-(float)i * (13.287712379549449f / 64.f));
        const float ang = (float)pos * inv_freq;
        const double rev = (double)ang * 0.15915494309189535; const float fr = (float)(rev - rint(rev));
        ct[idx] = __builtin_amdgcn_cosf(fr); st[idx] = __builtin_amdgcn_sinf(fr);
      }
      if (blockIdx.x == 0 && tid < 64) ((unsigned*)(ws + WS_CNT))[tid] = 0u; }
}

__device__ __forceinline__ void p2_finalize(const Args& a, unsigned char* lds) {
    const int tid = threadIdx.x, lane = tid & 63, wave = tid >> 6;
    unsigned char* ws = a.ws; bf16_t* P = (bf16_t*)(ws + WS_P);
    const float* ct = (const float*)(ws + WS_SINCOS); const float* st = ct + SEQ * 64;
    const float* qng = a.in[I_QNG]; const float* kng = a.in[I_KNG];
    for (int tok = blockIdx.x * 8 + wave; tok < T; tok += gridDim.x * 8) {
        bf16_t* pr = P + (size_t)tok * PW; const int pos = tok & (SEQ - 1);
#pragma unroll
        for (int h = 0; h < 8; ++h) { unsigned* p2 = (unsigned*)(pr + PC_Q + h * 128) + lane; const unsigned w = *p2;
            const float v0 = __uint_as_float(w << 16), v1 = __uint_as_float(w & 0xffff0000u);
            const float ss = wave_sum(v0 * v0 + v1 * v1), r = rsqrtf(ss * (1.f / 128.f) + RMS_EPS);
            *p2 = pk2(v0 * r * qng[2 * lane], v1 * r * qng[2 * lane + 1]); }
#pragma unroll
        for (int j = 0; j < 4; ++j) { const int col = (j < 2 ? PC_KSLC : PC_KWIN) + (j & 1) * 128; const float* gg = kng + (j < 2 ? 128 : 256);
            unsigned* p2 = (unsigned*)(pr + col) + lane; const unsigned w = *p2;
            const float v0 = __uint_as_float(w << 16), v1 = __uint_as_float(w & 0xffff0000u);
            const float ss = wave_sum(v0 * v0 + v1 * v1), r = rsqrtf(ss * (1.f / 128.f) + RMS_EPS);
            *p2 = pk2(v0 * r * gg[2 * lane], v1 * r * gg[2 * lane + 1]); }
        const float c = ct[pos * 64 + lane], s = st[pos * 64 + lane];
#pragma unroll
        for (int h = 0; h < 8; ++h) {
            { bf16_t* q1 = pr + PC_RQ + h * 128 + lane; const float t1 = bf2f(q1[0]), t2 = bf2f(q1[64]); q1[0] = f2bf(t1 * c - t2 * s); q1[64] = f2bf(t1 * s + t2 * c); }
            { bf16_t* k1 = pr + PC_RK + h * 128 + lane; const float t1 = bf2f(k1[0]), t2 = bf2f(k1[64]); k1[0] = f2bf((t1 * c - t2 * s) * QK_SCALE); k1[64] = f2bf((t1 * s + t2 * c) * QK_SCALE); }
        }
    }
    float* tb = (float*)lds; float* red = tb + 4096; float* hidl = red + 512; float* red2 = hidl + 128;
    const float* cpos = a.in[I_CPOS]; const float* w1 = a.in[I_CW1]; const float* w2 = a.in[I_CW2];
    float* KC = (float*)(ws + WS_KC); float* VC = (float*)(ws + WS_VC);
    for (int item = blockIdx.x; item < BATCH * NCMP * 4; item += gridDim.x) {
        const int which = item & 1, g = (item >> 1) & 1, rest = item >> 2, n = rest % NCMP, b = rest / NCMP;
        __syncthreads();
#pragma unroll
        for (int i = 0; i < 8; ++i) { const int idx = tid + 512 * i, l = idx >> 7, d = idx & 127; const int tok = b * SEQ + 16 * n + l;
            tb[idx] = bf2f(P[(size_t)tok * PW + (which ? PC_VCMP : PC_KCMP) + g * 128 + d]) + cpos[which * 4096 + idx]; }
        __syncthreads();
        { const int e = tid & 127, part = tid >> 7; float sacc = 0.f; const float* wp = w1 + ((size_t)which * 4096 + part * 1024) * 128 + e; const float* tp = tb + part * 1024;
          for (int k = 0; k < 1024; ++k) sacc += tp[k] * wp[(size_t)k * 128];
          red[part * 128 + e] = sacc; }
        __syncthreads();
        if (tid < 128) hidl[tid] = silu_f(red[tid] + red[128 + tid] + red[256 + tid] + red[384 + tid]);
        __syncthreads();
        float o = 0.f;
        if (tid < 128) { const float* wp = w2 + which * 16384 + tid; for (int e = 0; e < 128; ++e) o += hidl[e] * wp[e * 128];
            const float ss = wave_sum(o * o); if (lane == 0) red2[wave] = ss; }
        __syncthreads();
        if (tid < 128) { const size_t oi = ((size_t)(b * 2 + g) * 128 + n) * 128 + tid;
            if (which == 0) { const float r = rsqrtf((red2[0] + red2[1]) * (1.f / 128.f) + RMS_EPS); KC[oi] = o * r * kng[tid]; } else VC[oi] = o; }
    }
}

__device__ __forceinline__ void softmax_rows(float* sc, int ncols, int tid) {
    const int lane = tid & 63, wave = tid >> 6;
    if (wave < 4) { float* r = sc + wave * 512; float mx = -1e30f;
        for (int i = lane; i < ncols; i += 64) mx = fmaxf(mx, r[i]);
        mx = wave_max(mx); float sum = 0.f;
        for (int i = lane; i < ncols; i += 64) { const float v = r[i]; const float e = (v > -1e29f) ? __expf(v - mx) : 0.f; r[i] = e; sum += e; }
        sum = wave_sum(sum); const float inv = sum > 0.f ? 1.f / sum : 0.f;
        for (int i = lane; i < ncols; i += 64) r[i] *= inv; }
}
__device__ __forceinline__ float dot_q_kbf16(const float* q, const bf16_t* k) {
    float s = 0.f;
#pragma unroll
    for (int c = 0; c < 16; ++c) { const u32x4 w = *(const u32x4*)(k + c * 8);
        s += q[c * 8 + 0] * __uint_as_float(w.x << 16) + q[c * 8 + 1] * __uint_as_float(w.x & 0xffff0000u) + q[c * 8 + 2] * __uint_as_float(w.y << 16) + q[c * 8 + 3] * __uint_as_float(w.y & 0xffff0000u)
           + q[c * 8 + 4] * __uint_as_float(w.z << 16) + q[c * 8 + 5] * __uint_as_float(w.z & 0xffff0000u) + q[c * 8 + 6] * __uint_as_float(w.w << 16) + q[c * 8 + 7] * __uint_as_float(w.w & 0xffff0000u); }
    return s;
}
__device__ __forceinline__ void nsa_naive(const Args& a, unsigned char* lds, bf16_t* dst) {
    const int tid = threadIdx.x;
    unsigned char* ws = a.ws; const bf16_t* P = (const bf16_t*)(ws + WS_P);
    const float* KC = (const float*)(ws + WS_KC); const float* VC = (const float*)(ws + WS_VC); const float* gates = (const float*)(ws + WS_GATES);
    unsigned* selmask = (unsigned*)(ws + WS_SELMASK);
    float* qn = (float*)lds; float* sc = qn + 512; int* keypos = (int*)(sc + 2048); float* imp = (float*)(keypos + 512); unsigned* smask = (unsigned*)(imp + 32);
    for (int item = blockIdx.x; item < T * 2; item += gridDim.x) {
        const int g = item & 1, tok = item >> 1, b = tok >> 11, t = tok & (SEQ - 1);
        const int h = tid >> 7, d = tid & 127;
        __syncthreads();
        qn[tid] = bf2f(P[(size_t)tok * PW + PC_Q + (g * 4 + h) * 128 + d]) * QK_SCALE;
        __syncthreads();
        const int nvc = t >= 31 ? min(NCMP, (t - 31) / 16 + 1) : 0;
        { const int n = tid & 127; float s = -1e30f;
          if (n < nvc) { const float* kr = KC + ((size_t)(b * 2 + g) * 128 + n) * 128; const float* q = qn + h * 128; s = 0.f; for (int k = 0; k < 128; ++k) s += q[k] * kr[k]; }
          sc[h * 512 + n] = s; }
        __syncthreads();
        softmax_rows(sc, 128, tid);
        __syncthreads();
        float ocmp = 0.f;
        for (int n = 0; n < nvc; ++n) ocmp += sc[h * 512 + n] * VC[((size_t)(b * 2 + g) * 128 + n) * 128 + d];
        if (tid < 32) { float s = 0.f; const int j = tid;
            for (int n = max(0, 4 * j - 1); n <= min(NCMP - 1, 4 * j + 3); ++n) s += sc[n] + sc[512 + n] + sc[1024 + n] + sc[1536 + n];
            imp[j] = s; }
        __syncthreads();
        if (tid == 0) { const int cur = t >> 6; unsigned m = 0u;
            for (int k = 0; k < NSEL; ++k) { int best = -1; float bs = 0.f;
                for (int j = 0; j < NSBLK; ++j) { if ((m >> j) & 1u) continue;
                    const bool valid = j <= cur, forced = (j == 0) || (j == cur) || (j == cur - 1);
                    const float s = valid ? (forced ? 1e6f : imp[j]) : -INFINITY;
                    if (best < 0 || s > bs) { best = j; bs = s; } }
                m |= 1u << best; }
            *smask = m; selmask[tok * 2 + g] = m; }
        __syncthreads();
        { const unsigned m = *smask; const int k = tid >> 6, i = tid & 63; int cntb = 0, jk = 0;
          for (int j = 0; j < NSBLK; ++j) if ((m >> j) & 1u) { if (cntb == k) jk = j; ++cntb; }
          const int kp = 64 * jk + i; keypos[tid] = kp <= t ? kp : -1; }
        __syncthreads();
        for (int hh = 0; hh < 4; ++hh) { const int kp = keypos[tid];
            sc[hh * 512 + tid] = kp >= 0 ? dot_q_kbf16(qn + hh * 128, P + (size_t)(b * SEQ + kp) * PW + PC_KSLC + g * 128) : -1e30f; }
        __syncthreads();
        softmax_rows(sc, 512, tid);
        __syncthreads();
        float oslc = 0.f;
        for (int sidx = 0; sidx < 512; ++sidx) { const int kp = keypos[sidx]; if (kp >= 0) oslc += sc[h * 512 + sidx] * bf2f(P[(size_t)(b * SEQ + kp) * PW + PC_VSLC + g * 128 + d]); }
        __syncthreads();
        { const int kp = t - tid; keypos[tid] = kp >= 0 ? kp : -1; }
        __syncthreads();
        for (int hh = 0; hh < 4; ++hh) { const int kp = keypos[tid];
            sc[hh * 512 + tid] = kp >= 0 ? dot_q_kbf16(qn + hh * 128, P + (size_t)(b * SEQ + kp) * PW + PC_KWIN + g * 128) : -1e30f; }
        __syncthreads();
        softmax_rows(sc, 512, tid);
        __syncthreads();
        float owin = 0.f;
        for (int sidx = 0; sidx < 512; ++sidx) { const int kp = keypos[sidx]; if (kp >= 0) owin += sc[h * 512 + sidx] * bf2f(P[(size_t)(b * SEQ + kp) * PW + PC_VWIN + g * 128 + d]); }
        const float* gp = gates + (size_t)tok * 24 + g * 12 + h * 3;
        const float o = ocmp * sigmoid_f(gp[0]) + oslc * sigmoid_f(gp[1]) + owin * sigmoid_f(gp[2]);
        dst[(size_t)tok * DM + (g * 4 + h) * 128 + d] = f2bf(o);
    }
}

__device__ __forceinline__ void ret_naive(const Args& a, unsigned char* lds, bf16_t* dst) {
    const int tid = threadIdx.x, lane = tid & 63, wave = tid >> 6;
    unsigned char* ws = a.ws; const bf16_t* P = (const bf16_t*)(ws + WS_P);
    const float* gng = a.in[I_GNG]; const float* gnb = a.in[I_GNB];
    float* qf = (float*)lds; float* kf = qf + 32 * 128; float* sm = kf + 128 * 129; float* ob = kf;
    for (int item = blockIdx.x; item < BATCH * RET_H * (SEQ / 32); item += gridDim.x) {
        const int nt = item & 63, h = (item >> 6) & 7, b = item >> 9, n0 = nt * 32;
        const float lg = log1pf(-exp2f(-5.f - (float)h));
        __syncthreads();
        for (int i = tid; i < 32 * 128; i += NTHREADS) { const int n = i >> 7, d = i & 127; qf[i] = bf2f(P[(size_t)(b * SEQ + n0 + n) * PW + PC_RQ + h * 128 + d]); }
        float o[8];
#pragma unroll
        for (int i = 0; i < 8; ++i) o[i] = 0.f;
        const int e = tid & 127, ng = tid >> 7;
        for (int m0 = 0; m0 <= n0 + 31; m0 += 128) {
            __syncthreads();
            for (int i = tid; i < 128 * 128; i += NTHREADS) { const int mm = i >> 7, d = i & 127; kf[mm * 129 + d] = bf2f(P[(size_t)(b * SEQ + m0 + mm) * PW + PC_RK + h * 128 + d]); }
            __syncthreads();
            { const int mm = tid & 127;
#pragma unroll
              for (int i = 0; i < 8; ++i) { const int n = ng * 8 + i; const int dist = (n0 + n) - (m0 + mm); float s = 0.f;
                  if (dist >= 0) { const float* q = qf + n * 128; const float* k = kf + mm * 129; for (int dd = 0; dd < 128; ++dd) s += q[dd] * k[dd]; s *= __expf(lg * (float)dist); }
                  sm[n * 128 + mm] = s; } }
            __syncthreads();
            const int mmax = min(128, n0 + 32 - m0);
            for (int mm = 0; mm < mmax; ++mm) { const float v = bf2f(P[(size_t)(b * SEQ + m0 + mm) * PW + PC_RV + h * 128 + e]);
#pragma unroll
                for (int i = 0; i < 8; ++i) o[i] += sm[(ng * 8 + i) * 128 + mm] * v; }
        }
        __syncthreads();
#pragma unroll
        for (int i = 0; i < 8; ++i) ob[(ng * 8 + i) * 128 + e] = o[i];
        __syncthreads();
        for (int rr = 0; rr < 4; ++rr) { const int n = wave * 4 + rr; const float v0 = ob[n * 128 + lane], v1 = ob[n * 128 + 64 + lane];
            const float mu = wave_sum(v0 + v1) * (1.f / 128.f); const float d0 = v0 - mu, d1 = v1 - mu;
            const float var = wave_sum(d0 * d0 + d1 * d1) * (1.f / 128.f), r = rsqrtf(var + GN_EPS);
            const size_t tok = (size_t)(b * SEQ + n0 + n);
            const float g0 = bf2f(P[tok * PW + PC_RG + h * 128 + lane]), g1 = bf2f(P[tok * PW + PC_RG + h * 128 + 64 + lane]);
            const float y0 = d0 * r * gng[h * 128 + lane] + gnb[h * 128 + lane], y1 = d1 * r * gng[h * 128 + 64 + lane] + gnb[h * 128 + 64 + lane];
            dst[tok * DM + 1024 + h * 128 + lane] = f2bf(silu_f(g0) * y0); dst[tok * DM + 1024 + h * 128 + 64 + lane] = f2bf(silu_f(g1) * y1); }
    }
}

__device__ __forceinline__ void p7_route(const Args& a, unsigned char* lds) {
    const int tid = threadIdx.x, lane = tid & 63, wave = tid >> 6;
    unsigned char* ws = a.ws; const float* x1 = a.out; bf16_t* h2 = (bf16_t*)(ws + WS_H2);
    const float* g2 = a.in[I_N2G]; const float* wrg = a.in[I_WRG]; const float* brg = a.in[I_BRG]; const float* wre = a.in[I_WRE]; const float* bre = a.in[I_BRE];
    unsigned* cnt = (unsigned*)(ws + WS_CNT); int* ltok = (int*)(ws + WS_LTOK); float* lw = (float*)(ws + WS_LW);
    for (int tok = blockIdx.x * 8 + wave; tok < T; tok += gridDim.x * 8) {
        const float* xr = x1 + (size_t)tok * DM; float ss = 0.f;
#pragma unroll
        for (int i = 0; i < 8; ++i) { const f32x4 v = *(const f32x4*)(xr + i * 256 + lane * 4); ss += v[0] * v[0] + v[1] * v[1] + v[2] * v[2] + v[3] * v[3]; }
        ss = wave_sum(ss); const float rs = rsqrtf(ss * (1.f / DM) + RMS_EPS);
        float lg[4], le[32];
#pragma unroll
        for (int j = 0; j < 4; ++j) lg[j] = 0.f;
#pragma unroll
        for (int j = 0; j < 32; ++j) le[j] = 0.f;
#pragma unroll 1
        for (int i = 0; i < 8; ++i) { const int d0 = i * 256 + lane * 4; const f32x4 gg = *(const f32x4*)(g2 + d0); const f32x4 v = *(const f32x4*)(xr + d0) * rs * gg;
            u32x2 w; w.x = pk2(v[0], v[1]); w.y = pk2(v[2], v[3]); *(u32x2*)(h2 + (size_t)tok * DM + d0) = w;
#pragma unroll
            for (int c = 0; c < 4; ++c) { const float hv = v[c]; const f32x4 wg = *(const f32x4*)(wrg + (size_t)(d0 + c) * 4);
                lg[0] += hv * wg[0]; lg[1] += hv * wg[1]; lg[2] += hv * wg[2]; lg[3] += hv * wg[3];
#pragma unroll
                for (int j4 = 0; j4 < 8; ++j4) { const f32x4 we = *(const f32x4*)(wre + (size_t)(d0 + c) * 32 + j4 * 4);
                    le[j4 * 4 + 0] += hv * we[0]; le[j4 * 4 + 1] += hv * we[1]; le[j4 * 4 + 2] += hv * we[2]; le[j4 * 4 + 3] += hv * we[3]; } } }
#pragma unroll
        for (int j = 0; j < 4; ++j) lg[j] = wave_sum(lg[j]) + brg[j];
#pragma unroll
        for (int j = 0; j < 32; ++j) le[j] = wave_sum(le[j]);
        int gi = 0; float gm = lg[0];
#pragma unroll
        for (int j = 1; j < 4; ++j) if (lg[j] > gm) { gm = lg[j]; gi = j; }
        float gs = 0.f;
#pragma unroll
        for (int j = 0; j < 4; ++j) gs += __expf(lg[j] - gm);
        const float gtop = 1.f / gs;
        float mine = 0.f;
#pragma unroll
        for (int j = 0; j < 32; ++j) mine = (lane == j) ? le[j] : mine;
        if (lane < 32) mine += bre[lane];
        float ls[8];
#pragma unroll
        for (int j = 0; j < 8; ++j) ls[j] = __shfl(mine, gi * 8 + j);
        int e0 = 0; float m0 = ls[0];
#pragma unroll
        for (int j = 1; j < 8; ++j) if (ls[j] > m0) { m0 = ls[j]; e0 = j; }
        int e1 = -1; float m1 = -INFINITY;
#pragma unroll
        for (int j = 0; j < 8; ++j) if (j != e0 && (e1 < 0 || ls[j] > m1)) { m1 = ls[j]; e1 = j; }
        const float p1 = __expf(m1 - m0); const float w0 = gtop / (1.f + p1), w1 = gtop * p1 / (1.f + p1);
        if (lane == 0) {
            const int ea = gi * 8 + e0, eb = gi * 8 + e1;
            const unsigned pa = atomicAdd(cnt + ea, 1u); ltok[ea * T + pa] = tok * 2 + 0; lw[ea * T + pa] = w0;
            const unsigned pb = atomicAdd(cnt + eb, 1u); ltok[eb * T + pb] = tok * 2 + 1; lw[eb * T + pb] = w1;
        }
    }
}

__device__ __forceinline__ void p8_gather(const Args& a, unsigned char* lds) {
    const int tid = threadIdx.x, lane = tid & 63, wave = tid >> 6;
    unsigned char* ws = a.ws; const bf16_t* h2 = (const bf16_t*)(ws + WS_H2); bf16_t* xg = (bf16_t*)(ws + WS_XG);
    const int* ltok = (const int*)(ws + WS_LTOK);
    MoeTab tab = moe_tab(lds); const int ntiles = moe_build_tab(tab, (const unsigned*)(ws + WS_CNT));
    for (int r = blockIdx.x * 8 + wave; r < ntiles * 256; r += gridDim.x * 8) {
        const int tile = r >> 8, e = tab.tile_e[tile], li = tab.tile_i[tile] * 256 + (r & 255);
        u32x4 v0 = {0u, 0u, 0u, 0u}, v1 = v0, v2 = v0, v3 = v0;
        if (li < tab.cnt[e]) { const int tok = ltok[e * T + li] >> 1; const u32x4* s = (const u32x4*)(h2 + (size_t)tok * DM);
            v0 = s[lane]; v1 = s[64 + lane]; v2 = s[128 + lane]; v3 = s[192 + lane]; }
        u32x4* dp = (u32x4*)(xg + (size_t)r * DM); dp[lane] = v0; dp[64 + lane] = v1; dp[128 + lane] = v2; dp[192 + lane] = v3;
    }
}

__device__ __forceinline__ void p11_final(const Args& a) {
    const bf16_t* y = (const bf16_t*)(a.ws + WS_Y); float* out = a.out;
    const size_t n8 = (size_t)T * DM / 8;
    for (size_t i = (size_t)blockIdx.x * NTHREADS + threadIdx.x; i < n8; i += (size_t)gridDim.x * NTHREADS) {
        const u32x4 a0 = *(const u32x4*)(y + i * 8), a1 = *(const u32x4*)(y + (size_t)T * DM + i * 8);
        f32x4 o0 = *(f32x4*)(out + i * 8), o1 = *(f32x4*)(out + i * 8 + 4);
        o0[0] += __uint_as_float(a0.x << 16) + __uint_as_float(a1.x << 16); o0[1] += __uint_as_float(a0.x & 0xffff0000u) + __uint_as_float(a1.x & 0xffff0000u);
        o0[2] += __uint_as_float(a0.y << 16) + __uint_as_float(a1.y << 16); o0[3] += __uint_as_float(a0.y & 0xffff0000u) + __uint_as_float(a1.y & 0xffff0000u);
        o1[0] += __uint_as_float(a0.z << 16) + __uint_as_float(a1.z << 16); o1[1] += __uint_as_float(a0.z & 0xffff0000u) + __uint_as_float(a1.z & 0xffff0000u);
        o1[2] += __uint_as_float(a0.w << 16) + __uint_as_float(a1.w << 16); o1[3] += __uint_as_float(a0.w & 0xffff0000u) + __uint_as_float(a1.w & 0xffff0000u);
        *(f32x4*)(out + i * 8) = o0; *(f32x4*)(out + i * 8 + 4) = o1;
    }
}

constexpr int NPHASES = 10;
__device__ __forceinline__ void run_phase(int ph, const Args& a, unsigned char* lds) {
    unsigned char* ws = a.ws;
    PG8_LAS unsigned char* l3 = (PG8_LAS unsigned char*)lds;
    const int G = gridDim.x, c = blockIdx.x;
    if (ph == 0) { p0_prepass(a, lds); }
    else if (ph == 1) {
        pg8::Gemm g{(const bf16_t*)(ws + WS_XB), (const bf16_t*)(ws + WS_WIN_T), T, NIN_PAD, DM}; pg8::StaticOrder S; S.init(T, NIN_PAD, G, c);
        EpiInProj E{(bf16_t*)(ws + WS_P), (float*)(ws + WS_GATES), (const float*)(ws + WS_ROWSCALE)};
        pg8::gemm_phase<EpiInProj, pg8::StaticOrder, true, true>(l3, g, S, E);
    }
    else if (ph == 2) { p2_finalize(a, lds); }
    else if (ph == 3) { nsa_naive(a, lds, (bf16_t*)(ws + WS_ATT)); ret_naive(a, lds, (bf16_t*)(ws + WS_ATT)); }
    else if (ph == 4) {
        pg8::Gemm g{(const bf16_t*)(ws + WS_ATT), (const bf16_t*)(ws + WS_WOUT_T), T, DM, DM}; pg8::StaticOrder S; S.init(T, DM, G, c);
        EpiOutProj E{a.in[I_X], a.out};
        pg8::gemm_phase<EpiOutProj, pg8::StaticOrder, true, true>(l3, g, S, E);
    }
    else if (ph == 5) { p7_route(a, lds); }
    else if (ph == 6) { p8_gather(a, lds); }
    else if (ph == 7) {
        MoeTab tab = moe_tab(lds); const int ntiles = moe_build_tab(tab, (const unsigned*)(ws + WS_CNT));
        pg8::Gemm g{(const bf16_t*)(ws + WS_XG), (const bf16_t*)(ws + WS_WGU_T), ntiles * 256, NEXP * 1024, DM}; MoeOrder<4> S{G, c, ntiles, tab.tile_e};
        EpiGateUp E{(bf16_t*)(ws + WS_HB)};
        pg8::gemm_phase<EpiGateUp, MoeOrder<4>, true, true>(l3, g, S, E);
    }
    else if (ph == 8) {
        MoeTab tab = moe_tab(lds); const int ntiles = moe_build_tab(tab, (const unsigned*)(ws + WS_CNT));
        pg8::Gemm g{(const bf16_t*)(ws + WS_HB), (const bf16_t*)(ws + WS_WD_T), ntiles * 256, NEXP * DM, DEXP}; MoeOrder<8> S{G, c, ntiles, tab.tile_e};
        EpiDown E{(bf16_t*)(ws + WS_Y), (const int*)(ws + WS_LTOK), (const float*)(ws + WS_LW), tab.tile_e, tab.tile_i, tab.cnt};
        pg8::gemm_phase<EpiDown, MoeOrder<8>, true, true>(l3, g, S, E);
    }
    else if (ph == 9) { p11_final(a); }
}

template <int PH> __global__ void __launch_bounds__(NTHREADS, 2) mega_one(Args a) {
    extern __shared__ __attribute__((aligned(16))) unsigned char lds[];
    run_phase(PH, a, lds);
}
typedef void (*kern_t)(Args);
static kern_t phase_kernels[NPHASES] = { mega_one<0>, mega_one<1>, mega_one<2>, mega_one<3>, mega_one<4>, mega_one<5>, mega_one<6>, mega_one<7>, mega_one<8>, mega_one<9> };

extern "C" void kernel_launch(void* const* d_in, const int* in_sizes, int n_in, void* d_out, int out_size, void* d_ws, size_t ws_size, hipStream_t stream) {
    static int grid = 0;
    if (grid == 0) {
        if (n_in != 19 || in_sizes[0] != T * DM || out_size != T * DM || ws_size < WS_END) {
            fprintf(stderr, "kernel_launch: shape mismatch n_in %d in0 %d out %d ws %zu (need %zu)\n", n_in, n_in > 0 ? in_sizes[0] : -1, out_size, ws_size, (size_t)WS_END); grid = -1; return; }
        int dev = 0, cus = 0;
        if (hipGetDevice(&dev) != hipSuccess || hipDeviceGetAttribute(&cus, hipDeviceAttributeMultiprocessorCount, dev) != hipSuccess) { grid = -1; return; }
        for (int ph = 0; ph < NPHASES; ++ph)
            if (hipFuncSetAttribute((const void*)phase_kernels[ph], hipFuncAttributeMaxDynamicSharedMemorySize, LDS_BYTES) != hipSuccess) { fprintf(stderr, "kernel_launch: hipFuncSetAttribute failed\n"); grid = -1; return; }
        grid = cus;
    }
    if (grid < 0) return;
    Args a{};
    for (int i = 0; i < 19; ++i) a.in[i] = (const float*)d_in[i];
    a.out = (float*)d_out; a.ws = (unsigned char*)d_ws;
    for (int ph = 0; ph < NPHASES; ++ph) {
        a.ph_lo = ph; a.ph_hi = ph + 1;
        hipLaunchKernelGGL(phase_kernels[ph], dim3(grid), dim3(NTHREADS), LDS_BYTES, stream, a);
    }
}
```

```cpp
#include <hip/hip_runtime.h>
#include <hip/hip_cooperative_groups.h>
#include <cstdio>
#include <cstdint>
namespace cg = cooperative_groups;

constexpr int BATCH = 8, SEQ = 2048, DM = 2048, T = BATCH * SEQ;
constexpr int NSA_H = 8, NSA_G = 2, NSA_HG = 4, HD = 128;
constexpr int RET_H = 8;
constexpr int CMP_BLOCK = 32, CMP_STRIDE = 16, NCMP = 127, SEL_BLOCK = 64, NSBLK = 32, NSEL = 8, WINDOW = 512;
constexpr int NGROUPS = 4, EPG = 8, NEXP = 32, DEXP = 512;
constexpr int IN_W = 6680;
constexpr int PW = 6656;
constexpr int NIN_PAD = 6912;
constexpr int PC_Q = 0, PC_KCMP = 1024, PC_VCMP = 1280, PC_KSLC = 1536, PC_VSLC = 1792, PC_KWIN = 2048, PC_VWIN = 2304, PC_RQ = 2560, PC_RK = 3584, PC_RV = 4608, PC_RG = 5632;
constexpr float RMS_EPS = 1e-6f, GN_EPS = 1e-5f;
constexpr float QK_SCALE = 0.08838834764831845f;
constexpr int NTHREADS = 512;
constexpr int MAXTILES = 160;

namespace pg8 {
#define PG8_LAS __attribute__((address_space(3)))
typedef unsigned short bf16_t;
typedef short bf16x8 __attribute__((ext_vector_type(8)));
typedef float f32x4 __attribute__((ext_vector_type(4)));
typedef unsigned u32x4 __attribute__((ext_vector_type(4)));
constexpr int BM = 256, BK = 64, HALF = 128, HTB = HALF * BK * 2, STAGE_BYTES = 8 * HTB, NXCD = 8, WGM = 8;

__host__ __device__ __forceinline__ int lds_byte(int r, int c) { const int st = (r >> 4) * 2 + (c >> 5), rr = r & 15, cc = c & 31, ob = rr * 64 + cc * 2; return st * 1024 + (ob ^ (((ob >> 9) & 1) << 5)); }
__host__ __device__ __forceinline__ void stage_rc(int b, int& R, int& C) { const int st = b / 1024, sb = b % 1024, swz = sb ^ (((sb >> 9) & 1) << 5); R = (st >> 1) * 16 + swz / 64; C = (st & 1) * 32 + (swz % 64) / 2; }
__host__ __device__ __forceinline__ int perm32(int rho) { const int n = rho >> 4, i = rho & 15; return 8 * (i >> 2) + 4 * n + (i & 3); }

struct Unit { int pm, pn; };
struct Gemm { const bf16_t* A; const bf16_t* Bt; int M, N, K; };

struct StaticOrder {
    int nM, nN, nwg, G, c;
    __host__ __device__ void init(int M, int N, int G_, int c_) { nM = M / BM; nN = N / BM; nwg = nM * nN; G = G_; c = c_; }
    __host__ __device__ bool next(int i, Unit& u) const {
        const long L = (long)i * G + c; if (L >= nwg) return false;
        int wgid = (int)L; { const int q = nwg / NXCD, r = nwg % NXCD, xcd = wgid % NXCD, off = wgid / NXCD; wgid = (xcd < r ? xcd * (q + 1) : r * (q + 1) + (xcd - r) * q) + off; }
        const int nig = WGM * nN, gid = wgid / nig, fm = gid * WGM, gsz = (nM - fm) < WGM ? (nM - fm) : WGM;
        u.pm = fm + ((wgid % nig) % gsz); u.pn = (wgid % nig) / gsz; return true;
    }
    __device__ __forceinline__ void a_ready(const Unit&) const {}
    __device__ __forceinline__ void done(const Unit&) const {}
};

__device__ __forceinline__ unsigned cvt_pk_bf16(float lo, float hi) { unsigned r; asm volatile("v_cvt_pk_bf16_f32 %0, %1, %2" : "=v"(r) : "v"(lo), "v"(hi)); return r; }

template <class Epi, class Sched, bool ALIGN_EPI = false, bool SP2 = false>
__device__ __forceinline__ void gemm_phase(PG8_LAS unsigned char* lds, const Gemm g, const Sched& S, const Epi& E) {
    const int tid = threadIdx.x, wid = __builtin_amdgcn_readfirstlane(tid >> 6), lane = tid & 63, wr = wid >> 2, wc = wid & 3, fr = lane & 15, fq = lane >> 4;
    const int K = g.K, nt = K / BK;
    unsigned voffA[2], voffB[2];
#pragma unroll
    for (int i = 0; i < 2; ++i) { int R, C; stage_rc(tid * 16 + i * 8192, R, C); const int Rb = Epi::PERM ? ((R & ~31) + perm32(R & 31)) : R;
        voffA[i] = (unsigned)(R * K + C) * 2u; voffB[i] = (unsigned)(Rb * K + C) * 2u; }
    const size_t kstep = (size_t)(BK * 2);
    const size_t hstep = (size_t)HALF * K * 2;
    const size_t tstep = 2 * hstep;
    const unsigned ldsw = (unsigned)wid * 1024u;
    const int aoff = lds_byte(wr * 64 + fr, fq * 8), boff = lds_byte(wc * 32 + fr, fq * 8);
#define PG8_SA(b, h) (((b) * 2 + (h)) * HTB)
#define PG8_SB(b, h) ((4 + (b) * 2 + (h)) * HTB)
#define PG8_STAGE(bufoff, gbase, voff) do { _Pragma("unroll") for (int _i = 0; _i < 2; ++_i) \
        __builtin_amdgcn_global_load_lds((const unsigned*)((const char*)(gbase) + (voff)[_i]), (PG8_LAS unsigned*)(lds + (bufoff) + ldsw + _i * 8192), 16, 0, 0); } while (0)
#define PG8_LDA(dst, b, h) do { _Pragma("unroll") for (int m = 0; m < 4; ++m) _Pragma("unroll") for (int k = 0; k < 2; ++k) dst[m][k] = *(const PG8_LAS bf16x8*)(lds + PG8_SA(b, h) + aoff + m * 2048 + k * 1024); } while (0)
#define PG8_LDB(dst, b, h) do { _Pragma("unroll") for (int n = 0; n < 2; ++n) _Pragma("unroll") for (int k = 0; k < 2; ++k) dst[n][k] = *(const PG8_LAS bf16x8*)(lds + PG8_SB(b, h) + boff + n * 2048 + k * 1024); } while (0)
#define PG8_MMA(ai, bj, At, Bt) do { __builtin_amdgcn_s_setprio(1); _Pragma("unroll") for (int m = 0; m < 4; ++m) _Pragma("unroll") for (int n = 0; n < 2; ++n) _Pragma("unroll") for (int k = 0; k < 2; ++k) \
        acc[ai][bj][m][n] = __builtin_amdgcn_mfma_f32_16x16x32_bf16(Bt[n][k], At[m][k], acc[ai][bj][m][n], 0, 0, 0); __builtin_amdgcn_s_setprio(0); } while (0)
#define PG8_WAIT_V(n) asm volatile("s_waitcnt vmcnt(" #n ")" ::: "memory")
#define PG8_WAIT_L(n) asm volatile("s_waitcnt lgkmcnt(" #n ")" ::: "memory")
#define PG8_BAR __builtin_amdgcn_s_barrier()
#define PG8_SCHED __builtin_amdgcn_sched_barrier(0)
    Unit cur, nxt; int ui = 0;
    if (!S.next(0, cur)) return;
    f32x4 acc[2][2][4][2];
#pragma unroll
    for (int a = 0; a < 2; ++a)
#pragma unroll
        for (int b = 0; b < 2; ++b)
#pragma unroll
            for (int m = 0; m < 4; ++m)
#pragma unroll
                for (int n = 0; n < 2; ++n) acc[a][b][m][n] = (f32x4){0.f, 0.f, 0.f, 0.f};
    bf16x8 At[4][2], B0[2][2], B1[2][2];
    const char* cA = (const char*)g.A + (size_t)cur.pm * tstep; const char* cB = (const char*)g.Bt + (size_t)cur.pn * tstep;
    S.a_ready(cur);
    if constexpr (SP2) {
        PG8_STAGE(PG8_SB(0, 0), cB, voffB); PG8_STAGE(PG8_SB(0, 1), cB + hstep, voffB); PG8_STAGE(PG8_SA(0, 0), cA, voffA); PG8_STAGE(PG8_SA(0, 1), cA + hstep, voffA);
        if (wr == 1) PG8_BAR;
        PG8_WAIT_V(2); PG8_BAR;
        PG8_STAGE(PG8_SB(1, 0), cB + kstep, voffB); PG8_STAGE(PG8_SA(1, 0), cA + kstep, voffA); PG8_STAGE(PG8_SB(1, 1), cB + hstep + kstep, voffB);
        PG8_WAIT_V(6); PG8_BAR;
    } else {
        PG8_STAGE(PG8_SB(0, 0), cB, voffB); PG8_STAGE(PG8_SA(0, 0), cA, voffA); PG8_STAGE(PG8_SB(0, 1), cB + hstep, voffB); PG8_STAGE(PG8_SA(0, 1), cA + hstep, voffA);
        if (wr == 1) PG8_BAR;
        PG8_WAIT_V(4); PG8_BAR;
        PG8_STAGE(PG8_SB(1, 0), cB + kstep, voffB); PG8_STAGE(PG8_SA(1, 0), cA + kstep, voffA); PG8_STAGE(PG8_SB(1, 1), cB + hstep + kstep, voffB);
        PG8_WAIT_V(6); PG8_BAR;
    }
    for (;;) {
        const bool has_next = S.next(ui + 1, nxt);
        const char* nA = has_next ? (const char*)g.A + (size_t)nxt.pm * tstep : cA; const char* nB = has_next ? (const char*)g.Bt + (size_t)nxt.pn * tstep : cB;
        for (int t = 0; t < nt; t += 2) {
            const bool last = (t == nt - 2);
            const char* a1 = cA + (size_t)(t + 1) * kstep;
            const char* a2 = last ? nA : cA + (size_t)(t + 2) * kstep; const char* b2 = last ? nB : cB + (size_t)(t + 2) * kstep;
            const char* a3 = a2 + kstep; const char* b3 = b2 + kstep;
            if (last && has_next) S.a_ready(nxt);
            if constexpr (SP2) {
            PG8_LDB(B0, 0, 0); PG8_LDB(B1, 0, 1); PG8_SCHED; PG8_LDA(At, 0, 0); PG8_STAGE(PG8_SA(1, 1), a1 + hstep, voffA);
            PG8_WAIT_V(8); PG8_WAIT_L(0); PG8_BAR; PG8_MMA(0, 0, At, B0); PG8_MMA(0, 1, At, B1); PG8_BAR; PG8_SCHED;
            PG8_LDA(At, 0, 1); PG8_STAGE(PG8_SB(0, 0), b2, voffB); PG8_STAGE(PG8_SB(0, 1), b2 + hstep, voffB); PG8_STAGE(PG8_SA(0, 0), a2, voffA);
            PG8_WAIT_V(8); PG8_WAIT_L(0); PG8_BAR; PG8_MMA(1, 0, At, B0); PG8_MMA(1, 1, At, B1); PG8_BAR; PG8_SCHED;
            PG8_LDB(B0, 1, 0); PG8_LDB(B1, 1, 1); PG8_SCHED; PG8_LDA(At, 1, 0); PG8_STAGE(PG8_SA(0, 1), a2 + hstep, voffA);
            PG8_WAIT_V(8); PG8_WAIT_L(0); PG8_BAR; PG8_MMA(0, 0, At, B0); PG8_MMA(0, 1, At, B1); PG8_BAR; PG8_SCHED;
            PG8_LDA(At, 1, 1); PG8_STAGE(PG8_SB(1, 0), b3, voffB); PG8_STAGE(PG8_SB(1, 1), b3 + hstep, voffB); PG8_STAGE(PG8_SA(1, 0), a3, voffA);
            PG8_WAIT_V(8); PG8_WAIT_L(0); PG8_BAR; PG8_MMA(1, 0, At, B0); PG8_MMA(1, 1, At, B1); PG8_BAR; PG8_SCHED;
            } else {
            PG8_LDB(B0, 0, 0); PG8_SCHED; PG8_LDA(At, 0, 0); PG8_STAGE(PG8_SA(1, 1), a1 + hstep, voffA);
            PG8_WAIT_L(8); PG8_BAR; PG8_WAIT_L(0); PG8_MMA(0, 0, At, B0); PG8_BAR; PG8_SCHED;
            PG8_LDB(B1, 0, 1); PG8_STAGE(PG8_SB(0, 0), b2, voffB);
            PG8_BAR; PG8_WAIT_L(0); PG8_MMA(0, 1, At, B1); PG8_BAR;
            PG8_LDA(At, 0, 1); PG8_STAGE(PG8_SA(0, 0), a2, voffA);
            PG8_BAR; PG8_WAIT_L(0); PG8_MMA(1, 0, At, B0); PG8_BAR; PG8_SCHED;
            PG8_STAGE(PG8_SB(0, 1), b2 + hstep, voffB);
            PG8_WAIT_V(6); PG8_BAR; PG8_MMA(1, 1, At, B1); PG8_BAR;
            PG8_LDB(B0, 1, 0); PG8_SCHED; PG8_LDA(At, 1, 0); PG8_STAGE(PG8_SA(0, 1), a2 + hstep, voffA);
            PG8_WAIT_L(8); PG8_BAR; PG8_WAIT_L(0); PG8_MMA(0, 0, At, B0); PG8_BAR; PG8_SCHED;
            PG8_LDB(B1, 1, 1); PG8_STAGE(PG8_SB(1, 0), b3, voffB);
            PG8_BAR; PG8_WAIT_L(0); PG8_MMA(0, 1, At, B1); PG8_BAR;
            PG8_LDA(At, 1, 1); PG8_STAGE(PG8_SA(1, 0), a3, voffA);
            PG8_BAR; PG8_WAIT_L(0); PG8_MMA(1, 0, At, B0); PG8_BAR; PG8_SCHED;
            PG8_STAGE(PG8_SB(1, 1), b3 + hstep, voffB);
            PG8_WAIT_V(6); PG8_BAR; PG8_MMA(1, 1, At, B1); PG8_BAR;
            }
        }
        if constexpr (ALIGN_EPI) { if (wr == 0) PG8_BAR; }
        if constexpr (!Epi::AFTER_DRAIN) { E(acc, cur, wr, wc, fr, fq); S.done(cur); }
        if (!has_next) break;
#pragma unroll
        for (int a = 0; a < 2; ++a)
#pragma unroll
            for (int b = 0; b < 2; ++b)
#pragma unroll
                for (int m = 0; m < 4; ++m)
#pragma unroll
                    for (int n = 0; n < 2; ++n) acc[a][b][m][n] = (f32x4){0.f, 0.f, 0.f, 0.f};
        cur = nxt; cA = nA; cB = nB; ++ui;
        if constexpr (ALIGN_EPI) { if (wr == 1) PG8_BAR; }
    }
    PG8_WAIT_V(0);
    if constexpr (!ALIGN_EPI) { if (wr == 0) PG8_BAR; }
    PG8_BAR;
    if constexpr (Epi::AFTER_DRAIN) { E.fused(acc, cur, wr, wc, fr, fq, lds, wid, lane); S.done(cur); }
#undef PG8_SA
#undef PG8_SB
#undef PG8_STAGE
#undef PG8_LDA
#undef PG8_LDB
#undef PG8_MMA
#undef PG8_WAIT_V
#undef PG8_WAIT_L
#undef PG8_BAR
#undef PG8_SCHED
}
}

typedef unsigned short bf16_t;
typedef short bf16x8 __attribute__((ext_vector_type(8)));
typedef float f32x4 __attribute__((ext_vector_type(4)));
typedef float f32x16 __attribute__((ext_vector_type(16)));
typedef unsigned u32x4 __attribute__((ext_vector_type(4)));
typedef unsigned u32x2 __attribute__((ext_vector_type(2)));
#define LAS __attribute__((address_space(3)))

__device__ __forceinline__ float bf2f(bf16_t v) { return __uint_as_float((unsigned)v << 16); }
__device__ __forceinline__ bf16_t f2bf(float f) { unsigned u = __float_as_uint(f); return (bf16_t)((u + 0x7fffu + ((u >> 16) & 1u)) >> 16); }
__device__ __forceinline__ unsigned pk2(float lo, float hi) { return (unsigned)f2bf(lo) | ((unsigned)f2bf(hi) << 16); }
__device__ __forceinline__ float wave_sum(float v) {
#pragma unroll
    for (int o = 32; o >= 1; o >>= 1) v += __shfl_xor(v, o);
    return v;
}
__device__ __forceinline__ float wave_max(float v) {
#pragma unroll
    for (int o = 32; o >= 1; o >>= 1) v = fmaxf(v, __shfl_xor(v, o));
    return v;
}
__device__ __forceinline__ float silu_f(float x) { return x / (1.f + __expf(-x)); }
__device__ __forceinline__ float sigmoid_f(float x) { return 1.f / (1.f + __expf(-x)); }

constexpr size_t MiB = 1u << 20;
constexpr size_t WS_ROWSCALE = 0;
constexpr size_t WS_CNT      = 64 * 1024;
constexpr size_t WS_RS2      = 128 * 1024;
constexpr size_t WS_SINCOS   = 1 * MiB;
constexpr size_t WS_GATES    = 2 * MiB;
constexpr size_t WS_KC       = 4 * MiB;
constexpr size_t WS_VC       = 5 * MiB;
constexpr size_t WS_LTOK     = 6 * MiB;
constexpr size_t WS_LW       = 8 * MiB;
constexpr size_t WS_SELMASK  = 10 * MiB;
constexpr size_t WS_WIN_T    = 12 * MiB;
constexpr size_t WS_WOUT_T   = 39 * MiB;
constexpr size_t WS_WGU_T    = 47 * MiB;
constexpr size_t WS_WD_T     = 175 * MiB;
constexpr size_t WS_XB       = 239 * MiB;
constexpr size_t WS_ATT      = 303 * MiB;
constexpr size_t WS_Y        = 239 * MiB;
constexpr size_t WS_P        = 367 * MiB;
constexpr size_t WS_XG       = 367 * MiB;
constexpr size_t WS_HB       = 527 * MiB;
constexpr size_t WS_END      = 575 * MiB;
constexpr size_t WS_H2       = WS_XB;

struct Args { const float* in[19]; float* out; unsigned char* ws; int ph_lo, ph_hi; };
enum { I_X = 0, I_N1G, I_WIN, I_CPOS, I_CW1, I_CW2, I_QNG, I_KNG, I_GNG, I_GNB, I_WOUT, I_N2G, I_WRG, I_BRG, I_WRE, I_BRE, I_WEG, I_WEU, I_WED };

constexpr int LDS_BYTES = 147456;
constexpr int LDS_TAB = 131072;

using pg8::Unit;
struct EpiInProj {
    static constexpr bool PERM = true, AFTER_DRAIN = false;
    bf16_t* P; float* gates; const float* rowscale;
    __device__ __forceinline__ void operator()(const f32x4 (&acc)[2][2][4][2], const Unit& u, int wr, int wc, int fr, int fq) const {
        const int row0 = u.pm * 256 + wr * 64 + fr;
        if (u.pn < 26) {
            const int col0 = u.pn * 256 + wc * 32 + 8 * fq;
#pragma unroll
            for (int ai = 0; ai < 2; ++ai)
#pragma unroll
                for (int m = 0; m < 4; ++m) {
                    const int row = row0 + ai * 128 + m * 16; const float rs = rowscale[row];
                    bf16_t* rowp = P + (size_t)row * PW + col0;
#pragma unroll
                    for (int bj = 0; bj < 2; ++bj) {
                        const f32x4 v0 = acc[ai][bj][m][0] * rs, v1 = acc[ai][bj][m][1] * rs;
                        u32x4 w; w.x = pg8::cvt_pk_bf16(v0[0], v0[1]); w.y = pg8::cvt_pk_bf16(v0[2], v0[3]); w.z = pg8::cvt_pk_bf16(v1[0], v1[1]); w.w = pg8::cvt_pk_bf16(v1[2], v1[3]);
                        *(u32x4*)(rowp + bj * 128) = w;
                    }
                }
        } else {
            if (wc == 0 && fq < 3) {
#pragma unroll
                for (int ai = 0; ai < 2; ++ai)
#pragma unroll
                    for (int m = 0; m < 4; ++m) {
                        const int row = row0 + ai * 128 + m * 16; const float rs = rowscale[row];
                        float* gp = gates + (size_t)row * 24 + 8 * fq;
                        *(f32x4*)gp = acc[ai][0][m][0] * rs; *(f32x4*)(gp + 4) = acc[ai][0][m][1] * rs;
                    }
            }
        }
    }
};
struct EpiOutProj {
    static constexpr bool PERM = true, AFTER_DRAIN = false;
    const float* x; float* x1;
    __device__ __forceinline__ void operator()(const f32x4 (&acc)[2][2][4][2], const Unit& u, int wr, int wc, int fr, int fq) const {
        const int row0 = u.pm * 256 + wr * 64 + fr, col0 = u.pn * 256 + wc * 32 + 8 * fq;
#pragma unroll
        for (int ai = 0; ai < 2; ++ai)
#pragma unroll
            for (int m = 0; m < 4; ++m) {
                const size_t off = (size_t)(row0 + ai * 128 + m * 16) * DM + col0;
#pragma unroll
                for (int bj = 0; bj < 2; ++bj) {
                    const f32x4 a0 = *(const f32x4*)(x + off + bj * 128), a1 = *(const f32x4*)(x + off + bj * 128 + 4);
                    *(f32x4*)(x1 + off + bj * 128) = a0 + acc[ai][bj][m][0]; *(f32x4*)(x1 + off + bj * 128 + 4) = a1 + acc[ai][bj][m][1];
                }
            }
    }
};
struct EpiGateUp {
    static constexpr bool PERM = true, AFTER_DRAIN = false;
    bf16_t* hb;
    __device__ __forceinline__ void operator()(const f32x4 (&acc)[2][2][4][2], const Unit& u, int wr, int wc, int fr, int fq) const {
        const int row0 = u.pm * 256 + wr * 64 + fr, col0 = (u.pn & 3) * 128 + wc * 32 + 8 * fq;
#pragma unroll
        for (int ai = 0; ai < 2; ++ai)
#pragma unroll
            for (int m = 0; m < 4; ++m) {
                bf16_t* rowp = hb + (size_t)(row0 + ai * 128 + m * 16) * DEXP + col0;
                const f32x4 g0 = acc[ai][0][m][0], g1 = acc[ai][0][m][1], u0 = acc[ai][1][m][0], u1 = acc[ai][1][m][1];
                float r[8];
#pragma unroll
                for (int j = 0; j < 4; ++j) { r[j] = silu_f(g0[j]) * u0[j]; r[4 + j] = silu_f(g1[j]) * u1[j]; }
                u32x4 w; w.x = pg8::cvt_pk_bf16(r[0], r[1]); w.y = pg8::cvt_pk_bf16(r[2], r[3]); w.z = pg8::cvt_pk_bf16(r[4], r[5]); w.w = pg8::cvt_pk_bf16(r[6], r[7]);
                *(u32x4*)rowp = w;
            }
    }
};
struct EpiDown {
    static constexpr bool PERM = true, AFTER_DRAIN = false;
    bf16_t* y; const int* ltok; const float* lw; const LAS int* tile_e; const LAS int* tile_i; const LAS int* cnt;
    __device__ __forceinline__ void operator()(const f32x4 (&acc)[2][2][4][2], const Unit& u, int wr, int wc, int fr, int fq) const {
        const int e = tile_e[u.pm], li0 = tile_i[u.pm] * 256, n = cnt[e];
        const int col0 = (u.pn & 7) * 256 + wc * 32 + 8 * fq;
#pragma unroll
        for (int ai = 0; ai < 2; ++ai)
#pragma unroll
            for (int m = 0; m < 4; ++m) {
                const int li = li0 + wr * 64 + fr + ai * 128 + m * 16;
                if (li < n) {
                    const int tr = ltok[e * T + li]; const float w = lw[e * T + li];
                    bf16_t* rowp = y + ((size_t)(tr & 1) * T + (tr >> 1)) * DM + col0;
#pragma unroll
                    for (int bj = 0; bj < 2; ++bj) {
                        const f32x4 v0 = acc[ai][bj][m][0] * w, v1 = acc[ai][bj][m][1] * w;
                        u32x4 q; q.x = pg8::cvt_pk_bf16(v0[0], v0[1]); q.y = pg8::cvt_pk_bf16(v0[2], v0[3]); q.z = pg8::cvt_pk_bf16(v1[0], v1[1]); q.w = pg8::cvt_pk_bf16(v1[2], v1[3]);
                        *(u32x4*)(rowp + bj * 128) = q;
                    }
                }
            }
    }
};
template <int NPN> struct MoeOrder {
    int G, c, ntiles; const LAS int* tile_e;
    __device__ __forceinline__ bool next(int i, Unit& u) const {
        const int L = i * G + c; if (L >= ntiles * NPN) return false;
        const int tile = L / NPN; u.pm = tile; u.pn = tile_e[tile] * NPN + (L % NPN); return true;
    }
    __device__ __forceinline__ void a_ready(const Unit&) const {}
    __device__ __forceinline__ void done(const Unit&) const {}
};

struct MoeTab { LAS int* cnt; LAS int* tstart; LAS int* tile_e; LAS int* tile_i; };
__device__ __forceinline__ MoeTab moe_tab(unsigned char* lds) {
    MoeTab t; LAS int* base = (LAS int*)(lds + LDS_TAB); t.cnt = base; t.tstart = base + 32; t.tile_e = base + 72; t.tile_i = base + 72 + MAXTILES; return t;
}
__device__ __forceinline__ int moe_build_tab(const MoeTab& t, const unsigned* gcnt) {
    __syncthreads();
    if (threadIdx.x == 0) {
        int acc = 0;
        for (int e = 0; e < NEXP; ++e) {
            const int n = (int)__hip_atomic_load(gcnt + e, __ATOMIC_RELAXED, __HIP_MEMORY_SCOPE_AGENT);
            t.cnt[e] = n; t.tstart[e] = acc; const int nt = (n + 255) >> 8;
            for (int i = 0; i < nt; ++i) { t.tile_e[acc + i] = e; t.tile_i[acc + i] = i; }
            acc += nt;
        }
        t.tstart[NEXP] = acc;
    }
    __syncthreads();
    return t.tstart[NEXP];
}

__device__ __forceinline__ void transpose_item(const float* __restrict__ src, int ldn, int k0, int n0, int nvalid, bf16_t* __restrict__ dst, int ldk,
                                               const float* __restrict__ gs, float* tile) {
    const int tid = threadIdx.x;
    { const int r = tid >> 4, c4 = (tid & 15) * 4;
#pragma unroll
      for (int h = 0; h < 2; ++h) { const int rr = r + 32 * h;
        f32x4 v = {0.f, 0.f, 0.f, 0.f};
        if (c4 < nvalid) v = *(const f32x4*)(src + (size_t)(k0 + rr) * ldn + n0 + c4);
        if (gs) v = v * gs[k0 + rr];
        float* tp = tile + rr * 65 + c4; tp[0] = v[0]; tp[1] = v[1]; tp[2] = v[2]; tp[3] = v[3]; } }
    __syncthreads();
    { const int n = tid >> 3, kc = (tid & 7) * 8; float v[8];
#pragma unroll
      for (int j = 0; j < 8; ++j) v[j] = tile[(kc + j) * 65 + n];
      u32x4 w; w.x = pk2(v[0], v[1]); w.y = pk2(v[2], v[3]); w.z = pk2(v[4], v[5]); w.w = pk2(v[6], v[7]);
      *(u32x4*)(dst + (size_t)n * ldk + k0 + kc) = w; }
    __syncthreads();
}

__device__ __forceinline__ void p0_prepass(const Args& a, unsigned char* lds) {
    const int tid = threadIdx.x, lane = tid & 63, wave = tid >> 6;
    unsigned char* ws = a.ws;
    { const float* x = a.in[I_X]; bf16_t* xb = (bf16_t*)(ws + WS_XB); float* rsc = (float*)(ws + WS_ROWSCALE);
      for (int row = blockIdx.x * 8 + wave; row < T; row += gridDim.x * 8) {
        const float* xr = x + (size_t)row * DM; f32x4 v[8]; float ss = 0.f;
#pragma unroll
        for (int i = 0; i < 8; ++i) { v[i] = *(const f32x4*)(xr + i * 256 + lane * 4); ss += v[i][0] * v[i][0] + v[i][1] * v[i][1] + v[i][2] * v[i][2] + v[i][3] * v[i][3]; }
        ss = wave_sum(ss);
        if (lane == 0) rsc[row] = rsqrtf(ss * (1.f / DM) + RMS_EPS);
#pragma unroll
        for (int i = 0; i < 8; ++i) { u32x2 w; w.x = pk2(v[i][0], v[i][1]); w.y = pk2(v[i][2], v[i][3]); *(u32x2*)(xb + (size_t)row * DM + i * 256 + lane * 4) = w; }
      } }
    { float* tile = (float*)lds;
      bf16_t* WinT = (bf16_t*)(ws + WS_WIN_T); bf16_t* WoT = (bf16_t*)(ws + WS_WOUT_T); bf16_t* WguT = (bf16_t*)(ws + WS_WGU_T); bf16_t* WdT = (bf16_t*)(ws + WS_WD_T);
      constexpr int N_A = (NIN_PAD / 64) * 32, N_B = 32 * 32, N_E = 768, NITEMS = N_A + N_B + NEXP * N_E;
      for (int it = blockIdx.x; it < NITEMS; it += gridDim.x) {
        if (it < N_A) { const int nb = it >> 5, kb = it & 31, nd = nb * 64; int c0, nv;
            if (nd < 2560) { c0 = nd; nv = 64; } else if (nd < PW) { c0 = nd + 24; nv = 64; } else if (nd == PW) { c0 = 2560; nv = 24; } else { c0 = 0; nv = 0; }
            transpose_item(a.in[I_WIN], IN_W, kb * 64, c0, nv, WinT + (size_t)nd * DM, DM, a.in[I_N1G], tile); }
        else if (it < N_A + N_B) { const int j = it - N_A, nb = j >> 5, kb = j & 31;
            transpose_item(a.in[I_WOUT], DM, kb * 64, nb * 64, 64, WoT + (size_t)nb * 64 * DM, DM, nullptr, tile); }
        else { const int j = it - N_A - N_B, e = j / N_E, r = j % N_E;
            if (r < 512) { const int up = r >> 8, rr = r & 255, nb = rr >> 5, kb = rr & 31, n0 = nb * 64, drow = 256 * (n0 >> 7) + (n0 & 127) + 128 * up;
                transpose_item(a.in[up ? I_WEU : I_WEG] + (size_t)e * DM * DEXP, DEXP, kb * 64, n0, 64, WguT + ((size_t)e * 1024 + drow) * DM, DM, nullptr, tile); }
            else { const int r2 = r - 512, nb = r2 >> 3, kb = r2 & 7;
                transpose_item(a.in[I_WED] + (size_t)e * DEXP * DM, DM, kb * 64, nb * 64, 64, WdT + ((size_t)e * DM + nb * 64) * DEXP, DEXP, nullptr, tile); } }
      } }
    { float* ct = (float*)(ws + WS_SINCOS); float* st = ct + SEQ * 64;
      for (int idx = blockIdx.x * NTHREADS + tid; idx < SEQ * 64; idx += gridDim.x * NTHREADS) {
        const int pos = idx >> 6, i = idx & 63;
        const float inv_freq = exp2f(-(float)i * (13.287712379549449f / 64.f));
        const float ang = (float)pos * inv_freq;
        const double rev = (double)ang * 0.15915494309189535; const float fr = (float)(rev - rint(rev));
        ct[idx] = __builtin_amdgcn_cosf(fr); st[idx] = __builtin_amdgcn_sinf(fr);
      }
      if (blockIdx.x == 0 && tid < 64) ((unsigned*)(ws + WS_CNT))[tid] = 0u; }
}

__device__ __forceinline__ void p2_finalize(const Args& a, unsigned char* lds) {
    const int tid = threadIdx.x, lane = tid & 63, wave = tid >> 6;
    unsigned char* ws = a.ws; bf16_t* P = (bf16_t*)(ws + WS_P);
    const float* ct = (const float*)(ws + WS_SINCOS); const float* st = ct + SEQ * 64;
    const float* qng = a.in[I_QNG]; const float* kng = a.in[I_KNG];
    for (int tok = blockIdx.x * 8 + wave; tok < T; tok += gridDim.x * 8) {
        bf16_t* pr = P + (size_t)tok * PW; const int pos = tok & (SEQ - 1);
#pragma unroll
        for (int h = 0; h < 8; ++h) { unsigned* p2 = (unsigned*)(pr + PC_Q + h * 128) + lane; const unsigned w = *p2;
            const float v0 = __uint_as_float(w << 16), v1 = __uint_as_float(w & 0xffff0000u);
            const float ss = wave_sum(v0 * v0 + v1 * v1), r = rsqrtf(ss * (1.f / 128.f) + RMS_EPS);
            *p2 = pk2(v0 * r * qng[2 * lane], v1 * r * qng[2 * lane + 1]); }
#pragma unroll
        for (int j = 0; j < 4; ++j) { const int col = (j < 2 ? PC_KSLC : PC_KWIN) + (j & 1) * 128; const float* gg = kng + (j < 2 ? 128 : 256);
            unsigned* p2 = (unsigned*)(pr + col) + lane; const unsigned w = *p2;
            const float v0 = __uint_as_float(w << 16), v1 = __uint_as_float(w & 0xffff0000u);
            const float ss = wave_sum(v0 * v0 + v1 * v1), r = rsqrtf(ss * (1.f / 128.f) + RMS_EPS);
            *p2 = pk2(v0 * r * gg[2 * lane], v1 * r * gg[2 * lane + 1]); }
        const float c = ct[pos * 64 + lane], s = st[pos * 64 + lane];
#pragma unroll
        for (int h = 0; h < 8; ++h) {
            { bf16_t* q1 = pr + PC_RQ + h * 128 + lane; const float t1 = bf2f(q1[0]), t2 = bf2f(q1[64]); q1[0] = f2bf(t1 * c - t2 * s); q1[64] = f2bf(t1 * s + t2 * c); }
            { bf16_t* k1 = pr + PC_RK + h * 128 + lane; const float t1 = bf2f(k1[0]), t2 = bf2f(k1[64]); k1[0] = f2bf((t1 * c - t2 * s) * QK_SCALE); k1[64] = f2bf((t1 * s + t2 * c) * QK_SCALE); }
        }
    }
    float* tb = (float*)lds; float* red = tb + 4096; float* hidl = red + 512; float* red2 = hidl + 128;
    const float* cpos = a.in[I_CPOS]; const float* w1 = a.in[I_CW1]; const float* w2 = a.in[I_CW2];
    float* KC = (float*)(ws + WS_KC); float* VC = (float*)(ws + WS_VC);
    for (int item = blockIdx.x; item < BATCH * NCMP * 4; item += gridDim.x) {
        const int which = item & 1, g = (item >> 1) & 1, rest = item >> 2, n = rest % NCMP, b = rest / NCMP;
        __syncthreads();
#pragma unroll
        for (int i = 0; i < 8; ++i) { const int idx = tid + 512 * i, l = idx >> 7, d = idx & 127; const int tok = b * SEQ + 16 * n + l;
            tb[idx] = bf2f(P[(size_t)tok * PW + (which ? PC_VCMP : PC_KCMP) + g * 128 + d]) + cpos[which * 4096 + idx]; }
        __syncthreads();
        { const int e = tid & 127, part = tid >> 7; float sacc = 0.f; const float* wp = w1 + ((size_t)which * 4096 + part * 1024) * 128 + e; const float* tp = tb + part * 1024;
          for (int k = 0; k < 1024; ++k) sacc += tp[k] * wp[(size_t)k * 128];
          red[part * 128 + e] = sacc; }
        __syncthreads();
        if (tid < 128) hidl[tid] = silu_f(red[tid] + red[128 + tid] + red[256 + tid] + red[384 + tid]);
        __syncthreads();
        float o = 0.f;
        if (tid < 128) { const float* wp = w2 + which * 16384 + tid; for (int e = 0; e < 128; ++e) o += hidl[e] * wp[e * 128];
            const float ss = wave_sum(o * o); if (lane == 0) red2[wave] = ss; }
        __syncthreads();
        if (tid < 128) { const size_t oi = ((size_t)(b * 2 + g) * 128 + n) * 128 + tid;
            if (which == 0) { const float r = rsqrtf((red2[0] + red2[1]) * (1.f / 128.f) + RMS_EPS); KC[oi] = o * r * kng[tid]; } else VC[oi] = o; }
    }
}

__device__ __forceinline__ void softmax_rows(float* sc, int ncols, int tid) {
    const int lane = tid & 63, wave = tid >> 6;
    if (wave < 4) { float* r = sc + wave * 512; float mx = -1e30f;
        for (int i = lane; i < ncols; i += 64) mx = fmaxf(mx, r[i]);
        mx = wave_max(mx); float sum = 0.f;
        for (int i = lane; i < ncols; i += 64) { const float v = r[i]; const float e = (v > -1e29f) ? __expf(v - mx) : 0.f; r[i] = e; sum += e; }
        sum = wave_sum(sum); const float inv = sum > 0.f ? 1.f / sum : 0.f;
        for (int i = lane; i < ncols; i += 64) r[i] *= inv; }
}
__device__ __forceinline__ float dot_q_kbf16(const float* q, const bf16_t* k) {
    float s = 0.f;
#pragma unroll
    for (int c = 0; c < 16; ++c) { const u32x4 w = *(const u32x4*)(k + c * 8);
        s += q[c * 8 + 0] * __uint_as_float(w.x << 16) + q[c * 8 + 1] * __uint_as_float(w.x & 0xffff0000u) + q[c * 8 + 2] * __uint_as_float(w.y << 16) + q[c * 8 + 3] * __uint_as_float(w.y & 0xffff0000u)
           + q[c * 8 + 4] * __uint_as_float(w.z << 16) + q[c * 8 + 5] * __uint_as_float(w.z & 0xffff0000u) + q[c * 8 + 6] * __uint_as_float(w.w << 16) + q[c * 8 + 7] * __uint_as_float(w.w & 0xffff0000u); }
    return s;
}
__device__ __forceinline__ void nsa_naive(const Args& a, unsigned char* lds, bf16_t* dst) {
    const int tid = threadIdx.x;
    unsigned char* ws = a.ws; const bf16_t* P = (const bf16_t*)(ws + WS_P);
    const float* KC = (const float*)(ws + WS_KC); const float* VC = (const float*)(ws + WS_VC); const float* gates = (const float*)(ws + WS_GATES);
    unsigned* selmask = (unsigned*)(ws + WS_SELMASK);
    float* qn = (float*)lds; float* sc = qn + 512; int* keypos = (int*)(sc + 2048); float* imp = (float*)(keypos + 512); unsigned* smask = (unsigned*)(imp + 32);
    for (int item = blockIdx.x; item < T * 2; item += gridDim.x) {
        const int g = item & 1, tok = item >> 1, b = tok >> 11, t = tok & (SEQ - 1);
        const int h = tid >> 7, d = tid & 127;
        __syncthreads();
        qn[tid] = bf2f(P[(size_t)tok * PW + PC_Q + (g * 4 + h) * 128 + d]) * QK_SCALE;
        __syncthreads();
        const int nvc = t >= 31 ? min(NCMP, (t - 31) / 16 + 1) : 0;
        { const int n = tid & 127; float s = -1e30f;
          if (n < nvc) { const float* kr = KC + ((size_t)(b * 2 + g) * 128 + n) * 128; const float* q = qn + h * 128; s = 0.f; for (int k = 0; k < 128; ++k) s += q[k] * kr[k]; }
          sc[h * 512 + n] = s; }
        __syncthreads();
        softmax_rows(sc, 128, tid);
        __syncthreads();
        float ocmp = 0.f;
        for (int n = 0; n < nvc; ++n) ocmp += sc[h * 512 + n] * VC[((size_t)(b * 2 + g) * 128 + n) * 128 + d];
        if (tid < 32) { float s = 0.f; const int j = tid;
            for (int n = max(0, 4 * j - 1); n <= min(NCMP - 1, 4 * j + 3); ++n) s += sc[n] + sc[512 + n] + sc[1024 + n] + sc[1536 + n];
            imp[j] = s; }
        __syncthreads();
        if (tid == 0) { const int cur = t >> 6; unsigned m = 0u;
            for (int k = 0; k < NSEL; ++k) { int best = -1; float bs = 0.f;
                for (int j = 0; j < NSBLK; ++j) { if ((m >> j) & 1u) continue;
                    const bool valid = j <= cur, forced = (j == 0) || (j == cur) || (j == cur - 1);
                    const float s = valid ? (forced ? 1e6f : imp[j]) : -INFINITY;
                    if (best < 0 || s > bs) { best = j; bs = s; } }
                m |= 1u << best; }
            *smask = m; selmask[tok * 2 + g] = m; }
        __syncthreads();
        { const unsigned m = *smask; const int k = tid >> 6, i = tid & 63; int cntb = 0, jk = 0;
          for (int j = 0; j < NSBLK; ++j) if ((m >> j) & 1u) { if (cntb == k) jk = j; ++cntb; }
          const int kp = 64 * jk + i; keypos[tid] = kp <= t ? kp : -1; }
        __syncthreads();
        for (int hh = 0; hh < 4; ++hh) { const int kp = keypos[tid];
            sc[hh * 512 + tid] = kp >= 0 ? dot_q_kbf16(qn + hh * 128, P + (size_t)(b * SEQ + kp) * PW + PC_KSLC + g * 128) : -1e30f; }
        __syncthreads();
        softmax_rows(sc, 512, tid);
        __syncthreads();
        float oslc = 0.f;
        for (int sidx = 0; sidx < 512; ++sidx) { const int kp = keypos[sidx]; if (kp >= 0) oslc += sc[h * 512 + sidx] * bf2f(P[(size_t)(b * SEQ + kp) * PW + PC_VSLC + g * 128 + d]); }
        __syncthreads();
        { const int kp = t - tid; keypos[tid] = kp >= 0 ? kp : -1; }
        __syncthreads();
        for (int hh = 0; hh < 4; ++hh) { const int kp = keypos[tid];
            sc[hh * 512 + tid] = kp >= 0 ? dot_q_kbf16(qn + hh * 128, P + (size_t)(b * SEQ + kp) * PW + PC_KWIN + g * 128) : -1e30f; }
        __syncthreads();
        softmax_rows(sc, 512, tid);
        __syncthreads();
        float owin = 0.f;
        for (int sidx = 0; sidx < 512; ++sidx) { const int kp = keypos[sidx]; if (kp >= 0) owin += sc[h * 512 + sidx] * bf2f(P[(size_t)(b * SEQ + kp) * PW + PC_VWIN + g * 128 + d]); }
        const float* gp = gates + (size_t)tok * 24 + g * 12 + h * 3;
        const float o = ocmp * sigmoid_f(gp[0]) + oslc * sigmoid_f(gp[1]) + owin * sigmoid_f(gp[2]);
        dst[(size_t)tok * DM + (g * 4 + h) * 128 + d] = f2bf(o);
    }
}

__device__ __forceinline__ void ret_naive(const Args& a, unsigned char* lds, bf16_t* dst) {
    const int tid = threadIdx.x, lane = tid & 63, wave = tid >> 6;
    unsigned char* ws = a.ws; const bf16_t* P = (const bf16_t*)(ws + WS_P);
    const float* gng = a.in[I_GNG]; const float* gnb = a.in[I_GNB];
    float* qf = (float*)lds; float* kf = qf + 32 * 128; float* sm = kf + 128 * 129; float* ob = kf;
    for (int item = blockIdx.x; item < BATCH * RET_H * (SEQ / 32); item += gridDim.x) {
        const int nt = item & 63, h = (item >> 6) & 7, b = item >> 9, n0 = nt * 32;
        const float lg = log1pf(-exp2f(-5.f - (float)h));
        __syncthreads();
        for (int i = tid; i < 32 * 128; i += NTHREADS) { const int n = i >> 7, d = i & 127; qf[i] = bf2f(P[(size_t)(b * SEQ + n0 + n) * PW + PC_RQ + h * 128 + d]); }
        float o[8];
#pragma unroll
        for (int i = 0; i < 8; ++i) o[i] = 0.f;
        const int e = tid & 127, ng = tid >> 7;
        for (int m0 = 0; m0 <= n0 + 31; m0 += 128) {
            __syncthreads();
            for (int i = tid; i < 128 * 128; i += NTHREADS) { const int mm = i >> 7, d = i & 127; kf[mm * 129 + d] = bf2f(P[(size_t)(b * SEQ + m0 + mm) * PW + PC_RK + h * 128 + d]); }
            __syncthreads();
            { const int mm = tid & 127;
#pragma unroll
              for (int i = 0; i < 8; ++i) { const int n = ng * 8 + i; const int dist = (n0 + n) - (m0 + mm); float s = 0.f;
                  if (dist >= 0) { const float* q = qf + n * 128; const float* k = kf + mm * 129; for (int dd = 0; dd < 128; ++dd) s += q[dd] * k[dd]; s *= __expf(lg * (float)dist); }
                  sm[n * 128 + mm] = s; } }
            __syncthreads();
            const int mmax = min(128, n0 + 32 - m0);
            for (int mm = 0; mm < mmax; ++mm) { const float v = bf2f(P[(size_t)(b * SEQ + m0 + mm) * PW + PC_RV + h * 128 + e]);
#pragma unroll
                for (int i = 0; i < 8; ++i) o[i] += sm[(ng * 8 + i) * 128 + mm] * v; }
        }
        __syncthreads();
#pragma unroll
        for (int i = 0; i < 8; ++i) ob[(ng * 8 + i) * 128 + e] = o[i];
        __syncthreads();
        for (int rr = 0; rr < 4; ++rr) { const int n = wave * 4 + rr; const float v0 = ob[n * 128 + lane], v1 = ob[n * 128 + 64 + lane];
            const float mu = wave_sum(v0 + v1) * (1.f / 128.f); const float d0 = v0 - mu, d1 = v1 - mu;
            const float var = wave_sum(d0 * d0 + d1 * d1) * (1.f / 128.f), r = rsqrtf(var + GN_EPS);
            const size_t tok = (size_t)(b * SEQ + n0 + n);
            const float g0 = bf2f(P[tok * PW + PC_RG + h * 128 + lane]), g1 = bf2f(P[tok * PW + PC_RG + h * 128 + 64 + lane]);
            const float y0 = d0 * r * gng[h * 128 + lane] + gnb[h * 128 + lane], y1 = d1 * r * gng[h * 128 + 64 + lane] + gnb[h * 128 + 64 + lane];
            dst[tok * DM + 1024 + h * 128 + lane] = f2bf(silu_f(g0) * y0); dst[tok * DM + 1024 + h * 128 + 64 + lane] = f2bf(silu_f(g1) * y1); }
    }
}

__device__ __forceinline__ void p7_route(const Args& a, unsigned char* lds) {
    const int tid = threadIdx.x, lane = tid & 63, wave = tid >> 6;
    unsigned char* ws = a.ws; const float* x1 = a.out; bf16_t* h2 = (bf16_t*)(ws + WS_H2);
    const float* g2 = a.in[I_N2G]; const float* wrg = a.in[I_WRG]; const float* brg = a.in[I_BRG]; const float* wre = a.in[I_WRE]; const float* bre = a.in[I_BRE];
    unsigned* cnt = (unsigned*)(ws + WS_CNT); int* ltok = (int*)(ws + WS_LTOK); float* lw = (float*)(ws + WS_LW);
    for (int tok = blockIdx.x * 8 + wave; tok < T; tok += gridDim.x * 8) {
        const float* xr = x1 + (size_t)tok * DM; float ss = 0.f;
#pragma unroll
        for (int i = 0; i < 8; ++i) { const f32x4 v = *(const f32x4*)(xr + i * 256 + lane * 4); ss += v[0] * v[0] + v[1] * v[1] + v[2] * v[2] + v[3] * v[3]; }
        ss = wave_sum(ss); const float rs = rsqrtf(ss * (1.f / DM) + RMS_EPS);
        float lg[4], le[32];
#pragma unroll
        for (int j = 0; j < 4; ++j) lg[j] = 0.f;
#pragma unroll
        for (int j = 0; j < 32; ++j) le[j] = 0.f;
#pragma unroll 1
        for (int i = 0; i < 8; ++i) { const int d0 = i * 256 + lane * 4; const f32x4 gg = *(const f32x4*)(g2 + d0); const f32x4 v = *(const f32x4*)(xr + d0) * rs * gg;
            u32x2 w; w.x = pk2(v[0], v[1]); w.y = pk2(v[2], v[3]); *(u32x2*)(h2 + (size_t)tok * DM + d0) = w;
#pragma unroll
            for (int c = 0; c < 4; ++c) { const float hv = v[c]; const f32x4 wg = *(const f32x4*)(wrg + (size_t)(d0 + c) * 4);
                lg[0] += hv * wg[0]; lg[1] += hv * wg[1]; lg[2] += hv * wg[2]; lg[3] += hv * wg[3];
#pragma unroll
                for (int j4 = 0; j4 < 8; ++j4) { const f32x4 we = *(const f32x4*)(wre + (size_t)(d0 + c) * 32 + j4 * 4);
                    le[j4 * 4 + 0] += hv * we[0]; le[j4 * 4 + 1] += hv * we[1]; le[j4 * 4 + 2] += hv * we[2]; le[j4 * 4 + 3] += hv * we[3]; } } }
#pragma unroll
        for (int j = 0; j < 4; ++j) lg[j] = wave_sum(lg[j]) + brg[j];
#pragma unroll
        for (int j = 0; j < 32; ++j) le[j] = wave_sum(le[j]);
        int gi = 0; float gm = lg[0];
#pragma unroll
        for (int j = 1; j < 4; ++j) if (lg[j] > gm) { gm = lg[j]; gi = j; }
        float gs = 0.f;
#pragma unroll
        for (int j = 0; j < 4; ++j) gs += __expf(lg[j] - gm);
        const float gtop = 1.f / gs;
        float mine = 0.f;
#pragma unroll
        for (int j = 0; j < 32; ++j) mine = (lane == j) ? le[j] : mine;
        if (lane < 32) mine += bre[lane];
        float ls[8];
#pragma unroll
        for (int j = 0; j < 8; ++j) ls[j] = __shfl(mine, gi * 8 + j);
        int e0 = 0; float m0 = ls[0];
#pragma unroll
        for (int j = 1; j < 8; ++j) if (ls[j] > m0) { m0 = ls[j]; e0 = j; }
        int e1 = -1; float m1 = -INFINITY;
#pragma unroll
        for (int j = 0; j < 8; ++j) if (j != e0 && (e1 < 0 || ls[j] > m1)) { m1 = ls[j]; e1 = j; }
        const float p1 = __expf(m1 - m0); const float w0 = gtop / (1.f + p1), w1 = gtop * p1 / (1.f + p1);
        if (lane == 0) {
            const int ea = gi * 8 + e0, eb = gi * 8 + e1;
            const unsigned pa = atomicAdd(cnt + ea, 1u); ltok[ea * T + pa] = tok * 2 + 0; lw[ea * T + pa] = w0;
            const unsigned pb = atomicAdd(cnt + eb, 1u); ltok[eb * T + pb] = tok * 2 + 1; lw[eb * T + pb] = w1;
        }
    }
}

__device__ __forceinline__ void p8_gather(const Args& a, unsigned char* lds) {
    const int tid = threadIdx.x, lane = tid & 63, wave = tid >> 6;
    unsigned char* ws = a.ws; const bf16_t* h2 = (const bf16_t*)(ws + WS_H2); bf16_t* xg = (bf16_t*)(ws + WS_XG);
    const int* ltok = (const int*)(ws + WS_LTOK);
    MoeTab tab = moe_tab(lds); const int ntiles = moe_build_tab(tab, (const unsigned*)(ws + WS_CNT));
    for (int r = blockIdx.x * 8 + wave; r < ntiles * 256; r += gridDim.x * 8) {
        const int tile = r >> 8, e = tab.tile_e[tile], li = tab.tile_i[tile] * 256 + (r & 255);
        u32x4 v0 = {0u, 0u, 0u, 0u}, v1 = v0, v2 = v0, v3 = v0;
        if (li < tab.cnt[e]) { const int tok = ltok[e * T + li] >> 1; const u32x4* s = (const u32x4*)(h2 + (size_t)tok * DM);
            v0 = s[lane]; v1 = s[64 + lane]; v2 = s[128 + lane]; v3 = s[192 + lane]; }
        u32x4* dp = (u32x4*)(xg + (size_t)r * DM); dp[lane] = v0; dp[64 + lane] = v1; dp[128 + lane] = v2; dp[192 + lane] = v3;
    }
}

__device__ __forceinline__ void p11_final(const Args& a) {
    const bf16_t* y = (const bf16_t*)(a.ws + WS_Y); float* out = a.out;
    const size_t n8 = (size_t)T * DM / 8;
    for (size_t i = (size_t)blockIdx.x * NTHREADS + threadIdx.x; i < n8; i += (size_t)gridDim.x * NTHREADS) {
        const u32x4 a0 = *(const u32x4*)(y + i * 8), a1 = *(const u32x4*)(y + (size_t)T * DM + i * 8);
        f32x4 o0 = *(f32x4*)(out + i * 8), o1 = *(f32x4*)(out + i * 8 + 4);
        o0[0] += __uint_as_float(a0.x << 16) + __uint_as_float(a1.x << 16); o0[1] += __uint_as_float(a0.x & 0xffff0000u) + __uint_as_float(a1.x & 0xffff0000u);
        o0[2] += __uint_as_float(a0.y << 16) + __uint_as_float(a1.y << 16); o0[3] += __uint_as_float(a0.y & 0xffff0000u) + __uint_as_float(a1.y & 0xffff0000u);
        o1[0] += __uint_as_float(a0.z << 16) + __uint_as_float(a1.z << 16); o1[1] += __uint_as_float(a0.z & 0xffff0000u) + __uint_as_float(a1.z & 0xffff0000u);
        o1[2] += __uint_as_float(a0.w << 16) + __uint_as_float(a1.w << 16); o1[3] += __uint_as_float(a0.w & 0xffff0000u) + __uint_as_float(a1.w & 0xffff0000u);
        *(f32x4*)(out + i * 8) = o0; *(f32x4*)(out + i * 8 + 4) = o1;
    }
}

constexpr int NPHASES = 10;
__device__ __forceinline__ void run_phase(int ph, const Args& a, unsigned char* lds) {
    unsigned char* ws = a.ws;
    PG8_LAS unsigned char* l3 = (PG8_LAS unsigned char*)lds;
    const int G = gridDim.x, c = blockIdx.x;
    if (ph == 0) { p0_prepass(a, lds); }
    else if (ph == 1) {
        pg8::Gemm g{(const bf16_t*)(ws + WS_XB), (const bf16_t*)(ws + WS_WIN_T), T, NIN_PAD, DM}; pg8::StaticOrder S; S.init(T, NIN_PAD, G, c);
        EpiInProj E{(bf16_t*)(ws + WS_P), (float*)(ws + WS_GATES), (const float*)(ws + WS_ROWSCALE)};
        pg8::gemm_phase<EpiInProj, pg8::StaticOrder, true, true>(l3, g, S, E);
    }
    else if (ph == 2) { p2_finalize(a, lds); }
    else if (ph == 3) { nsa_naive(a, lds, (bf16_t*)(ws + WS_ATT)); ret_naive(a, lds, (bf16_t*)(ws + WS_ATT)); }
    else if (ph == 4) {
        pg8::Gemm g{(const bf16_t*)(ws + WS_ATT), (const bf16_t*)(ws + WS_WOUT_T), T, DM, DM}; pg8::StaticOrder S; S.init(T, DM, G, c);
        EpiOutProj E{a.in[I_X], a.out};
        pg8::gemm_phase<EpiOutProj, pg8::StaticOrder, true, true>(l3, g, S, E);
    }
    else if (ph == 5) { p7_route(a, lds); }
    else if (ph == 6) { p8_gather(a, lds); }
    else if (ph == 7) {
        MoeTab tab = moe_tab(lds); const int ntiles = moe_build_tab(tab, (const unsigned*)(ws + WS_CNT));
        pg8::Gemm g{(const bf16_t*)(ws + WS_XG), (const bf16_t*)(ws + WS_WGU_T), ntiles * 256, NEXP * 1024, DM}; MoeOrder<4> S{G, c, ntiles, tab.tile_e};
        EpiGateUp E{(bf16_t*)(ws + WS_HB)};
        pg8::gemm_phase<EpiGateUp, MoeOrder<4>, true, true>(l3, g, S, E);
    }
    else if (ph == 8) {
        MoeTab tab = moe_tab(lds); const int ntiles = moe_build_tab(tab, (const unsigned*)(ws + WS_CNT));
        pg8::Gemm g{(const bf16_t*)(ws + WS_HB), (const bf16_t*)(ws + WS_WD_T), ntiles * 256, NEXP * DM, DEXP}; MoeOrder<8> S{G, c, ntiles, tab.tile_e};
        EpiDown E{(bf16_t*)(ws + WS_Y), (const int*)(ws + WS_LTOK), (const float*)(ws + WS_LW), tab.tile_e, tab.tile_i, tab.cnt};
        pg8::gemm_phase<EpiDown, MoeOrder<8>, true, true>(l3, g, S, E);
    }
    else if (ph == 9) { p11_final(a); }
}

template <int PH> __global__ void __launch_bounds__(NTHREADS, 2) mega_one(Args a) {
    extern __shared__ __attribute__((aligned(16))) unsigned char lds[];
    run_phase(PH, a, lds);
}
__global__ void __launch_bounds__(NTHREADS, 2) mega_all(Args a) {
    extern __shared__ __attribute__((aligned(16))) unsigned char lds[];
    cg::grid_group grid = cg::this_grid();
#define MK_PHASE(k) if (a.ph_lo <= (k) && (k) < a.ph_hi) { run_phase((k), a, lds); if ((k) + 1 < a.ph_hi) grid.sync(); }
    MK_PHASE(0) MK_PHASE(1) MK_PHASE(2) MK_PHASE(3) MK_PHASE(4) MK_PHASE(5) MK_PHASE(6) MK_PHASE(7) MK_PHASE(8) MK_PHASE(9)
#undef MK_PHASE
}
typedef void (*kern_t)(Args);
static kern_t phase_kernels[NPHASES] = { mega_one<0>, mega_one<1>, mega_one<2>, mega_one<3>, mega_one<4>, mega_one<5>, mega_one<6>, mega_one<7>, mega_one<8>, mega_one<9> };

#ifndef MK_MULTI
#define MK_MULTI 0
#endif
extern "C" void kernel_launch(void* const* d_in, const int* in_sizes, int n_in, void* d_out, int out_size, void* d_ws, size_t ws_size, hipStream_t stream) {
    static int grid = 0;
    if (grid == 0) {
        if (n_in != 19 || in_sizes[0] != T * DM || out_size != T * DM || ws_size < WS_END) {
            fprintf(stderr, "kernel_launch: shape mismatch n_in %d in0 %d out %d ws %zu (need %zu)\n", n_in, n_in > 0 ? in_sizes[0] : -1, out_size, ws_size, (size_t)WS_END); grid = -1; return; }
        int dev = 0, cus = 0, per_cu = 0;
        if (hipGetDevice(&dev) != hipSuccess || hipDeviceGetAttribute(&cus, hipDeviceAttributeMultiprocessorCount, dev) != hipSuccess) { grid = -1; return; }
        for (int ph = 0; ph < NPHASES; ++ph)
            if (hipFuncSetAttribute((const void*)phase_kernels[ph], hipFuncAttributeMaxDynamicSharedMemorySize, LDS_BYTES) != hipSuccess) { fprintf(stderr, "kernel_launch: hipFuncSetAttribute failed\n"); grid = -1; return; }
        if (hipFuncSetAttribute((const void*)mega_all, hipFuncAttributeMaxDynamicSharedMemorySize, LDS_BYTES) != hipSuccess) { fprintf(stderr, "kernel_launch: hipFuncSetAttribute(mega_all) failed\n"); grid = -1; return; }
        if (hipOccupancyMaxActiveBlocksPerMultiprocessor(&per_cu, (const void*)mega_all, NTHREADS, LDS_BYTES) != hipSuccess || per_cu < 1) { fprintf(stderr, "kernel_launch: occupancy query failed (%d)\n", per_cu); grid = -1; return; }
        grid = cus * per_cu;
        fprintf(stderr, "kernel_launch: cus %d per_cu %d grid %d\n", cus, per_cu, grid);
    }
    if (grid < 0) return;
    Args a{};
    for (int i = 0; i < 19; ++i) a.in[i] = (const float*)d_in[i];
    a.out = (float*)d_out; a.ws = (unsigned char*)d_ws;
#if MK_MULTI
    for (int ph = 0; ph < NPHASES; ++ph) {
        a.ph_lo = ph; a.ph_hi = ph + 1;
        hipLaunchKernelGGL(phase_kernels[ph], dim3(grid), dim3(NTHREADS), LDS_BYTES, stream, a);
    }
#else
    a.ph_lo = 0; a.ph_hi = NPHASES;
    void* kargs[] = {&a};
    hipError_t e = hipLaunchCooperativeKernel((const void*)mega_all, dim3(grid), dim3(NTHREADS), kargs, LDS_BYTES, stream);
    if (e != hipSuccess) fprintf(stderr, "kernel_launch: cooperative launch failed: %s (grid %d)\n", hipGetErrorString(e), grid);
#endif
}
```

```cpp
#include <hip/hip_runtime.h>
#include <hip/hip_cooperative_groups.h>
#include <cstdio>
#include <cstdint>
namespace cg = cooperative_groups;

constexpr int BATCH = 8, SEQ = 2048, DM = 2048, T = BATCH * SEQ;
constexpr int NSA_H = 8, NSA_G = 2, NSA_HG = 4, HD = 128;
constexpr int RET_H = 8;
constexpr int CMP_BLOCK = 32, CMP_STRIDE = 16, NCMP = 127, SEL_BLOCK = 64, NSBLK = 32, NSEL = 8, WINDOW = 512;
constexpr int NGROUPS = 4, EPG = 8, NEXP = 32, DEXP = 512;
constexpr int IN_W = 6680;
constexpr int PW = 6656;
constexpr int NIN_PAD = 6912;
constexpr int PC_Q = 0, PC_KCMP = 1024, PC_VCMP = 1280, PC_KSLC = 1536, PC_VSLC = 1792, PC_KWIN = 2048, PC_VWIN = 2304, PC_RQ = 2560, PC_RK = 3584, PC_RV = 4608, PC_RG = 5632;
constexpr float RMS_EPS = 1e-6f, GN_EPS = 1e-5f;
constexpr float QK_SCALE = 0.08838834764831845f;
constexpr int NTHREADS = 512;
constexpr int MAXTILES = 160;

namespace pg8 {
#define PG8_LAS __attribute__((address_space(3)))
typedef unsigned short bf16_t;
typedef short bf16x8 __attribute__((ext_vector_type(8)));
typedef float f32x4 __attribute__((ext_vector_type(4)));
typedef unsigned u32x4 __attribute__((ext_vector_type(4)));
constexpr int BM = 256, BK = 64, HALF = 128, HTB = HALF * BK * 2, STAGE_BYTES = 8 * HTB, NXCD = 8, WGM = 8;

__host__ __device__ __forceinline__ int lds_byte(int r, int c) { const int st = (r >> 4) * 2 + (c >> 5), rr = r & 15, cc = c & 31, ob = rr * 64 + cc * 2; return st * 1024 + (ob ^ (((ob >> 9) & 1) << 5)); }
__host__ __device__ __forceinline__ void stage_rc(int b, int& R, int& C) { const int st = b / 1024, sb = b % 1024, swz = sb ^ (((sb >> 9) & 1) << 5); R = (st >> 1) * 16 + swz / 64; C = (st & 1) * 32 + (swz % 64) / 2; }
__host__ __device__ __forceinline__ int perm32(int rho) { const int n = rho >> 4, i = rho & 15; return 8 * (i >> 2) + 4 * n + (i & 3); }

struct Unit { int pm, pn; };
struct Gemm { const bf16_t* A; const bf16_t* Bt; int M, N, K; };

struct StaticOrder {
    int nM, nN, nwg, G, c;
    __host__ __device__ void init(int M, int N, int G_, int c_) { nM = M / BM; nN = N / BM; nwg = nM * nN; G = G_; c = c_; }
    __host__ __device__ bool next(int i, Unit& u) const {
        const long L = (long)i * G + c; if (L >= nwg) return false;
        int wgid = (int)L; { const int q = nwg / NXCD, r = nwg % NXCD, xcd = wgid % NXCD, off = wgid / NXCD; wgid = (xcd < r ? xcd * (q + 1) : r * (q + 1) + (xcd - r) * q) + off; }
        const int nig = WGM * nN, gid = wgid / nig, fm = gid * WGM, gsz = (nM - fm) < WGM ? (nM - fm) : WGM;
        u.pm = fm + ((wgid % nig) % gsz); u.pn = (wgid % nig) / gsz; return true;
    }
    __device__ __forceinline__ void a_ready(const Unit&) const {}
    __device__ __forceinline__ void done(const Unit&) const {}
};

__device__ __forceinline__ unsigned cvt_pk_bf16(float lo, float hi) { unsigned r; asm volatile("v_cvt_pk_bf16_f32 %0, %1, %2" : "=v"(r) : "v"(lo), "v"(hi)); return r; }

template <class Epi, class Sched, bool ALIGN_EPI = false, bool SP2 = false>
__device__ __forceinline__ void gemm_phase(PG8_LAS unsigned char* lds, const Gemm g, const Sched& S, const Epi& E) {
    const int tid = threadIdx.x, wid = __builtin_amdgcn_readfirstlane(tid >> 6), lane = tid & 63, wr = wid >> 2, wc = wid & 3, fr = lane & 15, fq = lane >> 4;
    const int K = g.K, nt = K / BK;
    unsigned voffA[2], voffB[2];
#pragma unroll
    for (int i = 0; i < 2; ++i) { int R, C; stage_rc(tid * 16 + i * 8192, R, C); const int Rb = Epi::PERM ? ((R & ~31) + perm32(R & 31)) : R;
        voffA[i] = (unsigned)(R * K + C) * 2u; voffB[i] = (unsigned)(Rb * K + C) * 2u; }
    const size_t kstep = (size_t)(BK * 2);
    const size_t hstep = (size_t)HALF * K * 2;
    const size_t tstep = 2 * hstep;
    const unsigned ldsw = (unsigned)wid * 1024u;
    const int aoff = lds_byte(wr * 64 + fr, fq * 8), boff = lds_byte(wc * 32 + fr, fq * 8);
#define PG8_SA(b, h) (((b) * 2 + (h)) * HTB)
#define PG8_SB(b, h) ((4 + (b) * 2 + (h)) * HTB)
#define PG8_STAGE(bufoff, gbase, voff) do { _Pragma("unroll") for (int _i = 0; _i < 2; ++_i) \
        __builtin_amdgcn_global_load_lds((const unsigned*)((const char*)(gbase) + (voff)[_i]), (PG8_LAS unsigned*)(lds + (bufoff) + ldsw + _i * 8192), 16, 0, 0); } while (0)
#define PG8_LDA(dst, b, h) do { _Pragma("unroll") for (int m = 0; m < 4; ++m) _Pragma("unroll") for (int k = 0; k < 2; ++k) dst[m][k] = *(const PG8_LAS bf16x8*)(lds + PG8_SA(b, h) + aoff + m * 2048 + k * 1024); } while (0)
#define PG8_LDB(dst, b, h) do { _Pragma("unroll") for (int n = 0; n < 2; ++n) _Pragma("unroll") for (int k = 0; k < 2; ++k) dst[n][k] = *(const PG8_LAS bf16x8*)(lds + PG8_SB(b, h) + boff + n * 2048 + k * 1024); } while (0)
#define PG8_MMA(ai, bj, At, Bt) do { __builtin_amdgcn_s_setprio(1); _Pragma("unroll") for (int m = 0; m < 4; ++m) _Pragma("unroll") for (int n = 0; n < 2; ++n) _Pragma("unroll") for (int k = 0; k < 2; ++k) \
        acc[ai][bj][m][n] = __builtin_amdgcn_mfma_f32_16x16x32_bf16(Bt[n][k], At[m][k], acc[ai][bj][m][n], 0, 0, 0); __builtin_amdgcn_s_setprio(0); } while (0)
#define PG8_WAIT_V(n) asm volatile("s_waitcnt vmcnt(" #n ")" ::: "memory")
#define PG8_WAIT_L(n) asm volatile("s_waitcnt lgkmcnt(" #n ")" ::: "memory")
#define PG8_BAR __builtin_amdgcn_s_barrier()
#define PG8_SCHED __builtin_amdgcn_sched_barrier(0)
    Unit cur, nxt; int ui = 0;
    if (!S.next(0, cur)) return;
    f32x4 acc[2][2][4][2];
#pragma unroll
    for (int a = 0; a < 2; ++a)
#pragma unroll
        for (int b = 0; b < 2; ++b)
#pragma unroll
            for (int m = 0; m < 4; ++m)
#pragma unroll
                for (int n = 0; n < 2; ++n) acc[a][b][m][n] = (f32x4){0.f, 0.f, 0.f, 0.f};
    bf16x8 At[4][2], B0[2][2], B1[2][2];
    const char* cA = (const char*)g.A + (size_t)cur.pm * tstep; const char* cB = (const char*)g.Bt + (size_t)cur.pn * tstep;
    S.a_ready(cur);
    if constexpr (SP2) {
        PG8_STAGE(PG8_SB(0, 0), cB, voffB); PG8_STAGE(PG8_SB(0, 1), cB + hstep, voffB); PG8_STAGE(PG8_SA(0, 0), cA, voffA); PG8_STAGE(PG8_SA(0, 1), cA + hstep, voffA);
        if (wr == 1) PG8_BAR;
        PG8_WAIT_V(2); PG8_BAR;
        PG8_STAGE(PG8_SB(1, 0), cB + kstep, voffB); PG8_STAGE(PG8_SA(1, 0), cA + kstep, voffA); PG8_STAGE(PG8_SB(1, 1), cB + hstep + kstep, voffB);
        PG8_WAIT_V(6); PG8_BAR;
    } else {
        PG8_STAGE(PG8_SB(0, 0), cB, voffB); PG8_STAGE(PG8_SA(0, 0), cA, voffA); PG8_STAGE(PG8_SB(0, 1), cB + hstep, voffB); PG8_STAGE(PG8_SA(0, 1), cA + hstep, voffA);
        if (wr == 1) PG8_BAR;
        PG8_WAIT_V(4); PG8_BAR;
        PG8_STAGE(PG8_SB(1, 0), cB + kstep, voffB); PG8_STAGE(PG8_SA(1, 0), cA + kstep, voffA); PG8_STAGE(PG8_SB(1, 1), cB + hstep + kstep, voffB);
        PG8_WAIT_V(6); PG8_BAR;
    }
    for (;;) {
        const bool has_next = S.next(ui + 1, nxt);
        const char* nA = has_next ? (const char*)g.A + (size_t)nxt.pm * tstep : cA; const char* nB = has_next ? (const char*)g.Bt + (size_t)nxt.pn * tstep : cB;
        for (int t = 0; t < nt; t += 2) {
            const bool last = (t == nt - 2);
            const char* a1 = cA + (size_t)(t + 1) * kstep;
            const char* a2 = last ? nA : cA + (size_t)(t + 2) * kstep; const char* b2 = last ? nB : cB + (size_t)(t + 2) * kstep;
            const char* a3 = a2 + kstep; const char* b3 = b2 + kstep;
            if (last && has_next) S.a_ready(nxt);
            if constexpr (SP2) {
            PG8_LDB(B0, 0, 0); PG8_LDB(B1, 0, 1); PG8_SCHED; PG8_LDA(At, 0, 0); PG8_STAGE(PG8_SA(1, 1), a1 + hstep, voffA);
            PG8_WAIT_V(8); PG8_WAIT_L(0); PG8_BAR; PG8_MMA(0, 0, At, B0); PG8_MMA(0, 1, At, B1); PG8_BAR; PG8_SCHED;
            PG8_LDA(At, 0, 1); PG8_STAGE(PG8_SB(0, 0), b2, voffB); PG8_STAGE(PG8_SB(0, 1), b2 + hstep, voffB); PG8_STAGE(PG8_SA(0, 0), a2, voffA);
            PG8_WAIT_V(8); PG8_WAIT_L(0); PG8_BAR; PG8_MMA(1, 0, At, B0); PG8_MMA(1, 1, At, B1); PG8_BAR; PG8_SCHED;
            PG8_LDB(B0, 1, 0); PG8_LDB(B1, 1, 1); PG8_SCHED; PG8_LDA(At, 1, 0); PG8_STAGE(PG8_SA(0, 1), a2 + hstep, voffA);
            PG8_WAIT_V(8); PG8_WAIT_L(0); PG8_BAR; PG8_MMA(0, 0, At, B0); PG8_MMA(0, 1, At, B1); PG8_BAR; PG8_SCHED;
            PG8_LDA(At, 1, 1); PG8_STAGE(PG8_SB(1, 0), b3, voffB); PG8_STAGE(PG8_SB(1, 1), b3 + hstep, voffB); PG8_STAGE(PG8_SA(1, 0), a3, voffA);
            PG8_WAIT_V(8); PG8_WAIT_L(0); PG8_BAR; PG8_MMA(1, 0, At, B0); PG8_MMA(1, 1, At, B1); PG8_BAR; PG8_SCHED;
            } else {
            PG8_LDB(B0, 0, 0); PG8_SCHED; PG8_LDA(At, 0, 0); PG8_STAGE(PG8_SA(1, 1), a1 + hstep, voffA);
            PG8_WAIT_L(8); PG8_BAR; PG8_WAIT_L(0); PG8_MMA(0, 0, At, B0); PG8_BAR; PG8_SCHED;
            PG8_LDB(B1, 0, 1); PG8_STAGE(PG8_SB(0, 0), b2, voffB);
            PG8_BAR; PG8_WAIT_L(0); PG8_MMA(0, 1, At, B1); PG8_BAR;
            PG8_LDA(At, 0, 1); PG8_STAGE(PG8_SA(0, 0), a2, voffA);
            PG8_BAR; PG8_WAIT_L(0); PG8_MMA(1, 0, At, B0); PG8_BAR; PG8_SCHED;
            PG8_STAGE(PG8_SB(0, 1), b2 + hstep, voffB);
            PG8_WAIT_V(6); PG8_BAR; PG8_MMA(1, 1, At, B1); PG8_BAR;
            PG8_LDB(B0, 1, 0); PG8_SCHED; PG8_LDA(At, 1, 0); PG8_STAGE(PG8_SA(0, 1), a2 + hstep, voffA);
            PG8_WAIT_L(8); PG8_BAR; PG8_WAIT_L(0); PG8_MMA(0, 0, At, B0); PG8_BAR; PG8_SCHED;
            PG8_LDB(B1, 1, 1); PG8_STAGE(PG8_SB(1, 0), b3, voffB);
            PG8_BAR; PG8_WAIT_L(0); PG8_MMA(0, 1, At, B1); PG8_BAR;
            PG8_LDA(At, 1, 1); PG8_STAGE(PG8_SA(1, 0), a3, voffA);
            PG8_BAR; PG8_WAIT_L(0); PG8_MMA(1, 0, At, B0); PG8_BAR; PG8_SCHED;
            PG8_STAGE(PG8_SB(1, 1), b3 + hstep, voffB);
            PG8_WAIT_V(6); PG8_BAR; PG8_MMA(1, 1, At, B1); PG8_BAR;
            }
        }
        if constexpr (ALIGN_EPI) { if (wr == 0) PG8_BAR; }
        if constexpr (!Epi::AFTER_DRAIN) { E(acc, cur, wr, wc, fr, fq); S.done(cur); }
        if (!has_next) break;
#pragma unroll
        for (int a = 0; a < 2; ++a)
#pragma unroll
            for (int b = 0; b < 2; ++b)
#pragma unroll
                for (int m = 0; m < 4; ++m)
#pragma unroll
                    for (int n = 0; n < 2; ++n) acc[a][b][m][n] = (f32x4){0.f, 0.f, 0.f, 0.f};
        cur = nxt; cA = nA; cB = nB; ++ui;
        if constexpr (ALIGN_EPI) { if (wr == 1) PG8_BAR; }
    }
    PG8_WAIT_V(0);
    if constexpr (!ALIGN_EPI) { if (wr == 0) PG8_BAR; }
    PG8_BAR;
    if constexpr (Epi::AFTER_DRAIN) { E.fused(acc, cur, wr, wc, fr, fq, lds, wid, lane); S.done(cur); }
#undef PG8_SA
#undef PG8_SB
#undef PG8_STAGE
#undef PG8_LDA
#undef PG8_LDB
#undef PG8_MMA
#undef PG8_WAIT_V
#undef PG8_WAIT_L
#undef PG8_BAR
#undef PG8_SCHED
}
}

typedef unsigned short bf16_t;
typedef short bf16x8 __attribute__((ext_vector_type(8)));
typedef float f32x4 __attribute__((ext_vector_type(4)));
typedef float f32x16 __attribute__((ext_vector_type(16)));
typedef unsigned u32x4 __attribute__((ext_vector_type(4)));
typedef unsigned u32x2 __attribute__((ext_vector_type(2)));
#define LAS __attribute__((address_space(3)))

__device__ __forceinline__ float bf2f(bf16_t v) { return __uint_as_float((unsigned)v << 16); }
__device__ __forceinline__ bf16_t f2bf(float f) { unsigned u = __float_as_uint(f); return (bf16_t)((u + 0x7fffu + ((u >> 16) & 1u)) >> 16); }
__device__ __forceinline__ unsigned pk2(float lo, float hi) { return (unsigned)f2bf(lo) | ((unsigned)f2bf(hi) << 16); }
__device__ __forceinline__ float wave_sum(float v) {
#pragma unroll
    for (int o = 32; o >= 1; o >>= 1) v += __shfl_xor(v, o);
    return v;
}
__device__ __forceinline__ float wave_max(float v) {
#pragma unroll
    for (int o = 32; o >= 1; o >>= 1) v = fmaxf(v, __shfl_xor(v, o));
    return v;
}
__device__ __forceinline__ float silu_f(float x) { return x / (1.f + __expf(-x)); }
__device__ __forceinline__ float sigmoid_f(float x) { return 1.f / (1.f + __expf(-x)); }

constexpr size_t MiB = 1u << 20;
constexpr size_t WS_ROWSCALE = 0;
constexpr size_t WS_CNT      = 64 * 1024;
constexpr size_t WS_RS2      = 128 * 1024;
constexpr size_t WS_SINCOS   = 1 * MiB;
constexpr size_t WS_GATES    = 2 * MiB;
constexpr size_t WS_KC       = 4 * MiB;
constexpr size_t WS_VC       = 5 * MiB;
constexpr size_t WS_LTOK     = 6 * MiB;
constexpr size_t WS_LW       = 8 * MiB;
constexpr size_t WS_SELMASK  = 10 * MiB;
constexpr size_t WS_SELMASK2 = 10 * MiB + 256 * 1024;
constexpr size_t WS_KCB      = 10 * MiB + 512 * 1024;
constexpr size_t WS_VCB      = 11 * MiB;
constexpr size_t WS_DBG      = 64 * 1024 + 1024;
constexpr size_t WS_WIN_T    = 12 * MiB;
constexpr size_t WS_WOUT_T   = 39 * MiB;
constexpr size_t WS_WGU_T    = 47 * MiB;
constexpr size_t WS_WD_T     = 175 * MiB;
constexpr size_t WS_XB       = 239 * MiB;
constexpr size_t WS_ATT      = 303 * MiB;
constexpr size_t WS_Y        = 239 * MiB;
constexpr size_t WS_P        = 367 * MiB;
constexpr size_t WS_XG       = 367 * MiB;
constexpr size_t WS_HB       = 527 * MiB;
constexpr size_t WS_END      = 575 * MiB;
constexpr size_t WS_H2       = WS_XB;
constexpr size_t WS_FIN      = WS_XB + 32 * MiB;
constexpr size_t WS_REF      = WS_XB;

struct Args { const float* in[19]; float* out; unsigned char* ws; int ph_lo, ph_hi; };
enum { I_X = 0, I_N1G, I_WIN, I_CPOS, I_CW1, I_CW2, I_QNG, I_KNG, I_GNG, I_GNB, I_WOUT, I_N2G, I_WRG, I_BRG, I_WRE, I_BRE, I_WEG, I_WEU, I_WED };

constexpr int LDS_BYTES = 147456;
constexpr int LDS_TAB = 131072;

using pg8::Unit;
struct EpiInProj {
    static constexpr bool PERM = true, AFTER_DRAIN = false;
    bf16_t* P; float* gates; const float* rowscale;
    __device__ __forceinline__ void operator()(const f32x4 (&acc)[2][2][4][2], const Unit& u, int wr, int wc, int fr, int fq) const {
        const int row0 = u.pm * 256 + wr * 64 + fr;
        if (u.pn < 26) {
            const int col0 = u.pn * 256 + wc * 32 + 8 * fq;
#pragma unroll
            for (int ai = 0; ai < 2; ++ai)
#pragma unroll
                for (int m = 0; m < 4; ++m) {
                    const int row = row0 + ai * 128 + m * 16; const float rs = rowscale[row];
                    bf16_t* rowp = P + (size_t)row * PW + col0;
#pragma unroll
                    for (int bj = 0; bj < 2; ++bj) {
                        const f32x4 v0 = acc[ai][bj][m][0] * rs, v1 = acc[ai][bj][m][1] * rs;
                        u32x4 w; w.x = pg8::cvt_pk_bf16(v0[0], v0[1]); w.y = pg8::cvt_pk_bf16(v0[2], v0[3]); w.z = pg8::cvt_pk_bf16(v1[0], v1[1]); w.w = pg8::cvt_pk_bf16(v1[2], v1[3]);
                        *(u32x4*)(rowp + bj * 128) = w;
                    }
                }
        } else {
            if (wc == 0 && fq < 3) {
#pragma unroll
                for (int ai = 0; ai < 2; ++ai)
#pragma unroll
                    for (int m = 0; m < 4; ++m) {
                        const int row = row0 + ai * 128 + m * 16; const float rs = rowscale[row];
                        float* gp = gates + (size_t)row * 24 + 8 * fq;
                        *(f32x4*)gp = acc[ai][0][m][0] * rs; *(f32x4*)(gp + 4) = acc[ai][0][m][1] * rs;
                    }
            }
        }
    }
};
struct EpiOutProj {
    static constexpr bool PERM = true, AFTER_DRAIN = false;
    const float* x; float* x1;
    __device__ __forceinline__ void operator()(const f32x4 (&acc)[2][2][4][2], const Unit& u, int wr, int wc, int fr, int fq) const {
        const int row0 = u.pm * 256 + wr * 64 + fr, col0 = u.pn * 256 + wc * 32 + 8 * fq;
#pragma unroll
        for (int ai = 0; ai < 2; ++ai)
#pragma unroll
            for (int m = 0; m < 4; ++m) {
                const size_t off = (size_t)(row0 + ai * 128 + m * 16) * DM + col0;
#pragma unroll
                for (int bj = 0; bj < 2; ++bj) {
                    const f32x4 a0 = *(const f32x4*)(x + off + bj * 128), a1 = *(const f32x4*)(x + off + bj * 128 + 4);
                    *(f32x4*)(x1 + off + bj * 128) = a0 + acc[ai][bj][m][0]; *(f32x4*)(x1 + off + bj * 128 + 4) = a1 + acc[ai][bj][m][1];
                }
            }
    }
};
struct EpiGateUp {
    static constexpr bool PERM = true, AFTER_DRAIN = false;
    bf16_t* hb;
    __device__ __forceinline__ void operator()(const f32x4 (&acc)[2][2][4][2], const Unit& u, int wr, int wc, int fr, int fq) const {
        const int row0 = u.pm * 256 + wr * 64 + fr, col0 = (u.pn & 3) * 128 + wc * 32 + 8 * fq;
#pragma unroll
        for (int ai = 0; ai < 2; ++ai)
#pragma unroll
            for (int m = 0; m < 4; ++m) {
                bf16_t* rowp = hb + (size_t)(row0 + ai * 128 + m * 16) * DEXP + col0;
                const f32x4 g0 = acc[ai][0][m][0], g1 = acc[ai][0][m][1], u0 = acc[ai][1][m][0], u1 = acc[ai][1][m][1];
                float r[8];
#pragma unroll
                for (int j = 0; j < 4; ++j) { r[j] = silu_f(g0[j]) * u0[j]; r[4 + j] = silu_f(g1[j]) * u1[j]; }
                u32x4 w; w.x = pg8::cvt_pk_bf16(r[0], r[1]); w.y = pg8::cvt_pk_bf16(r[2], r[3]); w.z = pg8::cvt_pk_bf16(r[4], r[5]); w.w = pg8::cvt_pk_bf16(r[6], r[7]);
                *(u32x4*)rowp = w;
            }
    }
};
struct EpiDown {
    static constexpr bool PERM = true, AFTER_DRAIN = false;
    bf16_t* y; const int* ltok; const float* lw; const LAS int* tile_e; const LAS int* tile_i; const LAS int* cnt;
    __device__ __forceinline__ void operator()(const f32x4 (&acc)[2][2][4][2], const Unit& u, int wr, int wc, int fr, int fq) const {
        const int e = tile_e[u.pm], li0 = tile_i[u.pm] * 256, n = cnt[e];
        const int col0 = (u.pn & 7) * 256 + wc * 32 + 8 * fq;
#pragma unroll
        for (int ai = 0; ai < 2; ++ai)
#pragma unroll
            for (int m = 0; m < 4; ++m) {
                const int li = li0 + wr * 64 + fr + ai * 128 + m * 16;
                if (li < n) {
                    const int tr = ltok[e * T + li]; const float w = lw[e * T + li];
                    bf16_t* rowp = y + ((size_t)(tr & 1) * T + (tr >> 1)) * DM + col0;
#pragma unroll
                    for (int bj = 0; bj < 2; ++bj) {
                        const f32x4 v0 = acc[ai][bj][m][0] * w, v1 = acc[ai][bj][m][1] * w;
                        u32x4 q; q.x = pg8::cvt_pk_bf16(v0[0], v0[1]); q.y = pg8::cvt_pk_bf16(v0[2], v0[3]); q.z = pg8::cvt_pk_bf16(v1[0], v1[1]); q.w = pg8::cvt_pk_bf16(v1[2], v1[3]);
                        *(u32x4*)(rowp + bj * 128) = q;
                    }
                }
            }
    }
};
template <int NPN> struct MoeOrder {
    int G, c, ntiles; const LAS int* tile_e;
    __device__ __forceinline__ bool next(int i, Unit& u) const {
        const int L = i * G + c; if (L >= ntiles * NPN) return false;
        const int tile = L / NPN; u.pm = tile; u.pn = tile_e[tile] * NPN + (L % NPN); return true;
    }
    __device__ __forceinline__ void a_ready(const Unit&) const {}
    __device__ __forceinline__ void done(const Unit&) const {}
};

struct MoeTab { LAS int* cnt; LAS int* tstart; LAS int* tile_e; LAS int* tile_i; };
__device__ __forceinline__ MoeTab moe_tab(unsigned char* lds) {
    MoeTab t; LAS int* base = (LAS int*)(lds + LDS_TAB); t.cnt = base; t.tstart = base + 32; t.tile_e = base + 72; t.tile_i = base + 72 + MAXTILES; return t;
}
__device__ __forceinline__ int moe_build_tab(const MoeTab& t, const unsigned* gcnt) {
    __syncthreads();
    if (threadIdx.x == 0) {
        int acc = 0;
        for (int e = 0; e < NEXP; ++e) {
            const int n = (int)__hip_atomic_load(gcnt + e, __ATOMIC_RELAXED, __HIP_MEMORY_SCOPE_AGENT);
            t.cnt[e] = n; t.tstart[e] = acc; const int nt = (n + 255) >> 8;
            for (int i = 0; i < nt; ++i) { t.tile_e[acc + i] = e; t.tile_i[acc + i] = i; }
            acc += nt;
        }
        t.tstart[NEXP] = acc;
    }
    __syncthreads();
    return t.tstart[NEXP];
}

__device__ __forceinline__ void transpose_item(const float* __restrict__ src, int ldn, int k0, int n0, int nvalid, bf16_t* __restrict__ dst, int ldk,
                                               const float* __restrict__ gs, float* tile) {
    const int tid = threadIdx.x;
    { const int r = tid >> 4, c4 = (tid & 15) * 4;
#pragma unroll
      for (int h = 0; h < 2; ++h) { const int rr = r + 32 * h;
        f32x4 v = {0.f, 0.f, 0.f, 0.f};
        if (c4 < nvalid) v = *(const f32x4*)(src + (size_t)(k0 + rr) * ldn + n0 + c4);
        if (gs) v = v * gs[k0 + rr];
        float* tp = tile + rr * 65 + c4; tp[0] = v[0]; tp[1] = v[1]; tp[2] = v[2]; tp[3] = v[3]; } }
    __syncthreads();
    { const int n = tid >> 3, kc = (tid & 7) * 8; float v[8];
#pragma unroll
      for (int j = 0; j < 8; ++j) v[j] = tile[(kc + j) * 65 + n];
      u32x4 w; w.x = pk2(v[0], v[1]); w.y = pk2(v[2], v[3]); w.z = pk2(v[4], v[5]); w.w = pk2(v[6], v[7]);
      *(u32x4*)(dst + (size_t)n * ldk + k0 + kc) = w; }
    __syncthreads();
}

__device__ __forceinline__ void p0_prepass(const Args& a, unsigned char* lds) {
    const int tid = threadIdx.x, lane = tid & 63, wave = tid >> 6;
    unsigned char* ws = a.ws;
    { const float* x = a.in[I_X]; bf16_t* xb = (bf16_t*)(ws + WS_XB); float* rsc = (float*)(ws + WS_ROWSCALE);
      for (int row = blockIdx.x * 8 + wave; row < T; row += gridDim.x * 8) {
        const float* xr = x + (size_t)row * DM; f32x4 v[8]; float ss = 0.f;
#pragma unroll
        for (int i = 0; i < 8; ++i) { v[i] = *(const f32x4*)(xr + i * 256 + lane * 4); ss += v[i][0] * v[i][0] + v[i][1] * v[i][1] + v[i][2] * v[i][2] + v[i][3] * v[i][3]; }
        ss = wave_sum(ss);
        if (lane == 0) rsc[row] = rsqrtf(ss * (1.f / DM) + RMS_EPS);
#pragma unroll
        for (int i = 0; i < 8; ++i) { u32x2 w; w.x = pk2(v[i][0], v[i][1]); w.y = pk2(v[i][2], v[i][3]); *(u32x2*)(xb + (size_t)row * DM + i * 256 + lane * 4) = w; }
      } }
    { float* tile = (float*)lds;
      bf16_t* WinT = (bf16_t*)(ws + WS_WIN_T); bf16_t* WoT = (bf16_t*)(ws + WS_WOUT_T); bf16_t* WguT = (bf16_t*)(ws + WS_WGU_T); bf16_t* WdT = (bf16_t*)(ws + WS_WD_T);
      constexpr int N_A = (NIN_PAD / 64) * 32, N_B = 32 * 32, N_E = 768, NITEMS = N_A + N_B + NEXP * N_E;
      for (int it = blockIdx.x; it < NITEMS; it += gridDim.x) {
        if (it < N_A) { const int nb = it >> 5, kb = it & 31, nd = nb * 64; int c0, nv;
            if (nd < 2560) { c0 = nd; nv = 64; } else if (nd < PW) { c0 = nd + 24; nv = 64; } else if (nd == PW) { c0 = 2560; nv = 24; } else { c0 = 0; nv = 0; }
            transpose_item(a.in[I_WIN], IN_W, kb * 64, c0, nv, WinT + (size_t)nd * DM, DM, a.in[I_N1G], tile); }
        else if (it < N_A + N_B) { const int j = it - N_A, nb = j >> 5, kb = j & 31;
            transpose_item(a.in[I_WOUT], DM, kb * 64, nb * 64, 64, WoT + (size_t)nb * 64 * DM, DM, nullptr, tile); }
        else { const int j = it - N_A - N_B, e = j / N_E, r = j % N_E;
            if (r < 512) { const int up = r >> 8, rr = r & 255, nb = rr >> 5, kb = rr & 31, n0 = nb * 64, drow = 256 * (n0 >> 7) + (n0 & 127) + 128 * up;
                transpose_item(a.in[up ? I_WEU : I_WEG] + (size_t)e * DM * DEXP, DEXP, kb * 64, n0, 64, WguT + ((size_t)e * 1024 + drow) * DM, DM, nullptr, tile); }
            else { const int r2 = r - 512, nb = r2 >> 3, kb = r2 & 7;
                transpose_item(a.in[I_WED] + (size_t)e * DEXP * DM, DM, kb * 64, nb * 64, 64, WdT + ((size_t)e * DM + nb * 64) * DEXP, DEXP, nullptr, tile); } }
      } }
    { float* ct = (float*)(ws + WS_SINCOS); float* st = ct + SEQ * 64;
      for (int idx = blockIdx.x * NTHREADS + tid; idx < SEQ * 64; idx += gridDim.x * NTHREADS) {
        const int pos = idx >> 6, i = idx & 63;
        const float inv_freq = exp2f(-(float)i * (13.287712379549449f / 64.f));
        const float ang = (float)pos * inv_freq;
        const double rev = (double)ang * 0.15915494309189535; const float fr = (float)(rev - rint(rev));
        ct[idx] = __builtin_amdgcn_cosf(fr); st[idx] = __builtin_amdgcn_sinf(fr);
      }
      if (blockIdx.x == 0 && tid < 128) ((unsigned*)(ws + WS_CNT))[tid] = 0u;
      if (blockIdx.x == 0 && tid < 8) ((float*)(ws + WS_DBG))[tid] = 0.f; }
}

__device__ __forceinline__ void p2_finalize(const Args& a, unsigned char* lds) {
    const int tid = threadIdx.x, lane = tid & 63, wave = tid >> 6;
    unsigned char* ws = a.ws; bf16_t* P = (bf16_t*)(ws + WS_P);
    const float* ct = (const float*)(ws + WS_SINCOS); const float* st = ct + SEQ * 64;
    const float* qng = a.in[I_QNG]; const float* kng = a.in[I_KNG];
    for (int tok = blockIdx.x * 8 + wave; tok < T; tok += gridDim.x * 8) {
        bf16_t* pr = P + (size_t)tok * PW; const int pos = tok & (SEQ - 1);
#pragma unroll
        for (int h = 0; h < 8; ++h) { unsigned* p2 = (unsigned*)(pr + PC_Q + h * 128) + lane; const unsigned w = *p2;
            const float v0 = __uint_as_float(w << 16), v1 = __uint_as_float(w & 0xffff0000u);
            const float ss = wave_sum(v0 * v0 + v1 * v1), r = rsqrtf(ss * (1.f / 128.f) + RMS_EPS);
            *p2 = pk2(v0 * r * qng[2 * lane], v1 * r * qng[2 * lane + 1]); }
#pragma unroll
        for (int j = 0; j < 4; ++j) { const int col = (j < 2 ? PC_KSLC : PC_KWIN) + (j & 1) * 128; const float* gg = kng + (j < 2 ? 128 : 256);
            unsigned* p2 = (unsigned*)(pr + col) + lane; const unsigned w = *p2;
            const float v0 = __uint_as_float(w << 16), v1 = __uint_as_float(w & 0xffff0000u);
            const float ss = wave_sum(v0 * v0 + v1 * v1), r = rsqrtf(ss * (1.f / 128.f) + RMS_EPS);
            *p2 = pk2(v0 * r * gg[2 * lane], v1 * r * gg[2 * lane + 1]); }
        const float c = ct[pos * 64 + lane], s = st[pos * 64 + lane]; const float nl = (float)(pos & 127);
#pragma unroll
        for (int h = 0; h < 8; ++h) {
            const float lg2 = log2f(1.f - exp2f(-5.f - (float)h)), sq = exp2f(lg2 * nl), sk = exp2f(-lg2 * nl) * QK_SCALE;
            { bf16_t* q1 = pr + PC_RQ + h * 128 + lane; const float t1 = bf2f(q1[0]), t2 = bf2f(q1[64]); q1[0] = f2bf((t1 * c - t2 * s) * sq); q1[64] = f2bf((t1 * s + t2 * c) * sq); }
            { bf16_t* k1 = pr + PC_RK + h * 128 + lane; const float t1 = bf2f(k1[0]), t2 = bf2f(k1[64]); k1[0] = f2bf((t1 * c - t2 * s) * sk); k1[64] = f2bf((t1 * s + t2 * c) * sk); }
        }
    }
    float* tb = (float*)lds; float* red = tb + 4096; float* hidl = red + 512; float* red2 = hidl + 128;
    const float* cpos = a.in[I_CPOS]; const float* w1 = a.in[I_CW1]; const float* w2 = a.in[I_CW2];
    float* KC = (float*)(ws + WS_KC); float* VC = (float*)(ws + WS_VC); bf16_t* KCb = (bf16_t*)(ws + WS_KCB); bf16_t* VCb = (bf16_t*)(ws + WS_VCB);
    for (int i = blockIdx.x * NTHREADS + tid; i < 16 * 128; i += gridDim.x * NTHREADS) { const size_t oi = ((size_t)(i >> 7) * 128 + 127) * 128 + (i & 127); KCb[oi] = 0; VCb[oi] = 0; KC[oi] = 0.f; VC[oi] = 0.f; }
    for (int item = blockIdx.x; item < BATCH * NCMP * 4; item += gridDim.x) {
        const int which = item & 1, g = (item >> 1) & 1, rest = item >> 2, n = rest % NCMP, b = rest / NCMP;
        __syncthreads();
#pragma unroll
        for (int i = 0; i < 8; ++i) { const int idx = tid + 512 * i, l = idx >> 7, d = idx & 127; const int tok = b * SEQ + 16 * n + l;
            tb[idx] = bf2f(P[(size_t)tok * PW + (which ? PC_VCMP : PC_KCMP) + g * 128 + d]) + cpos[which * 4096 + idx]; }
        __syncthreads();
        { const int e = tid & 127, part = tid >> 7; float sacc = 0.f; const float* wp = w1 + ((size_t)which * 4096 + part * 1024) * 128 + e; const float* tp = tb + part * 1024;
          for (int k = 0; k < 1024; ++k) sacc += tp[k] * wp[(size_t)k * 128];
          red[part * 128 + e] = sacc; }
        __syncthreads();
        if (tid < 128) hidl[tid] = silu_f(red[tid] + red[128 + tid] + red[256 + tid] + red[384 + tid]);
        __syncthreads();
        float o = 0.f;
        if (tid < 128) { const float* wp = w2 + which * 16384 + tid; for (int e = 0; e < 128; ++e) o += hidl[e] * wp[e * 128];
            const float ss = wave_sum(o * o); if (lane == 0) red2[wave] = ss; }
        __syncthreads();
        if (tid < 128) { const size_t oi = ((size_t)(b * 2 + g) * 128 + n) * 128 + tid;
            if (which == 0) { const float r = rsqrtf((red2[0] + red2[1]) * (1.f / 128.f) + RMS_EPS); const float kv = o * r * kng[tid]; KC[oi] = kv; KCb[oi] = f2bf(kv); } else { VC[oi] = o; VCb[oi] = f2bf(o); } }
    }
}

__device__ __forceinline__ void softmax_rows(float* sc, int ncols, int tid) {
    const int lane = tid & 63, wave = tid >> 6;
    if (wave < 4) { float* r = sc + wave * 512; float mx = -1e30f;
        for (int i = lane; i < ncols; i += 64) mx = fmaxf(mx, r[i]);
        mx = wave_max(mx); float sum = 0.f;
        for (int i = lane; i < ncols; i += 64) { const float v = r[i]; const float e = (v > -1e29f) ? __expf(v - mx) : 0.f; r[i] = e; sum += e; }
        sum = wave_sum(sum); const float inv = sum > 0.f ? 1.f / sum : 0.f;
        for (int i = lane; i < ncols; i += 64) r[i] *= inv; }
}
__device__ __forceinline__ float dot_q_kbf16(const float* q, const bf16_t* k) {
    float s = 0.f;
#pragma unroll
    for (int c = 0; c < 16; ++c) { const u32x4 w = *(const u32x4*)(k + c * 8);
        s += q[c * 8 + 0] * __uint_as_float(w.x << 16) + q[c * 8 + 1] * __uint_as_float(w.x & 0xffff0000u) + q[c * 8 + 2] * __uint_as_float(w.y << 16) + q[c * 8 + 3] * __uint_as_float(w.y & 0xffff0000u)
           + q[c * 8 + 4] * __uint_as_float(w.z << 16) + q[c * 8 + 5] * __uint_as_float(w.z & 0xffff0000u) + q[c * 8 + 6] * __uint_as_float(w.w << 16) + q[c * 8 + 7] * __uint_as_float(w.w & 0xffff0000u); }
    return s;
}
__device__ __forceinline__ void nsa_naive(const Args& a, unsigned char* lds, bf16_t* dst, int ldd) {
    const int tid = threadIdx.x;
    unsigned char* ws = a.ws; const bf16_t* P = (const bf16_t*)(ws + WS_P);
    const bf16_t* KCb = (const bf16_t*)(ws + WS_KCB); const bf16_t* VCb = (const bf16_t*)(ws + WS_VCB); const float* gates = (const float*)(ws + WS_GATES);
    unsigned* selmask = (unsigned*)(ws + WS_SELMASK);
    float* qn = (float*)lds; float* sc = qn + 512; int* keypos = (int*)(sc + 2048); float* imp = (float*)(keypos + 512); unsigned* smask = (unsigned*)(imp + 32);
    for (int item = blockIdx.x; item < T * 2; item += gridDim.x) {
        const int g = item & 1, tok = item >> 1, b = tok >> 11, t = tok & (SEQ - 1);
        const int h = tid >> 7, d = tid & 127;
        __syncthreads();
        qn[tid] = bf2f(P[(size_t)tok * PW + PC_Q + (g * 4 + h) * 128 + d]) * QK_SCALE;
        __syncthreads();
        const int nvc = t >= 31 ? min(NCMP, (t - 31) / 16 + 1) : 0;
        { const int n = tid & 127; float s = -1e30f;
          if (n < nvc) { const bf16_t* kr = KCb + ((size_t)(b * 2 + g) * 128 + n) * 128; const float* q = qn + h * 128; s = 0.f; for (int k = 0; k < 128; ++k) s += q[k] * bf2f(kr[k]); }
          sc[h * 512 + n] = s; }
        __syncthreads();
        softmax_rows(sc, 128, tid);
        __syncthreads();
        float ocmp = 0.f;
        for (int n = 0; n < nvc; ++n) ocmp += sc[h * 512 + n] * bf2f(VCb[((size_t)(b * 2 + g) * 128 + n) * 128 + d]);
        if (tid < 32) { float s = 0.f; const int j = tid;
            for (int n = max(0, 4 * j - 1); n <= min(NCMP - 1, 4 * j + 3); ++n) s += sc[n] + sc[512 + n] + sc[1024 + n] + sc[1536 + n];
            imp[j] = s; }
        __syncthreads();
        if (tid == 0) { const int cur = t >> 6; unsigned m = 0u;
            for (int k = 0; k < NSEL; ++k) { int best = -1; float bs = 0.f;
                for (int j = 0; j < NSBLK; ++j) { if ((m >> j) & 1u) continue;
                    const bool valid = j <= cur, forced = (j == 0) || (j == cur) || (j == cur - 1);
                    const float s = valid ? (forced ? 1e6f : imp[j]) : -INFINITY;
                    if (best < 0 || s > bs) { best = j; bs = s; } }
                m |= 1u << best; }
            *smask = m; selmask[tok * 2 + g] = m; }
        __syncthreads();
        { const unsigned m = *smask; const int k = tid >> 6, i = tid & 63; int cntb = 0, jk = 0;
          for (int j = 0; j < NSBLK; ++j) if ((m >> j) & 1u) { if (cntb == k) jk = j; ++cntb; }
          const int kp = 64 * jk + i; keypos[tid] = kp <= t ? kp : -1; }
        __syncthreads();
        for (int hh = 0; hh < 4; ++hh) { const int kp = keypos[tid];
            sc[hh * 512 + tid] = kp >= 0 ? dot_q_kbf16(qn + hh * 128, P + (size_t)(b * SEQ + kp) * PW + PC_KSLC + g * 128) : -1e30f; }
        __syncthreads();
        softmax_rows(sc, 512, tid);
        __syncthreads();
        float oslc = 0.f;
        for (int sidx = 0; sidx < 512; ++sidx) { const int kp = keypos[sidx]; if (kp >= 0) oslc += sc[h * 512 + sidx] * bf2f(P[(size_t)(b * SEQ + kp) * PW + PC_VSLC + g * 128 + d]); }
        __syncthreads();
        { const int kp = t - tid; keypos[tid] = kp >= 0 ? kp : -1; }
        __syncthreads();
        for (int hh = 0; hh < 4; ++hh) { const int kp = keypos[tid];
            sc[hh * 512 + tid] = kp >= 0 ? dot_q_kbf16(qn + hh * 128, P + (size_t)(b * SEQ + kp) * PW + PC_KWIN + g * 128) : -1e30f; }
        __syncthreads();
        softmax_rows(sc, 512, tid);
        __syncthreads();
        float owin = 0.f;
        for (int sidx = 0; sidx < 512; ++sidx) { const int kp = keypos[sidx]; if (kp >= 0) owin += sc[h * 512 + sidx] * bf2f(P[(size_t)(b * SEQ + kp) * PW + PC_VWIN + g * 128 + d]); }
        const float* gp = gates + (size_t)tok * 24 + g * 12 + h * 3;
        const float o = ocmp * sigmoid_f(gp[0]) + oslc * sigmoid_f(gp[1]) + owin * sigmoid_f(gp[2]);
        dst[(size_t)tok * ldd + (g * 4 + h) * 128 + d] = f2bf(o);
    }
}

__device__ __forceinline__ void ret_naive(const Args& a, unsigned char* lds, bf16_t* dst, int ldd, int coff) {
    const int tid = threadIdx.x, lane = tid & 63, wave = tid >> 6;
    unsigned char* ws = a.ws; const bf16_t* P = (const bf16_t*)(ws + WS_P);
    const float* gng = a.in[I_GNG]; const float* gnb = a.in[I_GNB];
    float* qf = (float*)lds; float* kf = qf + 32 * 128; float* sm = kf + 128 * 129; float* ob = kf;
    for (int item = blockIdx.x; item < BATCH * RET_H * (SEQ / 32); item += gridDim.x) {
        const int nt = item & 63, h = (item >> 6) & 7, b = item >> 9, n0 = nt * 32;
        const float lg = log1pf(-exp2f(-5.f - (float)h));
        __syncthreads();
        for (int i = tid; i < 32 * 128; i += NTHREADS) { const int n = i >> 7, d = i & 127; qf[i] = bf2f(P[(size_t)(b * SEQ + n0 + n) * PW + PC_RQ + h * 128 + d]); }
        float o[8];
#pragma unroll
        for (int i = 0; i < 8; ++i) o[i] = 0.f;
        const int e = tid & 127, ng = tid >> 7;
        for (int m0 = 0; m0 <= n0 + 31; m0 += 128) {
            __syncthreads();
            for (int i = tid; i < 128 * 128; i += NTHREADS) { const int mm = i >> 7, d = i & 127; kf[mm * 129 + d] = bf2f(P[(size_t)(b * SEQ + m0 + mm) * PW + PC_RK + h * 128 + d]); }
            __syncthreads();
            { const int mm = tid & 127;
#pragma unroll
              for (int i = 0; i < 8; ++i) { const int n = ng * 8 + i; const int dist = (n0 + n) - (m0 + mm); float s = 0.f;
                  if (dist >= 0) { const float* q = qf + n * 128; const float* k = kf + mm * 129; for (int dd = 0; dd < 128; ++dd) s += q[dd] * k[dd]; s *= __expf(lg * 128.f * (float)(((n0 + n) >> 7) - ((m0 + mm) >> 7))); }
                  sm[n * 128 + mm] = s; } }
            __syncthreads();
            const int mmax = min(128, n0 + 32 - m0);
            for (int mm = 0; mm < mmax; ++mm) { const float v = bf2f(P[(size_t)(b * SEQ + m0 + mm) * PW + PC_RV + h * 128 + e]);
#pragma unroll
                for (int i = 0; i < 8; ++i) o[i] += sm[(ng * 8 + i) * 128 + mm] * v; }
        }
        __syncthreads();
#pragma unroll
        for (int i = 0; i < 8; ++i) ob[(ng * 8 + i) * 128 + e] = o[i];
        __syncthreads();
        for (int rr = 0; rr < 4; ++rr) { const int n = wave * 4 + rr; const float v0 = ob[n * 128 + lane], v1 = ob[n * 128 + 64 + lane];
            const float mu = wave_sum(v0 + v1) * (1.f / 128.f); const float d0 = v0 - mu, d1 = v1 - mu;
            const float var = wave_sum(d0 * d0 + d1 * d1) * (1.f / 128.f), r = rsqrtf(var + GN_EPS);
            const size_t tok = (size_t)(b * SEQ + n0 + n);
            const float g0 = bf2f(P[tok * PW + PC_RG + h * 128 + lane]), g1 = bf2f(P[tok * PW + PC_RG + h * 128 + 64 + lane]);
            const float y0 = d0 * r * gng[h * 128 + lane] + gnb[h * 128 + lane], y1 = d1 * r * gng[h * 128 + 64 + lane] + gnb[h * 128 + 64 + lane];
            dst[tok * ldd + coff + h * 128 + lane] = f2bf(silu_f(g0) * y0); dst[tok * ldd + coff + h * 128 + 64 + lane] = f2bf(silu_f(g1) * y1); }
    }
}

__device__ __forceinline__ void p7_route(const Args& a, unsigned char* lds) {
    const int tid = threadIdx.x, lane = tid & 63, wave = tid >> 6;
    unsigned char* ws = a.ws; const float* x1 = a.out; bf16_t* h2 = (bf16_t*)(ws + WS_H2);
    const float* g2 = a.in[I_N2G]; const float* wrg = a.in[I_WRG]; const float* brg = a.in[I_BRG]; const float* wre = a.in[I_WRE]; const float* bre = a.in[I_BRE];
    unsigned* cnt = (unsigned*)(ws + WS_CNT); int* ltok = (int*)(ws + WS_LTOK); float* lw = (float*)(ws + WS_LW);
    for (int tok = blockIdx.x * 8 + wave; tok < T; tok += gridDim.x * 8) {
        const float* xr = x1 + (size_t)tok * DM; float ss = 0.f;
#pragma unroll
        for (int i = 0; i < 8; ++i) { const f32x4 v = *(const f32x4*)(xr + i * 256 + lane * 4); ss += v[0] * v[0] + v[1] * v[1] + v[2] * v[2] + v[3] * v[3]; }
        ss = wave_sum(ss); const float rs = rsqrtf(ss * (1.f / DM) + RMS_EPS);
        float lg[4], le[32];
#pragma unroll
        for (int j = 0; j < 4; ++j) lg[j] = 0.f;
#pragma unroll
        for (int j = 0; j < 32; ++j) le[j] = 0.f;
#pragma unroll 1
        for (int i = 0; i < 8; ++i) { const int d0 = i * 256 + lane * 4; const f32x4 gg = *(const f32x4*)(g2 + d0); const f32x4 v = *(const f32x4*)(xr + d0) * rs * gg;
            u32x2 w; w.x = pk2(v[0], v[1]); w.y = pk2(v[2], v[3]); *(u32x2*)(h2 + (size_t)tok * DM + d0) = w;
#pragma unroll
            for (int c = 0; c < 4; ++c) { const float hv = v[c]; const f32x4 wg = *(const f32x4*)(wrg + (size_t)(d0 + c) * 4);
                lg[0] += hv * wg[0]; lg[1] += hv * wg[1]; lg[2] += hv * wg[2]; lg[3] += hv * wg[3];
#pragma unroll
                for (int j4 = 0; j4 < 8; ++j4) { const f32x4 we = *(const f32x4*)(wre + (size_t)(d0 + c) * 32 + j4 * 4);
                    le[j4 * 4 + 0] += hv * we[0]; le[j4 * 4 + 1] += hv * we[1]; le[j4 * 4 + 2] += hv * we[2]; le[j4 * 4 + 3] += hv * we[3]; } } }
#pragma unroll
        for (int j = 0; j < 4; ++j) lg[j] = wave_sum(lg[j]) + brg[j];
#pragma unroll
        for (int j = 0; j < 32; ++j) le[j] = wave_sum(le[j]);
        int gi = 0; float gm = lg[0];
#pragma unroll
        for (int j = 1; j < 4; ++j) if (lg[j] > gm) { gm = lg[j]; gi = j; }
        float gs = 0.f;
#pragma unroll
        for (int j = 0; j < 4; ++j) gs += __expf(lg[j] - gm);
        const float gtop = 1.f / gs;
        float mine = 0.f;
#pragma unroll
        for (int j = 0; j < 32; ++j) mine = (lane == j) ? le[j] : mine;
        if (lane < 32) mine += bre[lane];
        float ls[8];
#pragma unroll
        for (int j = 0; j < 8; ++j) ls[j] = __shfl(mine, gi * 8 + j);
        int e0 = 0; float m0 = ls[0];
#pragma unroll
        for (int j = 1; j < 8; ++j) if (ls[j] > m0) { m0 = ls[j]; e0 = j; }
        int e1 = -1; float m1 = -INFINITY;
#pragma unroll
        for (int j = 0; j < 8; ++j) if (j != e0 && (e1 < 0 || ls[j] > m1)) { m1 = ls[j]; e1 = j; }
        const float p1 = __expf(m1 - m0); const float w0 = gtop / (1.f + p1), w1 = gtop * p1 / (1.f + p1);
        if (lane == 0) {
            const int ea = gi * 8 + e0, eb = gi * 8 + e1;
            const unsigned pa = atomicAdd(cnt + ea, 1u); ltok[ea * T + pa] = tok * 2 + 0; lw[ea * T + pa] = w0;
            const unsigned pb = atomicAdd(cnt + eb, 1u); ltok[eb * T + pb] = tok * 2 + 1; lw[eb * T + pb] = w1;
        }
    }
}

__device__ __forceinline__ void p8_gather(const Args& a, unsigned char* lds) {
    const int tid = threadIdx.x, lane = tid & 63, wave = tid >> 6;
    unsigned char* ws = a.ws; const bf16_t* h2 = (const bf16_t*)(ws + WS_H2); bf16_t* xg = (bf16_t*)(ws + WS_XG);
    const int* ltok = (const int*)(ws + WS_LTOK);
    MoeTab tab = moe_tab(lds); const int ntiles = moe_build_tab(tab, (const unsigned*)(ws + WS_CNT));
    for (int r = blockIdx.x * 8 + wave; r < ntiles * 256; r += gridDim.x * 8) {
        const int tile = r >> 8, e = tab.tile_e[tile], li = tab.tile_i[tile] * 256 + (r & 255);
        u32x4 v0 = {0u, 0u, 0u, 0u}, v1 = v0, v2 = v0, v3 = v0;
        if (li < tab.cnt[e]) { const int tok = ltok[e * T + li] >> 1; const u32x4* s = (const u32x4*)(h2 + (size_t)tok * DM);
            v0 = s[lane]; v1 = s[64 + lane]; v2 = s[128 + lane]; v3 = s[192 + lane]; }
        u32x4* dp = (u32x4*)(xg + (size_t)r * DM); dp[lane] = v0; dp[64 + lane] = v1; dp[128 + lane] = v2; dp[192 + lane] = v3;
    }
}

__device__ __forceinline__ void p11_final(const Args& a) {
    const bf16_t* y = (const bf16_t*)(a.ws + WS_Y); float* out = a.out;
    const size_t n8 = (size_t)T * DM / 8;
    for (size_t i = (size_t)blockIdx.x * NTHREADS + threadIdx.x; i < n8; i += (size_t)gridDim.x * NTHREADS) {
        const u32x4 a0 = *(const u32x4*)(y + i * 8), a1 = *(const u32x4*)(y + (size_t)T * DM + i * 8);
        f32x4 o0 = *(f32x4*)(out + i * 8), o1 = *(f32x4*)(out + i * 8 + 4);
        o0[0] += __uint_as_float(a0.x << 16) + __uint_as_float(a1.x << 16); o0[1] += __uint_as_float(a0.x & 0xffff0000u) + __uint_as_float(a1.x & 0xffff0000u);
        o0[2] += __uint_as_float(a0.y << 16) + __uint_as_float(a1.y << 16); o0[3] += __uint_as_float(a0.y & 0xffff0000u) + __uint_as_float(a1.y & 0xffff0000u);
        o1[0] += __uint_as_float(a0.z << 16) + __uint_as_float(a1.z << 16); o1[1] += __uint_as_float(a0.z & 0xffff0000u) + __uint_as_float(a1.z & 0xffff0000u);
        o1[2] += __uint_as_float(a0.w << 16) + __uint_as_float(a1.w << 16); o1[3] += __uint_as_float(a0.w & 0xffff0000u) + __uint_as_float(a1.w & 0xffff0000u);
#ifdef DBG_COMPARE
        { const float* dbg = (const float*)(a.ws + WS_DBG); const float sc_ = 1.f + 3.f * sqrtf(dbg[0] / fmaxf(dbg[1], 1e-30f)); o0 = o0 * sc_; o1 = o1 * sc_; }
#endif
        *(f32x4*)(out + i * 8) = o0; *(f32x4*)(out + i * 8 + 4) = o1;
    }
}

__device__ __forceinline__ void dbg_compare(const Args& a, const bf16_t* X, const bf16_t* R, int ldr, int c0, int c1, int rc0) {
    float se = 0.f, sr = 0.f; const int w = c1 - c0;
    for (size_t i = (size_t)blockIdx.x * NTHREADS + threadIdx.x; i < (size_t)T * w; i += (size_t)gridDim.x * NTHREADS) {
        const size_t row = i / w; const int col = c0 + (int)(i % w); const float x = bf2f(X[row * DM + col]), r = bf2f(R[row * ldr + (col - c0 + rc0)]);
        se += (x - r) * (x - r); sr += r * r; }
    se = wave_sum(se); sr = wave_sum(sr);
    if ((threadIdx.x & 63) == 0) { atomicAdd((float*)(a.ws + WS_DBG), se); atomicAdd((float*)(a.ws + WS_DBG) + 1, sr); }
}

typedef short s16x4 __attribute__((ext_vector_type(4)));
#define KSWZ(row, colB) ((row) * 256 + ((colB) ^ (((row) & 7) << 4)))
#define SBAR() __builtin_amdgcn_sched_barrier(0)
__device__ __forceinline__ int crow(int r, int hi) { return (r & 3) + 8 * (r >> 2) + 4 * hi; }
__device__ __forceinline__ unsigned cvtpk(float lo, float hi) { unsigned r; asm volatile("v_cvt_pk_bf16_f32 %0, %1, %2" : "=v"(r) : "v"(lo), "v"(hi)); return r; }
constexpr float SM_C = QK_SCALE * 1.4426950408889634f;
constexpr float THR_RAW = 8.f / QK_SCALE;
constexpr float M_INIT = -1.0e4f;

__device__ __forceinline__ void qkt(f32x16& p0, f32x16& p1, const unsigned char* Ks, const bf16x8* qr, int r32, int hi, float iv, bool ranged, int lo, int hb) {
    if (ranged) {
        const int A = 4 * hi - lo, B = hb - 4 * hi; const unsigned ivb = __float_as_uint(iv), ngb = __float_as_uint(-1e30f);
#pragma unroll
        for (int r = 0; r < 16; ++r) { const int kr = (r & 3) + 8 * (r >> 2);
            const unsigned n0 = (unsigned)(((kr + A) | (B - kr)) >> 31), n1 = (unsigned)(((kr + 32 + A) | (B - kr - 32)) >> 31);
            p0[r] = __uint_as_float((n0 & ngb) | (~n0 & ivb)); p1[r] = __uint_as_float((n1 & ngb) | (~n1 & ivb)); }
    } else {
#pragma unroll
        for (int r = 0; r < 16; ++r) { p0[r] = iv; p1[r] = iv; }
    }
#pragma unroll
    for (int d0 = 0; d0 < 8; ++d0) { const int cb = (d0 * 16 + hi * 8) * 2;
        const bf16x8 b0 = *reinterpret_cast<const bf16x8*>(Ks + KSWZ(r32, cb));
        const bf16x8 b1 = *reinterpret_cast<const bf16x8*>(Ks + KSWZ(32 + r32, cb));
        p0 = __builtin_amdgcn_mfma_f32_32x32x16_bf16(b0, qr[d0], p0, 0, 0, 0);
        p1 = __builtin_amdgcn_mfma_f32_32x32x16_bf16(b1, qr[d0], p1, 0, 0, 0); }
}
__device__ __forceinline__ int v_st(int k, int c) { const int kk = (k & ~0xC) | ((k & 4) << 1) | ((k & 8) >> 1); return ((kk >> 3) * 4 + (c >> 5)) * 512 + ((kk & 7) * 32 + (c & 31)) * 2; }
__device__ __forceinline__ int v_rd_base(int lane) { return ((lane & 3) << 3) | (((lane >> 2) & 3) << 6) | (((lane >> 4) & 1) << 5) | (((lane >> 5) & 1) << 8); }
constexpr int v_rd_off(int d0, int ks, int half) { return d0 * 512 + ks * 4096 + half * 2048; }
template <int OFF> __device__ __forceinline__ s16x4 tr_read(int vb) {
    s16x4 r; asm volatile("ds_read_b64_tr_b16 %0, %1 offset:%2" : "=&v"(r) : "v"(vb), "i"(OFF) : "memory"); return r;
}
template <int D0> __device__ __forceinline__ void pv_one(f32x16& od, int vb, bf16x8 pa0, bf16x8 pa1, bf16x8 pa2, bf16x8 pa3) {
    const s16x4 l0 = tr_read<v_rd_off(D0, 0, 0)>(vb), h0 = tr_read<v_rd_off(D0, 0, 1)>(vb), l1 = tr_read<v_rd_off(D0, 1, 0)>(vb), h1 = tr_read<v_rd_off(D0, 1, 1)>(vb);
    const s16x4 l2 = tr_read<v_rd_off(D0, 2, 0)>(vb), h2 = tr_read<v_rd_off(D0, 2, 1)>(vb), l3 = tr_read<v_rd_off(D0, 3, 0)>(vb), h3 = tr_read<v_rd_off(D0, 3, 1)>(vb);
    asm volatile("s_waitcnt lgkmcnt(0)" ::: "memory"); SBAR();
#define PKV(L, H) (bf16x8){L[0], L[1], L[2], L[3], H[0], H[1], H[2], H[3]}
    od = __builtin_amdgcn_mfma_f32_32x32x16_bf16(pa0, PKV(l0, h0), od, 0, 0, 0);
    od = __builtin_amdgcn_mfma_f32_32x32x16_bf16(pa1, PKV(l1, h1), od, 0, 0, 0);
    od = __builtin_amdgcn_mfma_f32_32x32x16_bf16(pa2, PKV(l2, h2), od, 0, 0, 0);
    od = __builtin_amdgcn_mfma_f32_32x32x16_bf16(pa3, PKV(l3, h3), od, 0, 0, 0);
#undef PKV
}
__device__ __forceinline__ void pv_d0(f32x16* o, int vb, bf16x8 pa0, bf16x8 pa1, bf16x8 pa2, bf16x8 pa3) {
    pv_one<0>(o[0], vb, pa0, pa1, pa2, pa3); pv_one<1>(o[1], vb, pa0, pa1, pa2, pa3); pv_one<2>(o[2], vb, pa0, pa1, pa2, pa3); pv_one<3>(o[3], vb, pa0, pa1, pa2, pa3);
}
__device__ __forceinline__ void pack_p(const f32x16& p0, const f32x16& p1, bf16x8& pa0, bf16x8& pa1, bf16x8& pa2, bf16x8& pa3) {
#define PK4(P, BASE, OUT) do { unsigned a0 = cvtpk(P[BASE + 0], P[BASE + 1]), a1 = cvtpk(P[BASE + 2], P[BASE + 3]);   \
    unsigned b0 = cvtpk(P[BASE + 4], P[BASE + 5]), b1 = cvtpk(P[BASE + 6], P[BASE + 7]);                              \
    auto r0 = __builtin_amdgcn_permlane32_swap(a0, b0, false, false); auto r1 = __builtin_amdgcn_permlane32_swap(a1, b1, false, false); \
    u32x4 w = {r0[0], r1[0], r0[1], r1[1]}; OUT = *reinterpret_cast<bf16x8*>(&w); } while (0)
    PK4(p0, 0, pa0); PK4(p0, 8, pa1); PK4(p1, 0, pa2); PK4(p1, 8, pa3);
#undef PK4
}
__device__ __forceinline__ float xhalf_max(float v) { auto rr = __builtin_amdgcn_permlane32_swap(__float_as_uint(v), __float_as_uint(v), false, false); return fmaxf(__uint_as_float(rr[0]), __uint_as_float(rr[1])); }
__device__ __forceinline__ float xhalf_sum(float v) { auto rr = __builtin_amdgcn_permlane32_swap(__float_as_uint(v), __float_as_uint(v), false, false); return __uint_as_float(rr[0]) + __uint_as_float(rr[1]); }
__device__ __forceinline__ float xhalf_other(float v) { return __shfl_xor(v, 32); }
__device__ __forceinline__ void mask_range(f32x16& p0, f32x16& p1, int lo, int hb, int hi) {
#pragma unroll
    for (int r = 0; r < 16; ++r) { const int k0 = crow(r, hi), k1 = 32 + k0;
        p0[r] = (k0 >= lo && k0 <= hb) ? p0[r] : -1e30f; p1[r] = (k1 >= lo && k1 <= hb) ? p1[r] : -1e30f; }
}
__device__ __forceinline__ float sm_step(f32x16& p0, f32x16& p1, float& m_reg) {
    float pmax = p0[0];
#pragma unroll
    for (int r = 1; r < 16; ++r) pmax = fmaxf(pmax, p0[r]);
#pragma unroll
    for (int r = 0; r < 16; ++r) pmax = fmaxf(pmax, p1[r]);
    pmax = xhalf_max(pmax);
    float alpha = 1.f;
    if (!__all(pmax - m_reg <= THR_RAW)) { const float mn = fmaxf(m_reg, pmax); alpha = __builtin_amdgcn_exp2f((m_reg - mn) * SM_C); m_reg = mn; }
    const float mnC = -m_reg * SM_C;
#pragma unroll
    for (int r = 0; r < 16; ++r) { p0[r] = __builtin_amdgcn_exp2f(fmaf(p0[r], SM_C, mnC)); p1[r] = __builtin_amdgcn_exp2f(fmaf(p1[r], SM_C, mnC)); }
    return alpha;
}
__device__ __forceinline__ float row_sum32(const f32x16& p0, const f32x16& p1) {
    float ps = 0.f;
#pragma unroll
    for (int r = 0; r < 16; ++r) ps += p0[r];
#pragma unroll
    for (int r = 0; r < 16; ++r) ps += p1[r];
    return xhalf_sum(ps);
}

constexpr int NL_K = 0, NL_V = 32768, NL_WS = 65536, NL_SLAB = 67584, NL_SC = NL_SLAB + 32768, NL_SMASK = NL_SC + 8192;

__device__ __forceinline__ void stage_glds(const bf16_t* Kp, const bf16_t* Vp, int ld, unsigned char* Kb, unsigned char* Vb, int wid, int lane) {
#pragma unroll
    for (int i = 0; i < 2; ++i) { const int piece = wid * 2 + i;
        { const int R = piece * 4 + (lane >> 4), cs = (lane & 15) ^ (R & 7);
          __builtin_amdgcn_global_load_lds((const unsigned*)(Kp + (size_t)R * ld + cs * 8), (LAS unsigned*)(Kb + piece * 1024), 16, 0, 0); }
        { const int sub = piece * 2 + (lane >> 5), kk = (sub >> 2) * 8 + ((lane & 31) >> 2), k = (kk & ~0xC) | ((kk & 4) << 1) | ((kk & 8) >> 1), cc = (sub & 3) * 32 + 8 * (lane & 3);
          __builtin_amdgcn_global_load_lds((const unsigned*)(Vp + (size_t)k * ld + cc), (LAS unsigned*)(Vb + piece * 1024), 16, 0, 0); } }
}

__device__ __forceinline__ void nsa_task(const Args& a, unsigned char* lds, int b, int g, int c, bf16_t* dst) {
    unsigned char* ws = a.ws; const bf16_t* P = (const bf16_t*)(ws + WS_P);
    const bf16_t* KCb = (const bf16_t*)(ws + WS_KCB) + (size_t)(b * 2 + g) * 128 * 128; const bf16_t* VCb = (const bf16_t*)(ws + WS_VCB) + (size_t)(b * 2 + g) * 128 * 128;
    const float* gates = (const float*)(ws + WS_GATES);
    int tid = threadIdx.x; asm volatile("" : "+v"(tid));
    const int wid = __builtin_amdgcn_readfirstlane(tid >> 6), lane = tid & 63, r32 = lane & 31, hi = lane >> 5;
    const int hh = wid & 3, th = wid >> 2, itok = 32 * th + r32, t = 64 * c + itok;
    const size_t tok0 = (size_t)b * SEQ + 64 * c;
    float* wsc = (float*)(lds + NL_WS) + wid * 64;
    float* slab = (float*)(lds + NL_SLAB); float* scl = (float*)(lds + NL_SC); unsigned* smask = (unsigned*)(lds + NL_SMASK);
    const int vb0 = (int)(uintptr_t)(lds + NL_V) + v_rd_base(lane);
    bf16x8 qr[8];
#define LOAD_Q() do { const bf16_t* Qw = P + (tok0 + itok) * PW + PC_Q + (g * 4 + hh) * 128 + hi * 8; \
      _Pragma("unroll") for (int d0 = 0; d0 < 8; ++d0) qr[d0] = *(const bf16x8*)(Qw + d0 * 16); } while (0)
    LOAD_Q();
    const float* gp = gates + (tok0 + itok) * 24 + g * 12 + hh * 3;
    f32x16 o[4];
#pragma unroll
    for (int d = 0; d < 4; ++d) o[d] = f32x16{};
    f32x4* fsc = (f32x4*)((float*)(ws + WS_FIN) + (size_t)blockIdx.x * 32768 + wid * 4096 + lane * 64);
    bf16x8 pa0, pa1, pa2, pa3;
    __syncthreads();
#ifndef NO_CMP
    {
        const int ntc = (4 * c + 2 >= 64) ? 2 : 1;
        stage_glds(KCb, VCb, 128, lds + NL_K, lds + NL_V, wid, lane);
        if (ntc == 2) stage_glds(KCb + 64 * 128, VCb + 64 * 128, 128, lds + NL_K + 16384, lds + NL_V + 16384, wid, lane);
        asm volatile("s_waitcnt vmcnt(0)" ::: "memory"); __syncthreads();
        const int nvc = t >= 31 ? min(NCMP, (t - 31) / 16 + 1) : 0;
        float m_c = M_INIT, l_c = 0.f, prevL = 0.f, alphaB = 1.f;
        float* sl = slab + ((size_t)(wid * 32 + r32)) * 32 + hi;
#define IMP_GROUP(PH, q, u) do { const float G_ = (PH[4 * (q)] + PH[4 * (q) + 1]) + (PH[4 * (q) + 2] + PH[4 * (q) + 3]); const float Lp_ = xhalf_other(PH[4 * (q) + 3]); \
            sl[2 * (u)] = G_ + (hi ? Lp_ : prevL); prevL = Lp_; } while (0)
#define CMP_TILE(TT) do { f32x16 p0, p1; qkt(p0, p1, lds + NL_K + (TT) * 16384, qr, r32, hi, 0.f, true, 0, nvc - 1 - 64 * (TT)); \
            float pmax = p0[0]; _Pragma("unroll") for (int r = 1; r < 16; ++r) pmax = fmaxf(pmax, p0[r]); _Pragma("unroll") for (int r = 0; r < 16; ++r) pmax = fmaxf(pmax, p1[r]); \
            pmax = xhalf_max(pmax); const float mn = fmaxf(m_c, pmax); const float alpha = __builtin_amdgcn_exp2f((m_c - mn) * SM_C); m_c = mn; const float mnC = -mn * SM_C; \
            _Pragma("unroll") for (int r = 0; r < 16; ++r) { p0[r] = __builtin_amdgcn_exp2f(fmaf(p0[r], SM_C, mnC)); p1[r] = __builtin_amdgcn_exp2f(fmaf(p1[r], SM_C, mnC)); } \
            l_c = l_c * alpha + row_sum32(p0, p1); \
            if ((TT) == 1) { alphaB = alpha; prevL *= alpha; if (hi == 0) wsc[32 + r32] = alpha; asm volatile("s_waitcnt lgkmcnt(0)" ::: "memory"); \
                _Pragma("unroll") for (int r = 0; r < 16; ++r) { const float al = wsc[32 + crow(r, hi)]; _Pragma("unroll") for (int d = 0; d < 4; ++d) o[d][r] *= al; } } \
            IMP_GROUP(p0, 0, 8 * (TT) + 0); IMP_GROUP(p0, 1, 8 * (TT) + 1); IMP_GROUP(p0, 2, 8 * (TT) + 2); IMP_GROUP(p0, 3, 8 * (TT) + 3); \
            IMP_GROUP(p1, 0, 8 * (TT) + 4); IMP_GROUP(p1, 1, 8 * (TT) + 5); IMP_GROUP(p1, 2, 8 * (TT) + 6); IMP_GROUP(p1, 3, 8 * (TT) + 7); \
            pack_p(p0, p1, pa0, pa1, pa2, pa3); pv_d0(o, vb0 + (TT) * 16384, pa0, pa1, pa2, pa3); } while (0)
        CMP_TILE(0);
        if (ntc == 2) CMP_TILE(1);
#undef CMP_TILE
#undef IMP_GROUP
        const float inv = l_c > 0.f ? 1.f / l_c : 0.f;
        { const float fa = inv * alphaB;
#pragma unroll
          for (int u = 0; u < 8; ++u) sl[2 * u] *= fa;
          if (ntc == 2) {
#pragma unroll
              for (int u = 8; u < 16; ++u) sl[2 * u] *= inv; }
          else {
#pragma unroll
              for (int u = 8; u < 16; ++u) sl[2 * u] = 0.f; } }
        const float gcoef = sigmoid_f(gp[0]) * inv;
        if (hi == 0) wsc[r32] = gcoef;
        asm volatile("s_waitcnt lgkmcnt(0)" ::: "memory");
        { float cf[16];
#pragma unroll
          for (int r = 0; r < 16; ++r) cf[r] = wsc[crow(r, hi)];
#pragma unroll
          for (int d = 0; d < 4; ++d)
#pragma unroll
              for (int q = 0; q < 4; ++q) { f32x4 v; v[0] = o[d][4 * q] * cf[4 * q]; v[1] = o[d][4 * q + 1] * cf[4 * q + 1]; v[2] = o[d][4 * q + 2] * cf[4 * q + 2]; v[3] = o[d][4 * q + 3] * cf[4 * q + 3]; fsc[d * 4 + q] = v; } }
    }
#endif
    __syncthreads();
#ifndef NO_SEL
    {
        const int token = tid >> 3, sub = tid & 7, tth = token >> 5, tr = token & 31;
        f32x4 sum = {0.f, 0.f, 0.f, 0.f};
#pragma unroll
        for (int h4 = 0; h4 < 4; ++h4) sum = sum + *(const f32x4*)(slab + ((size_t)((tth * 4 + h4) * 32 + tr)) * 32 + 4 * sub);
        *(f32x4*)(scl + token * 32 + 4 * sub) = sum;
        __syncthreads();
        const int nf = c == 0 ? 1 : (c == 1 ? 2 : 3), need = NSEL - nf;
        const f32x4 mine = *(const f32x4*)(scl + token * 32 + 4 * sub);
        int rk0 = 0, rk1 = 0, rk2 = 0, rk3 = 0; const int jb = 4 * sub;
#pragma unroll 1
        for (int jj = 1; jj < c - 1; ++jj) {
            const float v = scl[token * 32 + jj];
            rk0 += (v > mine[0] || (v == mine[0] && jj < jb)) ? 1 : 0;     rk1 += (v > mine[1] || (v == mine[1] && jj < jb + 1)) ? 1 : 0;
            rk2 += (v > mine[2] || (v == mine[2] && jj < jb + 2)) ? 1 : 0; rk3 += (v > mine[3] || (v == mine[3] && jj < jb + 3)) ? 1 : 0; }
        unsigned bits = 0u;
#define SEL_BIT(q, rk) do { const int j = jb + (q); const bool valid = j <= c, forced = (j == 0) || (j == c) || (j == c - 1); bits |= (valid && (forced || (rk) < need)) ? (1u << j) : 0u; } while (0)
        SEL_BIT(0, rk0); SEL_BIT(1, rk1); SEL_BIT(2, rk2); SEL_BIT(3, rk3);
#undef SEL_BIT
        bits |= __shfl_xor(bits, 1); bits |= __shfl_xor(bits, 2); bits |= __shfl_xor(bits, 4);
        if (sub == 0) { smask[token] = bits; ((unsigned*)(a.ws + WS_SELMASK2))[(tok0 + token) * 2 + g] = bits; }
    }
#endif
    __syncthreads();
    const unsigned mymask = smask[itok];
    LOAD_Q();
#undef LOAD_Q
#ifndef NO_LOOP
    {
        const int nw = min(c + 1, 9);
        const bf16_t* Pb = P + (size_t)b * SEQ * PW;
#pragma unroll 1
        for (int seg = 0; seg < 2; ++seg) {
            const int nts = seg ? nw : c + 1, j0 = seg ? c - nw + 1 : 0;
            const bf16_t* Kb = Pb + (seg ? PC_KWIN : PC_KSLC) + g * 128; const bf16_t* Vb = Pb + (seg ? PC_VWIN : PC_VSLC) + g * 128;
            float m_reg = M_INIT, l_reg = 0.f;
#pragma unroll
            for (int d = 0; d < 4; ++d) o[d] = f32x16{};
            stage_glds(Kb + (size_t)(64 * j0) * PW, Vb + (size_t)(64 * j0) * PW, PW, lds + NL_K, lds + NL_V, wid, lane);
            asm volatile("s_waitcnt vmcnt(0)" ::: "memory"); __syncthreads();
#pragma unroll 1
            for (int it = 0; it < nts; ++it) {
                const int buf = it & 1, j = j0 + it;
                if (it + 1 < nts) stage_glds(Kb + (size_t)(64 * (j + 1)) * PW, Vb + (size_t)(64 * (j + 1)) * PW, PW, lds + NL_K + (buf ^ 1) * 16384, lds + NL_V + (buf ^ 1) * 16384, wid, lane);
                f32x16 p0, p1;
                { const bool sel = seg ? true : (((mymask >> j) & 1u) != 0u);
                  const bool ranged = (j == c) || (seg && j == c - 8);
                  const int lo = (seg && j == c - 8) ? itok + 1 : 0, hb = (j == c) ? itok : 63;
                  qkt(p0, p1, lds + NL_K + buf * 16384, qr, r32, hi, sel ? 0.f : -1e30f, ranged, lo, hb); }
                const float alpha = sm_step(p0, p1, m_reg);
                { if (hi == 0) wsc[32 + r32] = alpha; asm volatile("s_waitcnt lgkmcnt(0)" ::: "memory");
#pragma unroll
                    for (int r = 0; r < 16; ++r) { const float al = wsc[32 + crow(r, hi)];
#pragma unroll
                        for (int d = 0; d < 4; ++d) o[d][r] *= al; } }
                l_reg = l_reg * alpha + row_sum32(p0, p1);
                pack_p(p0, p1, pa0, pa1, pa2, pa3);
                pv_d0(o, vb0 + buf * 16384, pa0, pa1, pa2, pa3);
                asm volatile("s_waitcnt vmcnt(0)" ::: "memory"); __syncthreads();
            }
            const float cfm = (l_reg > 0.f ? 1.f / l_reg : 0.f) * sigmoid_f(gp[1 + seg]);
            if (hi == 0) wsc[r32] = cfm;
            asm volatile("s_waitcnt lgkmcnt(0)" ::: "memory");
            float cf[16];
#pragma unroll
            for (int r = 0; r < 16; ++r) cf[r] = wsc[crow(r, hi)];
            if (seg == 0) {
#pragma unroll
                for (int d = 0; d < 4; ++d)
#pragma unroll
                    for (int q = 0; q < 4; ++q) { f32x4 v = fsc[d * 4 + q]; v[0] += o[d][4 * q] * cf[4 * q]; v[1] += o[d][4 * q + 1] * cf[4 * q + 1]; v[2] += o[d][4 * q + 2] * cf[4 * q + 2]; v[3] += o[d][4 * q + 3] * cf[4 * q + 3]; fsc[d * 4 + q] = v; }
            } else {
                unsigned char* ost = lds + wid * 8192;
#pragma unroll
                for (int d = 0; d < 4; ++d)
#pragma unroll
                    for (int q = 0; q < 4; ++q) { const f32x4 v = fsc[d * 4 + q];
#pragma unroll
                        for (int jj = 0; jj < 4; ++jj) { const int r = 4 * q + jj; *(bf16_t*)(ost + crow(r, hi) * 256 + (d * 32 + r32) * 2) = f2bf(v[jj] + o[d][r] * cf[r]); } }
                asm volatile("s_waitcnt lgkmcnt(0)" ::: "memory");
                unsigned char* gdst = (unsigned char*)(dst + (tok0 + 32 * th + (lane >> 4)) * DM + (g * 4 + hh) * 128) + (lane & 15) * 16;
#pragma unroll 1
                for (int i = 0; i < 8; ++i) { *(u32x4*)gdst = *(const u32x4*)(ost + (i * 4 + (lane >> 4)) * 256 + (lane & 15) * 16); gdst += 4 * DM * 2; }
            }
        }
    }
#endif
}

__device__ __forceinline__ void nsa_phase(const Args& a, unsigned char* lds, bf16_t* dst) {
    const int G = gridDim.x, k = blockIdx.x;
    for (int i = 0;; ++i) {
        if (i * G >= 512) break;
        const int s = (i & 1) ? (i + 1) * G - 1 - k : i * G + k;
        if (s >= 512) continue;
        const int c = 31 - (s >> 4), bg = s & 15;
        nsa_task(a, lds, bg >> 1, bg & 1, c, dst);
    }
}

constexpr int RL_KROW = 0, RL_KTR = 32768, RL_VTR = 65536, RL_RT = 98304, RL_O = 0;

__device__ __forceinline__ void ret_stage(const bf16_t* Kp, const bf16_t* Vp, unsigned char* lds, int wid, int lane) {
#pragma unroll
    for (int i = 0; i < 4; ++i) { const int piece = wid * 4 + i;
        { const int R = piece * 4 + (lane >> 4), cs = (lane & 15) ^ (R & 7);
          __builtin_amdgcn_global_load_lds((const unsigned*)(Kp + (size_t)R * PW + cs * 8), (LAS unsigned*)(lds + RL_KROW + piece * 1024), 16, 0, 0); }
        { const int tile = piece >> 4, pc = piece & 15, sub = pc * 2 + (lane >> 5), kk = (sub >> 2) * 8 + ((lane & 31) >> 2), k = (kk & ~0xC) | ((kk & 4) << 1) | ((kk & 8) >> 1), cc = (sub & 3) * 32 + 8 * (lane & 3);
          const size_t so = (size_t)(tile * 64 + k) * PW + cc;
          __builtin_amdgcn_global_load_lds((const unsigned*)(Kp + so), (LAS unsigned*)(lds + RL_KTR + piece * 1024), 16, 0, 0);
          __builtin_amdgcn_global_load_lds((const unsigned*)(Vp + so), (LAS unsigned*)(lds + RL_VTR + piece * 1024), 16, 0, 0); } }
}
template <int KS> __device__ __forceinline__ void ret_state_step(f32x16& acc, int kb, int vb) {
    constexpr int OFF = (KS >> 2) * 16384 + (KS & 3) * 4096;
    const s16x4 al = tr_read<OFF>(kb), ah = tr_read<OFF + 2048>(kb), bl = tr_read<OFF>(vb), bh = tr_read<OFF + 2048>(vb);
    asm volatile("s_waitcnt lgkmcnt(0)" ::: "memory"); SBAR();
    acc = __builtin_amdgcn_mfma_f32_32x32x16_bf16((bf16x8){al[0], al[1], al[2], al[3], ah[0], ah[1], ah[2], ah[3]}, (bf16x8){bl[0], bl[1], bl[2], bl[3], bh[0], bh[1], bh[2], bh[3]}, acc, 0, 0, 0);
}
__device__ __forceinline__ void ret_state_tile(f32x16& acc, int kb, int vb) {
    ret_state_step<0>(acc, kb, vb); ret_state_step<1>(acc, kb, vb); ret_state_step<2>(acc, kb, vb); ret_state_step<3>(acc, kb, vb);
    ret_state_step<4>(acc, kb, vb); ret_state_step<5>(acc, kb, vb); ret_state_step<6>(acc, kb, vb); ret_state_step<7>(acc, kb, vb);
}

__device__ __forceinline__ void ret_task(const Args& a, unsigned char* lds, int b, int h, bf16_t* dst) {
    unsigned char* ws = a.ws; const bf16_t* P = (const bf16_t*)(ws + WS_P) + (size_t)b * SEQ * PW;
    const float* gng = a.in[I_GNG] + h * 128; const float* gnb = a.in[I_GNB] + h * 128;
    int tid = threadIdx.x; asm volatile("" : "+v"(tid));
    const int wid = __builtin_amdgcn_readfirstlane(tid >> 6), lane = tid & 63, r32 = lane & 31, hi = lane >> 5;
    const int nb = wid & 3, mh = wid >> 2;
    const float gam = 1.f - exp2f(-5.f - (float)h), lgam = log2f(gam), g127 = exp2f(127.f * lgam);
    const int vbase = v_rd_base(lane);
    f32x16 Racc[2];
    Racc[0] = f32x16{}; Racc[1] = f32x16{};
    __syncthreads();
    for (int i = tid; i < 32768 / 16; i += NTHREADS) *(u32x4*)(lds + RL_RT + i * 16) = (u32x4){0u, 0u, 0u, 0u};
    for (int ch = 0; ch < SEQ / 128; ++ch) {
        const bf16_t* Pc = P + (size_t)(ch * 128) * PW;
        __syncthreads();
        ret_stage(Pc + PC_RK + h * 128, Pc + PC_RV + h * 128, lds, wid, lane);
        bf16x8 qr[8];
        { const bf16_t* Qw = Pc + (size_t)(nb * 32 + r32) * PW + PC_RQ + h * 128 + hi * 8;
#pragma unroll
          for (int d0 = 0; d0 < 8; ++d0) qr[d0] = *(const bf16x8*)(Qw + d0 * 16); }
        asm volatile("s_waitcnt vmcnt(0)" ::: "memory"); __syncthreads();
        f32x16 o[4];
#pragma unroll
        for (int d = 0; d < 4; ++d) o[d] = f32x16{};
#pragma unroll
        for (int d0 = 0; d0 < 4; ++d0)
#pragma unroll
            for (int k4 = 0; k4 < 4; ++k4) { const int ks = 4 * mh + k4; const int cb = (ks * 16 + hi * 8) * 2;
                const bf16x8 bfr = *reinterpret_cast<const bf16x8*>(lds + RL_RT + KSWZ(32 * d0 + r32, cb));
                o[d0] = __builtin_amdgcn_mfma_f32_32x32x16_bf16(qr[ks], bfr, o[d0], 0, 0, 0); }
#pragma unroll
        for (int d = 0; d < 4; ++d)
#pragma unroll
            for (int r = 0; r < 16; ++r) o[d][r] *= gam;
        if (2 * mh <= nb) {
            f32x16 p0 = f32x16{}, p1 = f32x16{};
            const bool two = (2 * mh + 1 <= nb);
#pragma unroll
            for (int d0 = 0; d0 < 8; ++d0) { const int cb = (d0 * 16 + hi * 8) * 2;
                const bf16x8 k0 = *reinterpret_cast<const bf16x8*>(lds + RL_KROW + KSWZ(64 * mh + r32, cb));
                p0 = __builtin_amdgcn_mfma_f32_32x32x16_bf16(k0, qr[d0], p0, 0, 0, 0);
                if (two) { const bf16x8 k1 = *reinterpret_cast<const bf16x8*>(lds + RL_KROW + KSWZ(64 * mh + 32 + r32, cb));
                    p1 = __builtin_amdgcn_mfma_f32_32x32x16_bf16(k1, qr[d0], p1, 0, 0, 0); } }
            if (2 * mh == nb) {
#pragma unroll
                for (int r = 0; r < 16; ++r) { const unsigned keep = ~(unsigned)((r32 - crow(r, hi)) >> 31); p0[r] = __uint_as_float(__float_as_uint(p0[r]) & keep); } }
            if (2 * mh + 1 == nb) {
#pragma unroll
                for (int r = 0; r < 16; ++r) { const unsigned keep = ~(unsigned)((r32 - crow(r, hi)) >> 31); p1[r] = __uint_as_float(__float_as_uint(p1[r]) & keep); } }
            bf16x8 pa0, pa1, pa2, pa3;
            pack_p(p0, p1, pa0, pa1, pa2, pa3);
            pv_d0(o, (int)(uintptr_t)(lds + RL_VTR + mh * 16384) + vbase, pa0, pa1, pa2, pa3);
        }
        { const int dt = wid & 3, et0 = 2 * (wid >> 2);
#pragma unroll
          for (int r = 0; r < 16; ++r) { Racc[0][r] *= gam; Racc[1][r] *= gam; }
          const int kb = (int)(uintptr_t)(lds + RL_KTR) + vbase + dt * 512;
          ret_state_tile(Racc[0], kb, (int)(uintptr_t)(lds + RL_VTR) + vbase + et0 * 512);
          ret_state_tile(Racc[1], kb, (int)(uintptr_t)(lds + RL_VTR) + vbase + (et0 + 1) * 512);
#pragma unroll
          for (int r = 0; r < 16; ++r) { Racc[0][r] *= g127; Racc[1][r] *= g127; } }
        __syncthreads();
        { const int dt = wid & 3, et0 = 2 * (wid >> 2);
#pragma unroll
          for (int t2 = 0; t2 < 2; ++t2)
#pragma unroll
              for (int q = 0; q < 4; ++q) { u32x2 w; w.x = cvtpk(Racc[t2][4 * q], Racc[t2][4 * q + 1]); w.y = cvtpk(Racc[t2][4 * q + 2], Racc[t2][4 * q + 3]);
                  *(u32x2*)(lds + RL_RT + KSWZ(32 * (et0 + t2) + r32, (32 * dt + 8 * q + 4 * hi) * 2)) = w; } }
        float* Ot = (float*)(lds + RL_O);
        if (mh == 0) {
#pragma unroll
            for (int d = 0; d < 4; ++d)
#pragma unroll
                for (int r = 0; r < 16; ++r) Ot[(32 * nb + crow(r, hi)) * 128 + 32 * d + r32] = o[d][r]; }
        __syncthreads();
        if (mh == 1) {
#pragma unroll
            for (int d = 0; d < 4; ++d)
#pragma unroll
                for (int r = 0; r < 16; ++r) Ot[(32 * nb + crow(r, hi)) * 128 + 32 * d + r32] += o[d][r]; }
        __syncthreads();
        { const int row = tid >> 2, sub = tid & 3; const size_t tok = (size_t)b * SEQ + ch * 128 + row;
          f32x4 v[8]; float s1 = 0.f;
#pragma unroll
          for (int i = 0; i < 8; ++i) { v[i] = *(const f32x4*)(Ot + row * 128 + sub * 32 + i * 4); s1 += (v[i][0] + v[i][1]) + (v[i][2] + v[i][3]); }
          s1 += __shfl_xor(s1, 1); s1 += __shfl_xor(s1, 2);
          const float mu = s1 * (1.f / 128.f); float s2 = 0.f;
#pragma unroll
          for (int i = 0; i < 8; ++i) { v[i] = v[i] - mu; s2 += (v[i][0] * v[i][0] + v[i][1] * v[i][1]) + (v[i][2] * v[i][2] + v[i][3] * v[i][3]); }
          s2 += __shfl_xor(s2, 1); s2 += __shfl_xor(s2, 2);
          const float rstd = rsqrtf(s2 * (1.f / 128.f) + GN_EPS);
          const bf16_t* gr = (const bf16_t*)(ws + WS_P) + tok * PW + PC_RG + h * 128 + sub * 32;
          bf16_t* op = dst + tok * DM + 1024 + h * 128 + sub * 32;
#pragma unroll
          for (int i8 = 0; i8 < 4; ++i8) { const u32x4 gw = *(const u32x4*)(gr + i8 * 8); float y[8];
#pragma unroll
              for (int j = 0; j < 8; ++j) { const int e = sub * 32 + i8 * 8 + j; const unsigned wv = j < 2 ? gw.x : (j < 4 ? gw.y : (j < 6 ? gw.z : gw.w));
                  const float gt = (j & 1) ? __uint_as_float(wv & 0xffff0000u) : __uint_as_float(wv << 16);
                  y[j] = silu_f(gt) * (v[i8 * 2 + (j >> 2)][j & 3] * rstd * gng[e] + gnb[e]); }
              u32x4 w; w.x = pk2(y[0], y[1]); w.y = pk2(y[2], y[3]); w.z = pk2(y[4], y[5]); w.w = pk2(y[6], y[7]);
              *(u32x4*)(op + i8 * 8) = w; } }
    }
}

constexpr int NPHASES = 10;
__device__ __forceinline__ void run_phase(int ph, const Args& a, unsigned char* lds) {
    unsigned char* ws = a.ws;
    PG8_LAS unsigned char* l3 = (PG8_LAS unsigned char*)lds;
    const int G = gridDim.x, c = blockIdx.x;
    if (ph == 0) { p0_prepass(a, lds); }
    else if (ph == 1) {
        pg8::Gemm g{(const bf16_t*)(ws + WS_XB), (const bf16_t*)(ws + WS_WIN_T), T, NIN_PAD, DM}; pg8::StaticOrder S; S.init(T, NIN_PAD, G, c);
        EpiInProj E{(bf16_t*)(ws + WS_P), (float*)(ws + WS_GATES), (const float*)(ws + WS_ROWSCALE)};
        pg8::gemm_phase<EpiInProj, pg8::StaticOrder, true, true>(l3, g, S, E);
    }
    else if (ph == 2) { p2_finalize(a, lds); }
    else if (ph == 3) {
        bf16_t* att = (bf16_t*)(ws + WS_ATT);
        { unsigned* qctr = (unsigned*)(ws + WS_CNT) + 64; int* slot = (int*)(lds + LDS_TAB + 8192);
          for (;;) {
              __syncthreads();
              if (threadIdx.x == 0) *slot = (int)atomicAdd(qctr, 1u);
              __syncthreads();
              const int idx = *slot;
              if (idx >= 64 + 512) break;
              if (idx < 64) ret_task(a, lds, idx >> 3, idx & 7, att);
              else { const int s = idx - 64, cc = 31 - (s >> 4), bg = s & 15; nsa_task(a, lds, bg >> 1, bg & 1, cc, att); }
          } }
#if defined(DBG_COMPARE) && DBG_COMPARE == 1
        nsa_naive(a, lds, (bf16_t*)(ws + WS_REF), 1024);
#elif defined(DBG_COMPARE) && DBG_COMPARE == 2
        ret_naive(a, lds, (bf16_t*)(ws + WS_REF), 1024, 0);
#endif
    }
    else if (ph == 4) {
#if defined(DBG_COMPARE) && DBG_COMPARE == 1
        dbg_compare(a, (const bf16_t*)(ws + WS_ATT), (const bf16_t*)(ws + WS_REF), 1024, 0, 1024, 0);
#elif defined(DBG_COMPARE) && DBG_COMPARE == 2
        dbg_compare(a, (const bf16_t*)(ws + WS_ATT), (const bf16_t*)(ws + WS_REF), 1024, 1024, 2048, 0);
#endif
        pg8::Gemm g{(const bf16_t*)(ws + WS_ATT), (const bf16_t*)(ws + WS_WOUT_T), T, DM, DM}; pg8::StaticOrder S; S.init(T, DM, G, c);
        EpiOutProj E{a.in[I_X], a.out};
        pg8::gemm_phase<EpiOutProj, pg8::StaticOrder, true, true>(l3, g, S, E);
    }
    else if (ph == 5) { p7_route(a, lds); }
    else if (ph == 6) { p8_gather(a, lds); }
    else if (ph == 7) {
        MoeTab tab = moe_tab(lds); const int ntiles = moe_build_tab(tab, (const unsigned*)(ws + WS_CNT));
        pg8::Gemm g{(const bf16_t*)(ws + WS_XG), (const bf16_t*)(ws + WS_WGU_T), ntiles * 256, NEXP * 1024, DM}; MoeOrder<4> S{G, c, ntiles, tab.tile_e};
        EpiGateUp E{(bf16_t*)(ws + WS_HB)};
        pg8::gemm_phase<EpiGateUp, MoeOrder<4>, true, true>(l3, g, S, E);
    }
    else if (ph == 8) {
        MoeTab tab = moe_tab(lds); const int ntiles = moe_build_tab(tab, (const unsigned*)(ws + WS_CNT));
        pg8::Gemm g{(const bf16_t*)(ws + WS_HB), (const bf16_t*)(ws + WS_WD_T), ntiles * 256, NEXP * DM, DEXP}; MoeOrder<8> S{G, c, ntiles, tab.tile_e};
        EpiDown E{(bf16_t*)(ws + WS_Y), (const int*)(ws + WS_LTOK), (const float*)(ws + WS_LW), tab.tile_e, tab.tile_i, tab.cnt};
        pg8::gemm_phase<EpiDown, MoeOrder<8>, true, true>(l3, g, S, E);
    }
    else if (ph == 9) { p11_final(a); }
}

template <int PH> __global__ void __launch_bounds__(NTHREADS, 2) mega_one(Args a) {
    extern __shared__ __attribute__((aligned(16))) unsigned char lds[];
    run_phase(PH, a, lds);
}
__global__ void __launch_bounds__(NTHREADS, 2) mega_all(Args a) {
    extern __shared__ __attribute__((aligned(16))) unsigned char lds[];
    cg::grid_group grid = cg::this_grid();
#define MK_PHASE(k) if (a.ph_lo <= (k) && (k) < a.ph_hi) { run_phase((k), a, lds); if ((k) + 1 < a.ph_hi) grid.sync(); }
    MK_PHASE(0) MK_PHASE(1) MK_PHASE(2) MK_PHASE(3) MK_PHASE(4) MK_PHASE(5) MK_PHASE(6) MK_PHASE(7) MK_PHASE(8) MK_PHASE(9)
#undef MK_PHASE
}
typedef void (*kern_t)(Args);
static kern_t phase_kernels[NPHASES] = { mega_one<0>, mega_one<1>, mega_one<2>, mega_one<3>, mega_one<4>, mega_one<5>, mega_one<6>, mega_one<7>, mega_one<8>, mega_one<9> };

#ifndef MK_MULTI
#define MK_MULTI 0
#endif
extern "C" void kernel_launch(void* const* d_in, const int* in_sizes, int n_in, void* d_out, int out_size, void* d_ws, size_t ws_size, hipStream_t stream) {
    static int grid = 0;
    if (grid == 0) {
        if (n_in != 19 || in_sizes[0] != T * DM || out_size != T * DM || ws_size < WS_END) {
            fprintf(stderr, "kernel_launch: shape mismatch n_in %d in0 %d out %d ws %zu (need %zu)\n", n_in, n_in > 0 ? in_sizes[0] : -1, out_size, ws_size, (size_t)WS_END); grid = -1; return; }
        int dev = 0, cus = 0, per_cu = 0;
        if (hipGetDevice(&dev) != hipSuccess || hipDeviceGetAttribute(&cus, hipDeviceAttributeMultiprocessorCount, dev) != hipSuccess) { grid = -1; return; }
        for (int ph = 0; ph < NPHASES; ++ph)
            if (hipFuncSetAttribute((const void*)phase_kernels[ph], hipFuncAttributeMaxDynamicSharedMemorySize, LDS_BYTES) != hipSuccess) { fprintf(stderr, "kernel_launch: hipFuncSetAttribute failed\n"); grid = -1; return; }
        if (hipFuncSetAttribute((const void*)mega_all, hipFuncAttributeMaxDynamicSharedMemorySize, LDS_BYTES) != hipSuccess) { fprintf(stderr, "kernel_launch: hipFuncSetAttribute(mega_all) failed\n"); grid = -1; return; }
        if (hipOccupancyMaxActiveBlocksPerMultiprocessor(&per_cu, (const void*)mega_all, NTHREADS, LDS_BYTES) != hipSuccess || per_cu < 1) { fprintf(stderr, "kernel_launch: occupancy query failed (%d)\n", per_cu); grid = -1; return; }
        grid = cus * per_cu;
        fprintf(stderr, "kernel_launch: cus %d per_cu %d grid %d\n", cus, per_cu, grid);
    }
    if (grid < 0) return;
    Args a{};
    for (int i = 0; i < 19; ++i) a.in[i] = (const float*)d_in[i];
    a.out = (float*)d_out; a.ws = (unsigned char*)d_ws;
#if MK_MULTI
    for (int ph = 0; ph < NPHASES; ++ph) {
        a.ph_lo = ph; a.ph_hi = ph + 1;
        hipLaunchKernelGGL(phase_kernels[ph], dim3(grid), dim3(NTHREADS), LDS_BYTES, stream, a);
    }
#else
    a.ph_lo = 0; a.ph_hi = NPHASES;
    void* kargs[] = {&a};
    hipError_t e = hipLaunchCooperativeKernel((const void*)mega_all, dim3(grid), dim3(NTHREADS), kargs, LDS_BYTES, stream);
    if (e != hipSuccess) fprintf(stderr, "kernel_launch: cooperative launch failed: %s (grid %d)\n", hipGetErrorString(e), grid);
#endif
}
```

```cpp
#include <hip/hip_runtime.h>
#include <hip/hip_cooperative_groups.h>
#include <cstdio>
#include <cstdint>
namespace cg = cooperative_groups;
#define MK_COOP_SYNC0 1

constexpr int BATCH = 8, SEQ = 2048, DM = 2048, T = BATCH * SEQ;
constexpr int NSA_H = 8, NSA_G = 2, NSA_HG = 4, HD = 128;
constexpr int RET_H = 8;
constexpr int CMP_BLOCK = 32, CMP_STRIDE = 16, NCMP = 127, SEL_BLOCK = 64, NSBLK = 32, NSEL = 8, WINDOW = 512;
constexpr int NGROUPS = 4, EPG = 8, NEXP = 32, DEXP = 512;
constexpr int IN_W = 6680;
constexpr int PW = 6656;
constexpr int NIN_PAD = 6912;
constexpr int PC_Q = 0, PC_KCMP = 1024, PC_VCMP = 1280, PC_KSLC = 1536, PC_VSLC = 1792, PC_KWIN = 2048, PC_VWIN = 2304, PC_RQ = 2560, PC_RK = 3584, PC_RV = 4608, PC_RG = 5632;
constexpr float RMS_EPS = 1e-6f, GN_EPS = 1e-5f;
constexpr float QK_SCALE = 0.08838834764831845f;
constexpr int NTHREADS = 512;
constexpr int MAXTILES = 160;

namespace pg8 {
#define PG8_LAS __attribute__((address_space(3)))
typedef unsigned short bf16_t;
typedef short bf16x8 __attribute__((ext_vector_type(8)));
typedef float f32x4 __attribute__((ext_vector_type(4)));
typedef unsigned u32x4 __attribute__((ext_vector_type(4)));
constexpr int BM = 256, BK = 64, HALF = 128, HTB = HALF * BK * 2, STAGE_BYTES = 8 * HTB, NXCD = 8, WGM = 8;

__host__ __device__ __forceinline__ int lds_byte(int r, int c) { const int st = (r >> 4) * 2 + (c >> 5), rr = r & 15, cc = c & 31, ob = rr * 64 + cc * 2; return st * 1024 + (ob ^ (((ob >> 9) & 1) << 5)); }
__host__ __device__ __forceinline__ void stage_rc(int b, int& R, int& C) { const int st = b / 1024, sb = b % 1024, swz = sb ^ (((sb >> 9) & 1) << 5); R = (st >> 1) * 16 + swz / 64; C = (st & 1) * 32 + (swz % 64) / 2; }
__host__ __device__ __forceinline__ int perm32(int rho) { const int n = rho >> 4, i = rho & 15; return 8 * (i >> 2) + 4 * n + (i & 3); }

struct Unit { int pm, pn; };
struct Gemm { const bf16_t* A; const bf16_t* Bt; int M, N, K; };

struct StaticOrder {
    int nM, nN, nwg, G, c;
    __host__ __device__ void init(int M, int N, int G_, int c_) { nM = M / BM; nN = N / BM; nwg = nM * nN; G = G_; c = c_; }
    __host__ __device__ bool next(int i, Unit& u) const {
        const long L = (long)i * G + c; if (L >= nwg) return false;
        int wgid = (int)L; { const int q = nwg / NXCD, r = nwg % NXCD, xcd = wgid % NXCD, off = wgid / NXCD; wgid = (xcd < r ? xcd * (q + 1) : r * (q + 1) + (xcd - r) * q) + off; }
        const int nig = WGM * nN, gid = wgid / nig, fm = gid * WGM, gsz = (nM - fm) < WGM ? (nM - fm) : WGM;
        u.pm = fm + ((wgid % nig) % gsz); u.pn = (wgid % nig) / gsz; return true;
    }
    __device__ __forceinline__ void a_ready(const Unit&) const {}
    __device__ __forceinline__ void done(const Unit&) const {}
};

__device__ __forceinline__ unsigned cvt_pk_bf16(float lo, float hi) { unsigned r; asm volatile("v_cvt_pk_bf16_f32 %0, %1, %2" : "=v"(r) : "v"(lo), "v"(hi)); return r; }

template <class Epi, class Sched, bool ALIGN_EPI = false, bool SP2 = false>
__device__ __forceinline__ void gemm_phase(PG8_LAS unsigned char* lds, const Gemm g, const Sched& S, const Epi& E) {
    const int tid = threadIdx.x, wid = __builtin_amdgcn_readfirstlane(tid >> 6), lane = tid & 63, wr = wid >> 2, wc = wid & 3, fr = lane & 15, fq = lane >> 4;
    const int K = g.K, nt = K / BK;
    unsigned voffA[2], voffB[2];
#pragma unroll
    for (int i = 0; i < 2; ++i) { int R, C; stage_rc(tid * 16 + i * 8192, R, C); const int Rb = Epi::PERM ? ((R & ~31) + perm32(R & 31)) : R;
        voffA[i] = (unsigned)(R * K + C) * 2u; voffB[i] = (unsigned)(Rb * K + C) * 2u; }
    const size_t kstep = (size_t)(BK * 2);
    const size_t hstep = (size_t)HALF * K * 2;
    const size_t tstep = 2 * hstep;
    const unsigned ldsw = (unsigned)wid * 1024u;
    const int aoff = lds_byte(wr * 64 + fr, fq * 8), boff = lds_byte(wc * 32 + fr, fq * 8);
#define PG8_SA(b, h) (((b) * 2 + (h)) * HTB)
#define PG8_SB(b, h) ((4 + (b) * 2 + (h)) * HTB)
#define PG8_STAGE(bufoff, gbase, voff) do { _Pragma("unroll") for (int _i = 0; _i < 2; ++_i) \
        __builtin_amdgcn_global_load_lds((const unsigned*)((const char*)(gbase) + (voff)[_i]), (PG8_LAS unsigned*)(lds + (bufoff) + ldsw + _i * 8192), 16, 0, 0); } while (0)
#define PG8_LDA(dst, b, h) do { _Pragma("unroll") for (int m = 0; m < 4; ++m) _Pragma("unroll") for (int k = 0; k < 2; ++k) dst[m][k] = *(const PG8_LAS bf16x8*)(lds + PG8_SA(b, h) + aoff + m * 2048 + k * 1024); } while (0)
#define PG8_LDB(dst, b, h) do { _Pragma("unroll") for (int n = 0; n < 2; ++n) _Pragma("unroll") for (int k = 0; k < 2; ++k) dst[n][k] = *(const PG8_LAS bf16x8*)(lds + PG8_SB(b, h) + boff + n * 2048 + k * 1024); } while (0)
#define PG8_MMA(ai, bj, At, Bt) do { __builtin_amdgcn_s_setprio(1); _Pragma("unroll") for (int m = 0; m < 4; ++m) _Pragma("unroll") for (int n = 0; n < 2; ++n) _Pragma("unroll") for (int k = 0; k < 2; ++k) \
        acc[ai][bj][m][n] = __builtin_amdgcn_mfma_f32_16x16x32_bf16(Bt[n][k], At[m][k], acc[ai][bj][m][n], 0, 0, 0); __builtin_amdgcn_s_setprio(0); } while (0)
#define PG8_WAIT_V(n) asm volatile("s_waitcnt vmcnt(" #n ")" ::: "memory")
#define PG8_WAIT_L(n) asm volatile("s_waitcnt lgkmcnt(" #n ")" ::: "memory")
#define PG8_BAR __builtin_amdgcn_s_barrier()
#define PG8_SCHED __builtin_amdgcn_sched_barrier(0)
    Unit cur, nxt; int ui = 0;
    if (!S.next(0, cur)) return;
    f32x4 acc[2][2][4][2];
    if constexpr (Epi::HAS_INIT) E.init(acc, cur, wr, wc, fr, fq);
    else {
#pragma unroll
    for (int a = 0; a < 2; ++a)
#pragma unroll
        for (int b = 0; b < 2; ++b)
#pragma unroll
            for (int m = 0; m < 4; ++m)
#pragma unroll
                for (int n = 0; n < 2; ++n) acc[a][b][m][n] = (f32x4){0.f, 0.f, 0.f, 0.f};
    }
    bf16x8 At[4][2], B0[2][2], B1[2][2];
    const char* cA = (const char*)g.A + (size_t)cur.pm * tstep; const char* cB = (const char*)g.Bt + (size_t)cur.pn * tstep;
    S.a_ready(cur);
    if constexpr (SP2) {
        PG8_STAGE(PG8_SB(0, 0), cB, voffB); PG8_STAGE(PG8_SB(0, 1), cB + hstep, voffB); PG8_STAGE(PG8_SA(0, 0), cA, voffA); PG8_STAGE(PG8_SA(0, 1), cA + hstep, voffA);
        if (wr == 1) PG8_BAR;
        PG8_WAIT_V(2); PG8_BAR;
        PG8_STAGE(PG8_SB(1, 0), cB + kstep, voffB); PG8_STAGE(PG8_SA(1, 0), cA + kstep, voffA); PG8_STAGE(PG8_SB(1, 1), cB + hstep + kstep, voffB);
        PG8_WAIT_V(6); PG8_BAR;
    } else {
        PG8_STAGE(PG8_SB(0, 0), cB, voffB); PG8_STAGE(PG8_SA(0, 0), cA, voffA); PG8_STAGE(PG8_SB(0, 1), cB + hstep, voffB); PG8_STAGE(PG8_SA(0, 1), cA + hstep, voffA);
        if (wr == 1) PG8_BAR;
        PG8_WAIT_V(4); PG8_BAR;
        PG8_STAGE(PG8_SB(1, 0), cB + kstep, voffB); PG8_STAGE(PG8_SA(1, 0), cA + kstep, voffA); PG8_STAGE(PG8_SB(1, 1), cB + hstep + kstep, voffB);
        PG8_WAIT_V(6); PG8_BAR;
    }
    for (;;) {
        const bool has_next = S.next(ui + 1, nxt);
        const char* nA = has_next ? (const char*)g.A + (size_t)nxt.pm * tstep : cA; const char* nB = has_next ? (const char*)g.Bt + (size_t)nxt.pn * tstep : cB;
        for (int t = 0; t < nt; t += 2) {
            const bool last = (t == nt - 2);
            const char* a1 = cA + (size_t)(t + 1) * kstep;
            const char* a2 = last ? nA : cA + (size_t)(t + 2) * kstep; const char* b2 = last ? nB : cB + (size_t)(t + 2) * kstep;
            const char* a3 = a2 + kstep; const char* b3 = b2 + kstep;
            if (last && has_next) S.a_ready(nxt);
            if constexpr (SP2) {
            PG8_LDB(B0, 0, 0); PG8_LDB(B1, 0, 1); PG8_SCHED; PG8_LDA(At, 0, 0); PG8_STAGE(PG8_SA(1, 1), a1 + hstep, voffA);
            PG8_WAIT_V(8); PG8_WAIT_L(0); PG8_BAR; PG8_MMA(0, 0, At, B0); PG8_MMA(0, 1, At, B1); PG8_BAR; PG8_SCHED;
            PG8_LDA(At, 0, 1); PG8_STAGE(PG8_SB(0, 0), b2, voffB); PG8_STAGE(PG8_SB(0, 1), b2 + hstep, voffB); PG8_STAGE(PG8_SA(0, 0), a2, voffA);
            PG8_WAIT_V(8); PG8_WAIT_L(0); PG8_BAR; PG8_MMA(1, 0, At, B0); PG8_MMA(1, 1, At, B1); PG8_BAR; PG8_SCHED;
            PG8_LDB(B0, 1, 0); PG8_LDB(B1, 1, 1); PG8_SCHED; PG8_LDA(At, 1, 0); PG8_STAGE(PG8_SA(0, 1), a2 + hstep, voffA);
            PG8_WAIT_V(8); PG8_WAIT_L(0); PG8_BAR; PG8_MMA(0, 0, At, B0); PG8_MMA(0, 1, At, B1); PG8_BAR; PG8_SCHED;
            PG8_LDA(At, 1, 1); PG8_STAGE(PG8_SB(1, 0), b3, voffB); PG8_STAGE(PG8_SB(1, 1), b3 + hstep, voffB); PG8_STAGE(PG8_SA(1, 0), a3, voffA);
            PG8_WAIT_V(8); PG8_WAIT_L(0); PG8_BAR; PG8_MMA(1, 0, At, B0); PG8_MMA(1, 1, At, B1); PG8_BAR; PG8_SCHED;
            } else {
            PG8_LDB(B0, 0, 0); PG8_SCHED; PG8_LDA(At, 0, 0); PG8_STAGE(PG8_SA(1, 1), a1 + hstep, voffA);
            PG8_WAIT_L(8); PG8_BAR; PG8_WAIT_L(0); PG8_MMA(0, 0, At, B0); PG8_BAR; PG8_SCHED;
            PG8_LDB(B1, 0, 1); PG8_STAGE(PG8_SB(0, 0), b2, voffB);
            PG8_BAR; PG8_WAIT_L(0); PG8_MMA(0, 1, At, B1); PG8_BAR;
            PG8_LDA(At, 0, 1); PG8_STAGE(PG8_SA(0, 0), a2, voffA);
            PG8_BAR; PG8_WAIT_L(0); PG8_MMA(1, 0, At, B0); PG8_BAR; PG8_SCHED;
            PG8_STAGE(PG8_SB(0, 1), b2 + hstep, voffB);
            PG8_WAIT_V(6); PG8_BAR; PG8_MMA(1, 1, At, B1); PG8_BAR;
            PG8_LDB(B0, 1, 0); PG8_SCHED; PG8_LDA(At, 1, 0); PG8_STAGE(PG8_SA(0, 1), a2 + hstep, voffA);
            PG8_WAIT_L(8); PG8_BAR; PG8_WAIT_L(0); PG8_MMA(0, 0, At, B0); PG8_BAR; PG8_SCHED;
            PG8_LDB(B1, 1, 1); PG8_STAGE(PG8_SB(1, 0), b3, voffB);
            PG8_BAR; PG8_WAIT_L(0); PG8_MMA(0, 1, At, B1); PG8_BAR;
            PG8_LDA(At, 1, 1); PG8_STAGE(PG8_SA(1, 0), a3, voffA);
            PG8_BAR; PG8_WAIT_L(0); PG8_MMA(1, 0, At, B0); PG8_BAR; PG8_SCHED;
            PG8_STAGE(PG8_SB(1, 1), b3 + hstep, voffB);
            PG8_WAIT_V(6); PG8_BAR; PG8_MMA(1, 1, At, B1); PG8_BAR;
            }
        }
        if constexpr (ALIGN_EPI) { if (wr == 0) PG8_BAR; }
        if constexpr (!Epi::AFTER_DRAIN) { E(acc, cur, wr, wc, fr, fq); S.done(cur); }
        if (!has_next) break;
        if constexpr (Epi::HAS_INIT) E.init(acc, nxt, wr, wc, fr, fq);
        else {
#pragma unroll
        for (int a = 0; a < 2; ++a)
#pragma unroll
            for (int b = 0; b < 2; ++b)
#pragma unroll
                for (int m = 0; m < 4; ++m)
#pragma unroll
                    for (int n = 0; n < 2; ++n) acc[a][b][m][n] = (f32x4){0.f, 0.f, 0.f, 0.f};
        }
        cur = nxt; cA = nA; cB = nB; ++ui;
        if constexpr (ALIGN_EPI) { if (wr == 1) PG8_BAR; }
    }
    PG8_WAIT_V(0);
    if constexpr (!ALIGN_EPI) { if (wr == 0) PG8_BAR; }
    PG8_BAR;
    if constexpr (Epi::AFTER_DRAIN) { E.fused(acc, cur, wr, wc, fr, fq, lds, wid, lane); S.done(cur); }
#undef PG8_SA
#undef PG8_SB
#undef PG8_STAGE
#undef PG8_LDA
#undef PG8_LDB
#undef PG8_MMA
#undef PG8_WAIT_V
#undef PG8_WAIT_L
#undef PG8_BAR
#undef PG8_SCHED
}
template <class Epi, class Sched>
__device__ __forceinline__ void gemm_phase_g(PG8_LAS unsigned char* lds, const Gemm g, const Sched& S, const Epi& E, const PG8_LAS unsigned* rowtab) {
    constexpr bool ALIGN_EPI = true, SP2 = true;
    const int tid = threadIdx.x, wid = __builtin_amdgcn_readfirstlane(tid >> 6), lane = tid & 63, wr = wid >> 2, wc = wid & 3, fr = lane & 15, fq = lane >> 4;
    const int K = g.K, nt = K / BK;
    unsigned voffB[2], cu0[2], cu1[2], nx0[2], nx1[2]; int RA[2], CA2[2];
#pragma unroll
    for (int i = 0; i < 2; ++i) { int R, C; stage_rc(tid * 16 + i * 8192, R, C); const int Rb = Epi::PERM ? ((R & ~31) + perm32(R & 31)) : R;
        RA[i] = R; CA2[i] = C * 2; voffB[i] = (unsigned)(Rb * K + C) * 2u; }
#define PG8_ROWS(dst0, dst1, u) do { _Pragma("unroll") for (int _i = 0; _i < 2; ++_i) { dst0[_i] = rowtab[(u) * 256 + RA[_i]] + (unsigned)CA2[_i]; dst1[_i] = rowtab[(u) * 256 + 128 + RA[_i]] + (unsigned)CA2[_i]; } } while (0)
    const size_t kstep = (size_t)(BK * 2);
    const size_t hstep = (size_t)HALF * K * 2;
    const size_t tstep = 2 * hstep;
    const unsigned ldsw = (unsigned)wid * 1024u;
    const int aoff = lds_byte(wr * 64 + fr, fq * 8), boff = lds_byte(wc * 32 + fr, fq * 8);
#define PG8_SA(b, h) (((b) * 2 + (h)) * HTB)
#define PG8_SB(b, h) ((4 + (b) * 2 + (h)) * HTB)
#define PG8_STAGE(bufoff, gbase, voff) do { _Pragma("unroll") for (int _i = 0; _i < 2; ++_i) \
        __builtin_amdgcn_global_load_lds((const unsigned*)((const char*)(gbase) + (voff)[_i]), (PG8_LAS unsigned*)(lds + (bufoff) + ldsw + _i * 8192), 16, 0, 0); } while (0)
#define PG8_LDA(dst, b, h) do { _Pragma("unroll") for (int m = 0; m < 4; ++m) _Pragma("unroll") for (int k = 0; k < 2; ++k) dst[m][k] = *(const PG8_LAS bf16x8*)(lds + PG8_SA(b, h) + aoff + m * 2048 + k * 1024); } while (0)
#define PG8_LDB(dst, b, h) do { _Pragma("unroll") for (int n = 0; n < 2; ++n) _Pragma("unroll") for (int k = 0; k < 2; ++k) dst[n][k] = *(const PG8_LAS bf16x8*)(lds + PG8_SB(b, h) + boff + n * 2048 + k * 1024); } while (0)
#define PG8_MMA(ai, bj, At, Bt) do { __builtin_amdgcn_s_setprio(1); _Pragma("unroll") for (int m = 0; m < 4; ++m) _Pragma("unroll") for (int n = 0; n < 2; ++n) _Pragma("unroll") for (int k = 0; k < 2; ++k) \
        acc[ai][bj][m][n] = __builtin_amdgcn_mfma_f32_16x16x32_bf16(Bt[n][k], At[m][k], acc[ai][bj][m][n], 0, 0, 0); __builtin_amdgcn_s_setprio(0); } while (0)
#define PG8_WAIT_V(n) asm volatile("s_waitcnt vmcnt(" #n ")" ::: "memory")
#define PG8_WAIT_L(n) asm volatile("s_waitcnt lgkmcnt(" #n ")" ::: "memory")
#define PG8_BAR __builtin_amdgcn_s_barrier()
#define PG8_SCHED __builtin_amdgcn_sched_barrier(0)
    Unit cur, nxt; int ui = 0;
    if (!S.next(0, cur)) return;
    f32x4 acc[2][2][4][2];
    if constexpr (Epi::HAS_INIT) E.init(acc, cur, wr, wc, fr, fq);
    else {
#pragma unroll
    for (int a = 0; a < 2; ++a)
#pragma unroll
        for (int b = 0; b < 2; ++b)
#pragma unroll
            for (int m = 0; m < 4; ++m)
#pragma unroll
                for (int n = 0; n < 2; ++n) acc[a][b][m][n] = (f32x4){0.f, 0.f, 0.f, 0.f};
    }
    bf16x8 At[4][2], B0[2][2], B1[2][2];
    const char* gA = (const char*)g.A; PG8_ROWS(cu0, cu1, 0); const char* cA = gA; unsigned voffA[2] = {0u, 0u}; (void)cA; (void)voffA;     const char* cB = (const char*)g.Bt + (size_t)cur.pn * tstep;
    S.a_ready(cur);
    if constexpr (SP2) {
        PG8_STAGE(PG8_SB(0, 0), cB, voffB); PG8_STAGE(PG8_SB(0, 1), cB + hstep, voffB); PG8_STAGE(PG8_SA(0, 0), gA, cu0); PG8_STAGE(PG8_SA(0, 1), gA, cu1);
        if (wr == 1) PG8_BAR;
        PG8_WAIT_V(2); PG8_BAR;
        PG8_STAGE(PG8_SB(1, 0), cB + kstep, voffB); PG8_STAGE(PG8_SA(1, 0), gA + kstep, cu0); PG8_STAGE(PG8_SB(1, 1), cB + hstep + kstep, voffB);
        PG8_WAIT_V(6); PG8_BAR;
    } else {
        PG8_STAGE(PG8_SB(0, 0), cB, voffB); PG8_STAGE(PG8_SA(0, 0), cA, voffA); PG8_STAGE(PG8_SB(0, 1), cB + hstep, voffB); PG8_STAGE(PG8_SA(0, 1), cA + hstep, voffA);
        if (wr == 1) PG8_BAR;
        PG8_WAIT_V(4); PG8_BAR;
        PG8_STAGE(PG8_SB(1, 0), cB + kstep, voffB); PG8_STAGE(PG8_SA(1, 0), cA + kstep, voffA); PG8_STAGE(PG8_SB(1, 1), cB + hstep + kstep, voffB);
        PG8_WAIT_V(6); PG8_BAR;
    }
    for (;;) {
        const bool has_next = S.next(ui + 1, nxt);
        if (has_next) PG8_ROWS(nx0, nx1, ui + 1); else { _Pragma("unroll") for (int _i = 0; _i < 2; ++_i) { nx0[_i] = cu0[_i]; nx1[_i] = cu1[_i]; } }
        const char* nB = has_next ? (const char*)g.Bt + (size_t)nxt.pn * tstep : cB;
        for (int t = 0; t < nt; t += 2) {
            const bool last = (t == nt - 2);
            const char* a1 = gA + (size_t)(t + 1) * kstep;
            const char* a2 = last ? gA : gA + (size_t)(t + 2) * kstep; const char* b2 = last ? nB : cB + (size_t)(t + 2) * kstep;
            const char* a3 = a2 + kstep; const char* b3 = b2 + kstep;
            unsigned v0[2], v1[2];
            _Pragma("unroll") for (int _i = 0; _i < 2; ++_i) { v0[_i] = last ? nx0[_i] : cu0[_i]; v1[_i] = last ? nx1[_i] : cu1[_i]; }
            if (last && has_next) S.a_ready(nxt);
            if constexpr (SP2) {
            PG8_LDB(B0, 0, 0); PG8_LDB(B1, 0, 1); PG8_SCHED; PG8_LDA(At, 0, 0); PG8_STAGE(PG8_SA(1, 1), a1, cu1);
            PG8_WAIT_V(8); PG8_WAIT_L(0); PG8_BAR; PG8_MMA(0, 0, At, B0); PG8_MMA(0, 1, At, B1); PG8_BAR; PG8_SCHED;
            PG8_LDA(At, 0, 1); PG8_STAGE(PG8_SB(0, 0), b2, voffB); PG8_STAGE(PG8_SB(0, 1), b2 + hstep, voffB); PG8_STAGE(PG8_SA(0, 0), a2, v0);
            PG8_WAIT_V(8); PG8_WAIT_L(0); PG8_BAR; PG8_MMA(1, 0, At, B0); PG8_MMA(1, 1, At, B1); PG8_BAR; PG8_SCHED;
            PG8_LDB(B0, 1, 0); PG8_LDB(B1, 1, 1); PG8_SCHED; PG8_LDA(At, 1, 0); PG8_STAGE(PG8_SA(0, 1), a2, v1);
            PG8_WAIT_V(8); PG8_WAIT_L(0); PG8_BAR; PG8_MMA(0, 0, At, B0); PG8_MMA(0, 1, At, B1); PG8_BAR; PG8_SCHED;
            PG8_LDA(At, 1, 1); PG8_STAGE(PG8_SB(1, 0), b3, voffB); PG8_STAGE(PG8_SB(1, 1), b3 + hstep, voffB); PG8_STAGE(PG8_SA(1, 0), a3, v0);
            PG8_WAIT_V(8); PG8_WAIT_L(0); PG8_BAR; PG8_MMA(1, 0, At, B0); PG8_MMA(1, 1, At, B1); PG8_BAR; PG8_SCHED;
            } else {
            PG8_LDB(B0, 0, 0); PG8_SCHED; PG8_LDA(At, 0, 0); PG8_STAGE(PG8_SA(1, 1), a1 + hstep, voffA);
            PG8_WAIT_L(8); PG8_BAR; PG8_WAIT_L(0); PG8_MMA(0, 0, At, B0); PG8_BAR; PG8_SCHED;
            PG8_LDB(B1, 0, 1); PG8_STAGE(PG8_SB(0, 0), b2, voffB);
            PG8_BAR; PG8_WAIT_L(0); PG8_MMA(0, 1, At, B1); PG8_BAR;
            PG8_LDA(At, 0, 1); PG8_STAGE(PG8_SA(0, 0), a2, voffA);
            PG8_BAR; PG8_WAIT_L(0); PG8_MMA(1, 0, At, B0); PG8_BAR; PG8_SCHED;
            PG8_STAGE(PG8_SB(0, 1), b2 + hstep, voffB);
            PG8_WAIT_V(6); PG8_BAR; PG8_MMA(1, 1, At, B1); PG8_BAR;
            PG8_LDB(B0, 1, 0); PG8_SCHED; PG8_LDA(At, 1, 0); PG8_STAGE(PG8_SA(0, 1), a2 + hstep, voffA);
            PG8_WAIT_L(8); PG8_BAR; PG8_WAIT_L(0); PG8_MMA(0, 0, At, B0); PG8_BAR; PG8_SCHED;
            PG8_LDB(B1, 1, 1); PG8_STAGE(PG8_SB(1, 0), b3, voffB);
            PG8_BAR; PG8_WAIT_L(0); PG8_MMA(0, 1, At, B1); PG8_BAR;
            PG8_LDA(At, 1, 1); PG8_STAGE(PG8_SA(1, 0), a3, voffA);
            PG8_BAR; PG8_WAIT_L(0); PG8_MMA(1, 0, At, B0); PG8_BAR; PG8_SCHED;
            PG8_STAGE(PG8_SB(1, 1), b3 + hstep, voffB);
            PG8_WAIT_V(6); PG8_BAR; PG8_MMA(1, 1, At, B1); PG8_BAR;
            }
        }
        if constexpr (ALIGN_EPI) { if (wr == 0) PG8_BAR; }
        if constexpr (!Epi::AFTER_DRAIN) { E(acc, cur, wr, wc, fr, fq); S.done(cur); }
        if (!has_next) break;
        if constexpr (Epi::HAS_INIT) E.init(acc, nxt, wr, wc, fr, fq);
        else {
#pragma unroll
        for (int a = 0; a < 2; ++a)
#pragma unroll
            for (int b = 0; b < 2; ++b)
#pragma unroll
                for (int m = 0; m < 4; ++m)
#pragma unroll
                    for (int n = 0; n < 2; ++n) acc[a][b][m][n] = (f32x4){0.f, 0.f, 0.f, 0.f};
        }
        cur = nxt; cB = nB; ++ui;
        _Pragma("unroll") for (int _i = 0; _i < 2; ++_i) { cu0[_i] = nx0[_i]; cu1[_i] = nx1[_i]; }
        if constexpr (ALIGN_EPI) { if (wr == 1) PG8_BAR; }
    }
    PG8_WAIT_V(0);
    if constexpr (!ALIGN_EPI) { if (wr == 0) PG8_BAR; }
    PG8_BAR;
    if constexpr (Epi::AFTER_DRAIN) { E.fused(acc, cur, wr, wc, fr, fq, lds, wid, lane); S.done(cur); }
#undef PG8_ROWS
#undef PG8_SA
#undef PG8_SB
#undef PG8_STAGE
#undef PG8_LDA
#undef PG8_LDB
#undef PG8_MMA
#undef PG8_WAIT_V
#undef PG8_WAIT_L
#undef PG8_BAR
#undef PG8_SCHED
}
}

typedef unsigned short bf16_t;
typedef short bf16x8 __attribute__((ext_vector_type(8)));
typedef float f32x4 __attribute__((ext_vector_type(4)));
typedef float f32x16 __attribute__((ext_vector_type(16)));
typedef unsigned u32x4 __attribute__((ext_vector_type(4)));
typedef unsigned u32x2 __attribute__((ext_vector_type(2)));
#define LAS __attribute__((address_space(3)))

__device__ __forceinline__ float bf2f(bf16_t v) { return __uint_as_float((unsigned)v << 16); }
__device__ __forceinline__ bf16_t f2bf(float f) { unsigned u = __float_as_uint(f); return (bf16_t)((u + 0x7fffu + ((u >> 16) & 1u)) >> 16); }
__device__ __forceinline__ unsigned pk2(float lo, float hi) { return (unsigned)f2bf(lo) | ((unsigned)f2bf(hi) << 16); }
__device__ __forceinline__ float wave_sum(float v) {
#pragma unroll
    for (int o = 32; o >= 1; o >>= 1) v += __shfl_xor(v, o);
    return v;
}
__device__ __forceinline__ float wave_max(float v) {
#pragma unroll
    for (int o = 32; o >= 1; o >>= 1) v = fmaxf(v, __shfl_xor(v, o));
    return v;
}
__device__ __forceinline__ float silu_f(float x) { return x / (1.f + __expf(-x)); }
__device__ __forceinline__ float sigmoid_f(float x) { return 1.f / (1.f + __expf(-x)); }

constexpr size_t MiB = 1u << 20;
constexpr size_t WS_ROWSCALE = 0;
constexpr size_t WS_CNT      = 64 * 1024;
constexpr size_t WS_RS2      = 128 * 1024;
constexpr size_t WS_ECNT     = 192 * 1024;
constexpr size_t WS_BAR      = 256 * 1024;
constexpr size_t WS_SINCOS   = 1 * MiB;
constexpr size_t WS_GATES    = 2 * MiB;
constexpr size_t WS_W1T      = 4 * MiB;
constexpr size_t WS_TS       = 64 * 1024 + 4096;
constexpr size_t WS_CBIAS    = 64 * 1024 + 2048;
constexpr size_t WS_LTOK     = 6 * MiB;
constexpr size_t WS_LW       = 8 * MiB;
constexpr size_t WS_SELMASK  = 10 * MiB;
constexpr size_t WS_SELMASK2 = 10 * MiB + 256 * 1024;
constexpr size_t WS_KCB      = 10 * MiB + 512 * 1024;
constexpr size_t WS_VCB      = 11 * MiB;
constexpr size_t WS_DBG      = 64 * 1024 + 1024;
constexpr size_t WS_WR       = 11 * MiB + 512 * 1024;
constexpr size_t WS_WIN_T    = 12 * MiB;
constexpr size_t WS_WOUT_T   = 39 * MiB;
constexpr size_t WS_WGU_T    = 47 * MiB;
constexpr size_t WS_WD_T     = 175 * MiB;
constexpr size_t WS_XB       = 239 * MiB;
constexpr size_t WS_ATT      = 303 * MiB;
constexpr size_t WS_Y        = 239 * MiB;
constexpr size_t WS_P        = 367 * MiB;
constexpr size_t WS_XG       = 367 * MiB;
constexpr size_t WS_HB       = 527 * MiB;
constexpr size_t WS_END      = 575 * MiB;
constexpr size_t WS_H2       = WS_XB;
constexpr size_t WS_FIN      = WS_XB + 32 * MiB;
constexpr size_t WS_REF      = WS_XB;

struct Args { const float* in[19]; float* out; unsigned char* ws; int ph_lo, ph_hi; };
enum { I_X = 0, I_N1G, I_WIN, I_CPOS, I_CW1, I_CW2, I_QNG, I_KNG, I_GNG, I_GNB, I_WOUT, I_N2G, I_WRG, I_BRG, I_WRE, I_BRE, I_WEG, I_WEU, I_WED };

constexpr int LDS_BYTES = 147456 + 1024;
constexpr int LDS_XBAR = 147456;
constexpr int LDS_TAB = 131072;

using pg8::Unit;
struct EpiInProj {
    static constexpr bool PERM = true, AFTER_DRAIN = false, HAS_INIT = false;
    bf16_t* P; float* gates; const LAS float* rsT; const LAS int* slotpm;
    __device__ __forceinline__ void operator()(const f32x4 (&acc)[2][2][4][2], const Unit& u, int wr, int wc, int fr, int fq) const {
        const int row0 = u.pm * 256 + wr * 64 + fr; const LAS float* rsp = rsT + slotpm[u.pm] * 256 + wr * 64 + fr;
        if (u.pn < 26) {
            const int L = fq * 16 + fr, c8 = L & 7, srcb = ((L >> 3) + 16 * (c8 & 3)) * 4; const bool pick1 = (c8 >> 2) != 0;
            bf16_t* pbase = P + (size_t)(u.pm * 256 + wr * 64 + (L >> 3)) * PW + u.pn * 256 + wc * 64 + 8 * c8;
#pragma unroll
            for (int ai = 0; ai < 2; ++ai)
#pragma unroll
                for (int m = 0; m < 4; ++m) {
                    const float rs = rsp[ai * 128 + m * 16];
                    u32x4 w[2];
#pragma unroll
                    for (int bj = 0; bj < 2; ++bj) { const f32x4 v0 = acc[ai][bj][m][0] * rs, v1 = acc[ai][bj][m][1] * rs;
                        w[bj].x = pg8::cvt_pk_bf16(v0[0], v0[1]); w[bj].y = pg8::cvt_pk_bf16(v0[2], v0[3]); w[bj].z = pg8::cvt_pk_bf16(v1[0], v1[1]); w[bj].w = pg8::cvt_pk_bf16(v1[2], v1[3]); }
#pragma unroll
                    for (int h = 0; h < 2; ++h) { u32x4 o;
#pragma unroll
                        for (int d = 0; d < 4; ++d) { const unsigned a0 = (unsigned)__builtin_amdgcn_ds_bpermute(srcb + 32 * h, (int)w[0][d]), a1 = (unsigned)__builtin_amdgcn_ds_bpermute(srcb + 32 * h, (int)w[1][d]); o[d] = pick1 ? a1 : a0; }
                        *(u32x4*)(pbase + (size_t)(ai * 128 + m * 16 + 8 * h) * PW) = o; }
                }
        } else {
            if (wc == 0 && fq < 3) {
#pragma unroll
                for (int ai = 0; ai < 2; ++ai)
#pragma unroll
                    for (int m = 0; m < 4; ++m) {
                        const int row = row0 + ai * 128 + m * 16; const float rs = rsp[ai * 128 + m * 16];
                        float* gp = gates + (size_t)row * 24 + 8 * fq;
                        *(f32x4*)gp = acc[ai][0][m][0] * rs; *(f32x4*)(gp + 4) = acc[ai][0][m][1] * rs;
                    }
            }
        }
    }
};
struct EpiOutProj {
    static constexpr bool PERM = true, AFTER_DRAIN = false, HAS_INIT = true;
    const float* x; float* x1; bf16_t* x1b;
    __device__ __forceinline__ void init(f32x4 (&acc)[2][2][4][2], const Unit& u, int wr, int wc, int fr, int fq) const {
        const int row0 = u.pm * 256 + wr * 64 + fr, col0 = u.pn * 256 + wc * 32 + 8 * fq;
#pragma unroll
        for (int ai = 0; ai < 2; ++ai)
#pragma unroll
            for (int m = 0; m < 4; ++m) { const size_t off = (size_t)(row0 + ai * 128 + m * 16) * DM + col0;
#pragma unroll
                for (int bj = 0; bj < 2; ++bj) { acc[ai][bj][m][0] = *(const f32x4*)(x + off + bj * 128); acc[ai][bj][m][1] = *(const f32x4*)(x + off + bj * 128 + 4); } }
    }
    __device__ __forceinline__ void operator()(const f32x4 (&acc)[2][2][4][2], const Unit& u, int wr, int wc, int fr, int fq) const {
        const int row0 = u.pm * 256 + wr * 64 + fr, col0 = u.pn * 256 + wc * 32 + 8 * fq;
#pragma unroll
        for (int ai = 0; ai < 2; ++ai)
#pragma unroll
            for (int m = 0; m < 4; ++m) {
                const size_t off = (size_t)(row0 + ai * 128 + m * 16) * DM + col0;
#pragma unroll
                for (int bj = 0; bj < 2; ++bj) {
                    const f32x4 r0 = acc[ai][bj][m][0], r1 = acc[ai][bj][m][1];
                    *(f32x4*)(x1 + off + bj * 128) = r0; *(f32x4*)(x1 + off + bj * 128 + 4) = r1;
                    u32x4 w; w.x = pg8::cvt_pk_bf16(r0[0], r0[1]); w.y = pg8::cvt_pk_bf16(r0[2], r0[3]); w.z = pg8::cvt_pk_bf16(r1[0], r1[1]); w.w = pg8::cvt_pk_bf16(r1[2], r1[3]);
                    *(u32x4*)(x1b + off + bj * 128) = w;
                }
            }
    }
};
struct EpiGateUp {
    static constexpr bool PERM = true, AFTER_DRAIN = false, HAS_INIT = false;
    bf16_t* hb; const LAS float* rsT; const LAS int* tslot;
    __device__ __forceinline__ void operator()(const f32x4 (&acc)[2][2][4][2], const Unit& u, int wr, int wc, int fr, int fq) const {
        const int row0 = u.pm * 256 + wr * 64 + fr, col0 = (u.pn & 3) * 128 + wc * 32 + 8 * fq;
        const LAS float* rsp = rsT + tslot[u.pm] * 256 + wr * 64 + fr;
#pragma unroll
        for (int ai = 0; ai < 2; ++ai)
#pragma unroll
            for (int m = 0; m < 4; ++m) {
                bf16_t* rowp = hb + (size_t)(row0 + ai * 128 + m * 16) * DEXP + col0;
                const float rs = rsp[ai * 128 + m * 16];
                const f32x4 g0 = acc[ai][0][m][0] * rs, g1 = acc[ai][0][m][1] * rs, u0 = acc[ai][1][m][0] * rs, u1 = acc[ai][1][m][1] * rs;
                float r[8];
#pragma unroll
                for (int j = 0; j < 4; ++j) { r[j] = silu_f(g0[j]) * u0[j]; r[4 + j] = silu_f(g1[j]) * u1[j]; }
                u32x4 w; w.x = pg8::cvt_pk_bf16(r[0], r[1]); w.y = pg8::cvt_pk_bf16(r[2], r[3]); w.z = pg8::cvt_pk_bf16(r[4], r[5]); w.w = pg8::cvt_pk_bf16(r[6], r[7]);
                *(u32x4*)rowp = w;
            }
    }
};
struct EpiDown {
    static constexpr bool PERM = true, AFTER_DRAIN = false, HAS_INIT = false;
    bf16_t* y; const LAS int* tokT; const LAS float* wT; const LAS int* tslot;
    __device__ __forceinline__ void operator()(const f32x4 (&acc)[2][2][4][2], const Unit& u, int wr, int wc, int fr, int fq) const {
        const int slb = tslot[u.pm] * 256 + wr * 64;
        const int L = fq * 16 + fr, c8 = L & 7, srcb = ((L >> 3) + 16 * (c8 & 3)) * 4; const bool pick1 = (c8 >> 2) != 0;
        const int col = (u.pn & 7) * 256 + wc * 64 + 8 * c8;
#pragma unroll
        for (int ai = 0; ai < 2; ++ai)
#pragma unroll
            for (int m = 0; m < 4; ++m) {
                const float w = wT[slb + fr + ai * 128 + m * 16];
                u32x4 wv[2];
#pragma unroll
                for (int bj = 0; bj < 2; ++bj) { const f32x4 v0 = acc[ai][bj][m][0] * w, v1 = acc[ai][bj][m][1] * w;
                    wv[bj].x = pg8::cvt_pk_bf16(v0[0], v0[1]); wv[bj].y = pg8::cvt_pk_bf16(v0[2], v0[3]); wv[bj].z = pg8::cvt_pk_bf16(v1[0], v1[1]); wv[bj].w = pg8::cvt_pk_bf16(v1[2], v1[3]); }
#pragma unroll
                for (int h = 0; h < 2; ++h) { u32x4 o;
#pragma unroll
                    for (int d = 0; d < 4; ++d) { const unsigned a0 = (unsigned)__builtin_amdgcn_ds_bpermute(srcb + 32 * h, (int)wv[0][d]), a1 = (unsigned)__builtin_amdgcn_ds_bpermute(srcb + 32 * h, (int)wv[1][d]); o[d] = pick1 ? a1 : a0; }
                    const int tr = tokT[slb + ai * 128 + m * 16 + 8 * h + (L >> 3)];
                    if (tr >= 0) *(u32x4*)(y + ((size_t)(tr & 1) * T + (tr >> 1)) * DM + col) = o; }
            }
    }
};
template <int NPN> struct MoeOrder {
    int G, c, ntiles; const LAS int* tile_e;
    __device__ __forceinline__ bool next(int i, Unit& u) const {
        const int nwg = ntiles * NPN; int L = i * G + c; if (L >= nwg) return false;
        { const int q = nwg / 8, r = nwg % 8, xcd = L % 8, off = L / 8; L = (xcd < r ? xcd * (q + 1) : r * (q + 1) + (xcd - r) * q) + off; }
        const int tile = L / NPN; u.pm = tile; u.pn = tile_e[tile] * NPN + (L % NPN); return true;
    }
    __device__ __forceinline__ void a_ready(const Unit&) const {}
    __device__ __forceinline__ void done(const Unit&) const {}
};

struct MoeTab { LAS int* cnt; LAS int* tstart; LAS int* tile_e; LAS int* tile_i; };
__device__ __forceinline__ MoeTab moe_tab(unsigned char* lds) {
    MoeTab t; LAS int* base = (LAS int*)(lds + LDS_TAB); t.cnt = base; t.tstart = base + 32; t.tile_e = base + 72; t.tile_i = base + 72 + MAXTILES; return t;
}
__device__ __forceinline__ int moe_build_tab(const MoeTab& t, const unsigned* gcnt) {
    __syncthreads();
    if (threadIdx.x == 0) {
        int acc = 0;
        for (int e = 0; e < NEXP; ++e) {
            const int n = (int)__hip_atomic_load(gcnt + e * 64, __ATOMIC_RELAXED, __HIP_MEMORY_SCOPE_AGENT);
            t.cnt[e] = n; t.tstart[e] = acc; const int nt = (n + 255) >> 8;
            for (int i = 0; i < nt; ++i) { t.tile_e[acc + i] = e; t.tile_i[acc + i] = i; }
            acc += nt;
        }
        t.tstart[NEXP] = acc;
    }
    __syncthreads();
    return t.tstart[NEXP];
}

#define XB_TMO      128
#define XB_XCNT(j)  (256  + 64 * (j))
#define XB_XSUB(j)  (1280 + 64 * (j))
#define XB_XGEN(j)  (2304 + 64 * (j))
#define XB_TOP      3328
#define XB_TOPGEN   3392
#define XCD_BAR_WORDS 3456
#define XB_SPIN_CAP (1u << 18)

__device__ __forceinline__ unsigned xb_ld(unsigned* p)              { return __hip_atomic_load(p, __ATOMIC_RELAXED, __HIP_MEMORY_SCOPE_AGENT); }
__device__ __forceinline__ unsigned xb_add(unsigned* p, unsigned v) { return __hip_atomic_fetch_add(p, v, __ATOMIC_RELAXED, __HIP_MEMORY_SCOPE_AGENT); }
__device__ __forceinline__ unsigned xb_xcc_id() { return (unsigned)__builtin_amdgcn_s_getreg((3 << 11) | 20) & 0xFu; }
#define XB_SPIN(cond, bar) do { unsigned _sp = 0; while (cond) { __builtin_amdgcn_s_sleep(1); \
    if ((++_sp & 255u) == 0u) { if (xb_ld(&(bar)[XB_TMO])) break; if (_sp > XB_SPIN_CAP) { atomicAdd(&(bar)[XB_TMO], 1u); break; } } } } while (0)

struct XcdBarrier {
    unsigned* bar; unsigned x;
    volatile LAS unsigned* st;
};

__device__ __forceinline__ XcdBarrier xcd_barrier_post(unsigned* bar, volatile LAS unsigned* st) {
    XcdBarrier b; b.bar = bar; b.x = xb_xcc_id(); b.st = st;
    if (threadIdx.x == 0) (void)xb_add(&bar[XB_XCNT(b.x)], 1u);
    return b;
}
__device__ __forceinline__ void xcd_barrier_complete(unsigned* bar, unsigned x, unsigned& nloc, unsigned& nx) {
    const unsigned G = gridDim.x * gridDim.y * gridDim.z;
    unsigned sum, cnt, mine, sp = 0u;
    for (;;) {
        sum = 0u; cnt = 0u; mine = 0u;
#pragma unroll
        for (unsigned j = 0; j < 16; ++j) { const unsigned c = xb_ld(&bar[XB_XCNT(j)]); sum += c; cnt += (c > 0u) ? 1u : 0u; mine = (j == x) ? c : mine; }
        if (sum == G) break;
        __builtin_amdgcn_s_sleep(1);
        if ((++sp & 255u) == 0u) { if (xb_ld(&bar[XB_TMO])) break; if (sp > XB_SPIN_CAP) { atomicAdd(&bar[XB_TMO], 1u); break; } }
    }
    nloc = mine > 0u ? mine : 1u; nx = cnt > 0u ? cnt : 1u;
}

__device__ __forceinline__ void xcd_barrier(const XcdBarrier& b) {
    asm volatile("s_waitcnt vmcnt(0)" ::: "memory");
    __syncthreads();
    if (threadIdx.x == 0) {
        unsigned* bar = b.bar;
        __builtin_amdgcn_s_waitcnt(0);
        unsigned nloc = b.st[0], nx = b.st[1];
        if (nloc == 0u) { xcd_barrier_complete(bar, b.x, nloc, nx); b.st[0] = nloc; b.st[1] = nx; }
        const unsigned old = xb_add(&bar[XB_XSUB(b.x)], 1u);
        const unsigned gen = old / nloc;
        if (old + 1u == (gen + 1u) * nloc) {
            __builtin_amdgcn_fence(__ATOMIC_RELEASE, "agent");
            asm volatile("s_waitcnt vmcnt(0)" ::: "memory");
            const unsigned og = xb_add(&bar[XB_TOP], 1u);
            const unsigned tg = og / nx;
            if (og + 1u == (tg + 1u) * nx) xb_add(&bar[XB_TOPGEN], 1u);
            else XB_SPIN(xb_ld(&bar[XB_TOPGEN]) == tg, bar);
            __builtin_amdgcn_fence(__ATOMIC_ACQUIRE, "agent");
            xb_add(&bar[XB_XGEN(b.x)], 1u);
            asm volatile("s_waitcnt vmcnt(0)" ::: "memory");
        } else {
            XB_SPIN(xb_ld(&bar[XB_XGEN(b.x)]) == gen, bar);
            __builtin_amdgcn_fence(__ATOMIC_ACQUIRE, "agent");
            asm volatile("s_waitcnt vmcnt(0)" ::: "memory");
        }
    }
    __syncthreads();
}


__device__ __forceinline__ void transpose_item(const float* __restrict__ src, int ldn, int k0, int n0, int nvalid, bf16_t* __restrict__ dst, int ldk,
                                               const float* __restrict__ gs, float* tile, int lane, bool split32 = false) {
    { const int r0 = lane >> 4, c4 = (lane & 15) * 4; f32x4 v[16];
#pragma unroll
      for (int i = 0; i < 16; ++i) { v[i] = (f32x4){0.f, 0.f, 0.f, 0.f}; if (c4 < nvalid) v[i] = *(const f32x4*)(src + (size_t)(k0 + r0 + 4 * i) * ldn + n0 + c4); }
#pragma unroll
      for (int i = 0; i < 16; ++i) { const int rr = r0 + 4 * i; if (gs) v[i] = v[i] * gs[k0 + rr];
          float* tp = tile + rr * 65 + c4; tp[0] = v[i][0]; tp[1] = v[i][1]; tp[2] = v[i][2]; tp[3] = v[i][3]; } }
    asm volatile("s_waitcnt lgkmcnt(0)" ::: "memory"); __builtin_amdgcn_wave_barrier();
    { const int kc = (lane & 7) * 8;
#pragma unroll
      for (int i = 0; i < 8; ++i) { const int n = (lane >> 3) + 8 * i; float v[8];
#pragma unroll
          for (int j = 0; j < 8; ++j) v[j] = tile[(kc + j) * 65 + n];
          u32x4 w; w.x = pk2(v[0], v[1]); w.y = pk2(v[2], v[3]); w.z = pk2(v[4], v[5]); w.w = pk2(v[6], v[7]);
          *(u32x4*)(dst + (size_t)(n + ((split32 && n >= 32) ? 96 : 0)) * ldk + k0 + kc) = w; } }
    asm volatile("s_waitcnt lgkmcnt(0)" ::: "memory"); __builtin_amdgcn_wave_barrier();
}

constexpr int TR_NA = (NIN_PAD / 64) * 32, TR_NB = 32 * 32, TR_NE = 768, TR_NC = 256;
__device__ __forceinline__ void transpose_dispatch(const Args& a, int it, float* tile, int lane) {
    unsigned char* ws = a.ws;
    bf16_t* WinT = (bf16_t*)(ws + WS_WIN_T); bf16_t* WoT = (bf16_t*)(ws + WS_WOUT_T); bf16_t* WguT = (bf16_t*)(ws + WS_WGU_T); bf16_t* WdT = (bf16_t*)(ws + WS_WD_T);
    constexpr int N_A = TR_NA, N_B = TR_NB, N_E = TR_NE;
    if (it < N_A) { const int nb = it >> 5, kb = it & 31, nd = nb * 64; int c0, nv;
        if (nd < 2560) { c0 = nd; nv = 64; } else if (nd < PW) { c0 = nd + 24; nv = 64; } else if (nd == PW) { c0 = 2560; nv = 24; } else { c0 = 0; nv = 0; }
        transpose_item(a.in[I_WIN], IN_W, kb * 64, c0, nv, WinT + (size_t)((nd & ~255) + 32 * ((nd >> 6) & 3)) * DM, DM, a.in[I_N1G], tile, lane, true); }
    else if (it < N_A + N_B) { const int j = it - N_A, nb = j >> 5, kb = j & 31;
        transpose_item(a.in[I_WOUT], DM, kb * 64, nb * 64, 64, WoT + (size_t)nb * 64 * DM, DM, nullptr, tile, lane); }
    else if (it >= N_A + N_B + NEXP * N_E) { const int j = it - (N_A + N_B + NEXP * N_E), which = j >> 7, nb = (j >> 6) & 1, kb = j & 63;
        transpose_item(a.in[I_CW1] + (size_t)which * 4096 * 128, 128, kb * 64, nb * 64, 64, (bf16_t*)(ws + WS_W1T) + ((size_t)which * 128 + nb * 64) * 4096, 4096, nullptr, tile, lane); }
    else { const int j = it - N_A - N_B, e = j / N_E, r = j % N_E;
        if (r < 512) { const int up = r >> 8, rr = r & 255, nb = rr >> 5, kb = rr & 31, n0 = nb * 64, drow = 256 * (n0 >> 7) + (n0 & 127) + 128 * up;
            transpose_item(a.in[up ? I_WEU : I_WEG] + (size_t)e * DM * DEXP, DEXP, kb * 64, n0, 64, WguT + ((size_t)e * 1024 + drow) * DM, DM, a.in[I_N2G], tile, lane); }
        else { const int r2 = r - 512, nb = r2 >> 3, kb = r2 & 7;
            transpose_item(a.in[I_WED] + (size_t)e * DEXP * DM, DM, kb * 64, nb * 64, 64, WdT + ((size_t)e * DM + ((nb * 64) & ~255) + 32 * (nb & 3)) * DEXP, DEXP, nullptr, tile, lane, true); } }
}

__device__ __forceinline__ void p0_prepass(const Args& a, unsigned char* lds) {
    const int tid = threadIdx.x, lane = tid & 63, wave = tid >> 6;
    unsigned char* ws = a.ws;
    { const float* x = a.in[I_X]; bf16_t* xb = (bf16_t*)(ws + WS_XB); float* rsc = (float*)(ws + WS_ROWSCALE);
      for (int row = blockIdx.x * 8 + wave; row < T; row += gridDim.x * 8) {
        const float* xr = x + (size_t)row * DM; f32x4 v[8]; float ss = 0.f;
#pragma unroll
        for (int i = 0; i < 4; ++i) { v[2 * i] = *(const f32x4*)(xr + i * 512 + lane * 8); v[2 * i + 1] = *(const f32x4*)(xr + i * 512 + lane * 8 + 4); }
#pragma unroll
        for (int i = 0; i < 8; ++i) ss += v[i][0] * v[i][0] + v[i][1] * v[i][1] + v[i][2] * v[i][2] + v[i][3] * v[i][3];
        ss = wave_sum(ss);
        if (lane == 0) rsc[row] = rsqrtf(ss * (1.f / DM) + RMS_EPS);
#pragma unroll
        for (int i = 0; i < 4; ++i) { u32x4 w; w.x = pk2(v[2 * i][0], v[2 * i][1]); w.y = pk2(v[2 * i][2], v[2 * i][3]); w.z = pk2(v[2 * i + 1][0], v[2 * i + 1][1]); w.w = pk2(v[2 * i + 1][2], v[2 * i + 1][3]);
            *(u32x4*)(xb + (size_t)row * DM + i * 512 + lane * 8) = w; }
      } }
    { float* tile = (float*)lds + wave * (64 * 65);
      for (int it = blockIdx.x * 8 + wave; it < TR_NA + TR_NB + NEXP * TR_NE + TR_NC; it += gridDim.x * 8) transpose_dispatch(a, it, tile, lane);
    }
    { float* ct = (float*)(ws + WS_SINCOS); float* st = ct + SEQ * 64;
      for (int idx = blockIdx.x * NTHREADS + tid; idx < SEQ * 64; idx += gridDim.x * NTHREADS) {
        const int pos = idx >> 6, i = idx & 63;
        const float inv_freq = exp2f(-(float)i * (13.287712379549449f / 64.f));
        const float ang = (float)pos * inv_freq;
        const double rev = (double)ang * 0.15915494309189535; const float fr = (float)(rev - rint(rev));
        ct[idx] = __builtin_amdgcn_cosf(fr); st[idx] = __builtin_amdgcn_sinf(fr);
      }
      { bf16_t* Wh = (bf16_t*)(ws + WS_WR); bf16_t* Wl = Wh + 64 * DM;
        for (int idx = blockIdx.x * NTHREADS + tid; idx < 64 * DM; idx += gridDim.x * NTHREADS) { const int j = idx >> 11, k = idx & (DM - 1);
            float v = 0.f; if (j < 32) v = a.in[I_WRE][(size_t)k * 32 + j]; else if (j < 36) v = a.in[I_WRG][(size_t)k * 4 + (j - 32)];
            v *= a.in[I_N2G][k]; const bf16_t hb = f2bf(v); Wh[idx] = hb; Wl[idx] = f2bf(v - bf2f(hb)); } }
      for (int oi = blockIdx.x * 8 + wave; oi < 256; oi += gridDim.x * 8) { const int which = oi >> 7, e = oi & 127; float s = 0.f;
          for (int k = lane; k < 4096; k += 64) s += a.in[I_CPOS][which * 4096 + k] * a.in[I_CW1][((size_t)which * 4096 + k) * 128 + e];
          s = wave_sum(s); if (lane == 0) ((float*)(ws + WS_CBIAS))[oi] = s; }
      if (blockIdx.x == 0) for (int i = tid; i < XCD_BAR_WORDS; i += NTHREADS) ((unsigned*)(ws + WS_BAR))[i] = 0u;
      if (blockIdx.x == 0 && tid < 128) ((unsigned*)(ws + WS_CNT))[tid] = 0u;
      if (blockIdx.x == 0 && tid < 64) ((unsigned*)(ws + WS_ECNT))[tid * 64] = 0u;
      if (blockIdx.x == 0 && tid < 8) ((float*)(ws + WS_DBG))[tid] = 0.f; }
}

__device__ __forceinline__ void p2_finalize(const Args& a, unsigned char* lds, int rep) {
    const int tid = threadIdx.x, lane = tid & 63, wave = tid >> 6;
    unsigned char* ws = a.ws; bf16_t* P = (bf16_t*)(ws + WS_P);
    const float* ct = (const float*)(ws + WS_SINCOS); const float* st = ct + SEQ * 64;
    const float* qng = a.in[I_QNG]; const float* kng = a.in[I_KNG];
    unsigned* qctr = (unsigned*)(ws + WS_CNT) + 66 + rep; int* qslot = (int*)(lds + LDS_XBAR + 64);
    for (;;) {
      __syncthreads();
      if (tid == 0) *qslot = (int)atomicAdd(qctr, 1u);
      __syncthreads();
      const int qi = *qslot;
      if (qi >= 128 + 256) break;
      if (qi >= 128) {
      if (!rep)
      for (int tok = (qi - 128) * 64 + wave; tok < (qi - 128) * 64 + 64; tok += 8) {
        bf16_t* pr = P + (size_t)tok * PW; const int pos = tok & (SEQ - 1);
#pragma unroll
        for (int h = 0; h < 8; ++h) { unsigned* p2 = (unsigned*)(pr + PC_Q + h * 128) + lane; const unsigned w = *p2;
            const float v0 = __uint_as_float(w << 16), v1 = __uint_as_float(w & 0xffff0000u);
            const float ss = wave_sum(v0 * v0 + v1 * v1), r = rsqrtf(ss * (1.f / 128.f) + RMS_EPS);
            *p2 = pk2(v0 * r * qng[2 * lane], v1 * r * qng[2 * lane + 1]); }
#pragma unroll
        for (int j = 0; j < 4; ++j) { const int col = (j < 2 ? PC_KSLC : PC_KWIN) + (j & 1) * 128; const float* gg = kng + (j < 2 ? 128 : 256);
            unsigned* p2 = (unsigned*)(pr + col) + lane; const unsigned w = *p2;
            const float v0 = __uint_as_float(w << 16), v1 = __uint_as_float(w & 0xffff0000u);
            const float ss = wave_sum(v0 * v0 + v1 * v1), r = rsqrtf(ss * (1.f / 128.f) + RMS_EPS);
            *p2 = pk2(v0 * r * gg[2 * lane], v1 * r * gg[2 * lane + 1]); }
        const float c = ct[pos * 64 + lane], s = st[pos * 64 + lane]; const float nl = (float)(pos & 127);
#pragma unroll
        for (int h = 0; h < 8; ++h) {
            const float lg2 = log2f(1.f - exp2f(-5.f - (float)h)), sq = exp2f(lg2 * nl), sk = exp2f(-lg2 * nl) * QK_SCALE;
            { bf16_t* q1 = pr + PC_RQ + h * 128 + lane; const float t1 = bf2f(q1[0]), t2 = bf2f(q1[64]); q1[0] = f2bf((t1 * c - t2 * s) * sq); q1[64] = f2bf((t1 * s + t2 * c) * sq); }
            { bf16_t* k1 = pr + PC_RK + h * 128 + lane; const float t1 = bf2f(k1[0]), t2 = bf2f(k1[64]); k1[0] = f2bf((t1 * c - t2 * s) * sk); k1[64] = f2bf((t1 * s + t2 * c) * sk); }
        }
    }
      } else {
    const float* w2 = a.in[I_CW2];
    const bf16_t* W1T = (const bf16_t*)(ws + WS_W1T); const float* cbias = (const float*)(ws + WS_CBIAS);
    bf16_t* KCb = (bf16_t*)(ws + WS_KCB); bf16_t* VCb = (bf16_t*)(ws + WS_VCB);
    const int r32 = lane & 31, hi = lane >> 5;
    float* red = (float*)lds;
    float* hid = (float*)(lds + LDS_TAB);
    { const int item = qi;
        const int nt = item & 3, which = (item >> 2) & 1, g = (item >> 3) & 1, b = item >> 4;
        const int n = min(32 * nt + r32, NCMP - 1);
        const bf16_t* Ap = P + ((size_t)b * SEQ + 16 * n + 4 * wave) * PW + (which ? PC_VCMP : PC_KCMP) + g * 128 + hi * 8;
        const bf16_t* Bp = W1T + ((size_t)which * 128 + r32) * 4096 + wave * 512 + hi * 8;
        f32x16 acc[4];
#pragma unroll
        for (int et = 0; et < 4; ++et) acc[et] = f32x16{};
#pragma unroll 4
        for (int ks = 0; ks < 32; ++ks) {
            const bf16x8 af = *(const bf16x8*)(Ap + (size_t)(ks >> 3) * PW + 16 * (ks & 7));
#pragma unroll
            for (int et = 0; et < 4; ++et) { const bf16x8 bfr = *(const bf16x8*)(Bp + (size_t)et * 32 * 4096 + 16 * ks);
                acc[et] = __builtin_amdgcn_mfma_f32_32x32x16_bf16(af, bfr, acc[et], 0, 0, 0); }
        }
        __syncthreads();
#pragma unroll
        for (int et = 0; et < 4; ++et)
#pragma unroll
            for (int r = 0; r < 16; ++r) red[(wave * 32 + (r & 3) + 8 * (r >> 2) + 4 * hi) * 128 + 32 * et + r32] = acc[et][r];
        __syncthreads();
#pragma unroll
        for (int i = 0; i < 8; ++i) { const int idx = tid + 512 * i; float s = cbias[which * 128 + (idx & 127)];
#pragma unroll
            for (int w8 = 0; w8 < 8; ++w8) s += red[w8 * 4096 + idx];
            hid[idx] = silu_f(s); }
        __syncthreads();
        { const int f = tid & 127, ng = tid >> 7; float o8[8];
#pragma unroll
          for (int i = 0; i < 8; ++i) o8[i] = 0.f;
          const float* wp = w2 + which * 16384 + f;
          for (int e = 0; e < 128; ++e) { const float wv = wp[e * 128];
#pragma unroll
              for (int i = 0; i < 8; ++i) o8[i] += hid[(ng * 8 + i) * 128 + e] * wv; }
#pragma unroll
          for (int i = 0; i < 8; ++i) red[(ng * 8 + i) * 128 + f] = o8[i]; }
        __syncthreads();
        for (int rr = 0; rr < 4; ++rr) { const int nl = wave * 4 + rr, nn = 32 * nt + nl; const float v0 = red[nl * 128 + lane], v1 = red[nl * 128 + 64 + lane];
            float s0 = v0, s1 = v1;
            if (which == 0) { const float r = rsqrtf(wave_sum(v0 * v0 + v1 * v1) * (1.f / 128.f) + RMS_EPS); s0 = v0 * r * kng[lane]; s1 = v1 * r * kng[64 + lane]; }
            if (nn >= NCMP) { s0 = 0.f; s1 = 0.f; }
            bf16_t* op = (which ? VCb : KCb) + ((size_t)(b * 2 + g) * 128 + nn) * 128; op[lane] = f2bf(s0); op[64 + lane] = f2bf(s1); }
    }
      }
    }
}

__device__ __forceinline__ void softmax_rows(float* sc, int ncols, int tid) {
    const int lane = tid & 63, wave = tid >> 6;
    if (wave < 4) { float* r = sc + wave * 512; float mx = -1e30f;
        for (int i = lane; i < ncols; i += 64) mx = fmaxf(mx, r[i]);
        mx = wave_max(mx); float sum = 0.f;
        for (int i = lane; i < ncols; i += 64) { const float v = r[i]; const float e = (v > -1e29f) ? __expf(v - mx) : 0.f; r[i] = e; sum += e; }
        sum = wave_sum(sum); const float inv = sum > 0.f ? 1.f / sum : 0.f;
        for (int i = lane; i < ncols; i += 64) r[i] *= inv; }
}
__device__ __forceinline__ float dot_q_kbf16(const float* q, const bf16_t* k) {
    float s = 0.f;
#pragma unroll
    for (int c = 0; c < 16; ++c) { const u32x4 w = *(const u32x4*)(k + c * 8);
        s += q[c * 8 + 0] * __uint_as_float(w.x << 16) + q[c * 8 + 1] * __uint_as_float(w.x & 0xffff0000u) + q[c * 8 + 2] * __uint_as_float(w.y << 16) + q[c * 8 + 3] * __uint_as_float(w.y & 0xffff0000u)
           + q[c * 8 + 4] * __uint_as_float(w.z << 16) + q[c * 8 + 5] * __uint_as_float(w.z & 0xffff0000u) + q[c * 8 + 6] * __uint_as_float(w.w << 16) + q[c * 8 + 7] * __uint_as_float(w.w & 0xffff0000u); }
    return s;
}
__device__ __forceinline__ void nsa_naive(const Args& a, unsigned char* lds, bf16_t* dst, int ldd) {
    const int tid = threadIdx.x;
    unsigned char* ws = a.ws; const bf16_t* P = (const bf16_t*)(ws + WS_P);
    const bf16_t* KCb = (const bf16_t*)(ws + WS_KCB); const bf16_t* VCb = (const bf16_t*)(ws + WS_VCB); const float* gates = (const float*)(ws + WS_GATES);
    unsigned* selmask = (unsigned*)(ws + WS_SELMASK);
    float* qn = (float*)lds; float* sc = qn + 512; int* keypos = (int*)(sc + 2048); float* imp = (float*)(keypos + 512); unsigned* smask = (unsigned*)(imp + 32);
    for (int item = blockIdx.x; item < T * 2; item += gridDim.x) {
        const int g = item & 1, tok = item >> 1, b = tok >> 11, t = tok & (SEQ - 1);
        const int h = tid >> 7, d = tid & 127;
        __syncthreads();
        qn[tid] = bf2f(P[(size_t)tok * PW + PC_Q + (g * 4 + h) * 128 + d]) * QK_SCALE;
        __syncthreads();
        const int nvc = t >= 31 ? min(NCMP, (t - 31) / 16 + 1) : 0;
        { const int n = tid & 127; float s = -1e30f;
          if (n < nvc) { const bf16_t* kr = KCb + ((size_t)(b * 2 + g) * 128 + n) * 128; const float* q = qn + h * 128; s = 0.f; for (int k = 0; k < 128; ++k) s += q[k] * bf2f(kr[k]); }
          sc[h * 512 + n] = s; }
        __syncthreads();
        softmax_rows(sc, 128, tid);
        __syncthreads();
        float ocmp = 0.f;
        for (int n = 0; n < nvc; ++n) ocmp += sc[h * 512 + n] * bf2f(VCb[((size_t)(b * 2 + g) * 128 + n) * 128 + d]);
        if (tid < 32) { float s = 0.f; const int j = tid;
            for (int n = max(0, 4 * j - 1); n <= min(NCMP - 1, 4 * j + 3); ++n) s += sc[n] + sc[512 + n] + sc[1024 + n] + sc[1536 + n];
            imp[j] = s; }
        __syncthreads();
        if (tid == 0) { const int cur = t >> 6; unsigned m = 0u;
            for (int k = 0; k < NSEL; ++k) { int best = -1; float bs = 0.f;
                for (int j = 0; j < NSBLK; ++j) { if ((m >> j) & 1u) continue;
                    const bool valid = j <= cur, forced = (j == 0) || (j == cur) || (j == cur - 1);
                    const float s = valid ? (forced ? 1e6f : imp[j]) : -INFINITY;
                    if (best < 0 || s > bs) { best = j; bs = s; } }
                m |= 1u << best; }
            *smask = m; selmask[tok * 2 + g] = m; }
        __syncthreads();
        { const unsigned m = *smask; const int k = tid >> 6, i = tid & 63; int cntb = 0, jk = 0;
          for (int j = 0; j < NSBLK; ++j) if ((m >> j) & 1u) { if (cntb == k) jk = j; ++cntb; }
          const int kp = 64 * jk + i; keypos[tid] = kp <= t ? kp : -1; }
        __syncthreads();
        for (int hh = 0; hh < 4; ++hh) { const int kp = keypos[tid];
            sc[hh * 512 + tid] = kp >= 0 ? dot_q_kbf16(qn + hh * 128, P + (size_t)(b * SEQ + kp) * PW + PC_KSLC + g * 128) : -1e30f; }
        __syncthreads();
        softmax_rows(sc, 512, tid);
        __syncthreads();
        float oslc = 0.f;
        for (int sidx = 0; sidx < 512; ++sidx) { const int kp = keypos[sidx]; if (kp >= 0) oslc += sc[h * 512 + sidx] * bf2f(P[(size_t)(b * SEQ + kp) * PW + PC_VSLC + g * 128 + d]); }
        __syncthreads();
        { const int kp = t - tid; keypos[tid] = kp >= 0 ? kp : -1; }
        __syncthreads();
        for (int hh = 0; hh < 4; ++hh) { const int kp = keypos[tid];
            sc[hh * 512 + tid] = kp >= 0 ? dot_q_kbf16(qn + hh * 128, P + (size_t)(b * SEQ + kp) * PW + PC_KWIN + g * 128) : -1e30f; }
        __syncthreads();
        softmax_rows(sc, 512, tid);
        __syncthreads();
        float owin = 0.f;
        for (int sidx = 0; sidx < 512; ++sidx) { const int kp = keypos[sidx]; if (kp >= 0) owin += sc[h * 512 + sidx] * bf2f(P[(size_t)(b * SEQ + kp) * PW + PC_VWIN + g * 128 + d]); }
        const float* gp = gates + (size_t)tok * 24 + g * 12 + h * 3;
        const float o = ocmp * sigmoid_f(gp[0]) + oslc * sigmoid_f(gp[1]) + owin * sigmoid_f(gp[2]);
        dst[(size_t)tok * ldd + (g * 4 + h) * 128 + d] = f2bf(o);
    }
}

__device__ __forceinline__ void ret_naive(const Args& a, unsigned char* lds, bf16_t* dst, int ldd, int coff) {
    const int tid = threadIdx.x, lane = tid & 63, wave = tid >> 6;
    unsigned char* ws = a.ws; const bf16_t* P = (const bf16_t*)(ws + WS_P);
    const float* gng = a.in[I_GNG]; const float* gnb = a.in[I_GNB];
    float* qf = (float*)lds; float* kf = qf + 32 * 128; float* sm = kf + 128 * 129; float* ob = kf;
    for (int item = blockIdx.x; item < BATCH * RET_H * (SEQ / 32); item += gridDim.x) {
        const int nt = item & 63, h = (item >> 6) & 7, b = item >> 9, n0 = nt * 32;
        const float lg = log1pf(-exp2f(-5.f - (float)h));
        __syncthreads();
        for (int i = tid; i < 32 * 128; i += NTHREADS) { const int n = i >> 7, d = i & 127; qf[i] = bf2f(P[(size_t)(b * SEQ + n0 + n) * PW + PC_RQ + h * 128 + d]); }
        float o[8];
#pragma unroll
        for (int i = 0; i < 8; ++i) o[i] = 0.f;
        const int e = tid & 127, ng = tid >> 7;
        for (int m0 = 0; m0 <= n0 + 31; m0 += 128) {
            __syncthreads();
            for (int i = tid; i < 128 * 128; i += NTHREADS) { const int mm = i >> 7, d = i & 127; kf[mm * 129 + d] = bf2f(P[(size_t)(b * SEQ + m0 + mm) * PW + PC_RK + h * 128 + d]); }
            __syncthreads();
            { const int mm = tid & 127;
#pragma unroll
              for (int i = 0; i < 8; ++i) { const int n = ng * 8 + i; const int dist = (n0 + n) - (m0 + mm); float s = 0.f;
                  if (dist >= 0) { const float* q = qf + n * 128; const float* k = kf + mm * 129; for (int dd = 0; dd < 128; ++dd) s += q[dd] * k[dd]; s *= __expf(lg * 128.f * (float)(((n0 + n) >> 7) - ((m0 + mm) >> 7))); }
                  sm[n * 128 + mm] = s; } }
            __syncthreads();
            const int mmax = min(128, n0 + 32 - m0);
            for (int mm = 0; mm < mmax; ++mm) { const float v = bf2f(P[(size_t)(b * SEQ + m0 + mm) * PW + PC_RV + h * 128 + e]);
#pragma unroll
                for (int i = 0; i < 8; ++i) o[i] += sm[(ng * 8 + i) * 128 + mm] * v; }
        }
        __syncthreads();
#pragma unroll
        for (int i = 0; i < 8; ++i) ob[(ng * 8 + i) * 128 + e] = o[i];
        __syncthreads();
        for (int rr = 0; rr < 4; ++rr) { const int n = wave * 4 + rr; const float v0 = ob[n * 128 + lane], v1 = ob[n * 128 + 64 + lane];
            const float mu = wave_sum(v0 + v1) * (1.f / 128.f); const float d0 = v0 - mu, d1 = v1 - mu;
            const float var = wave_sum(d0 * d0 + d1 * d1) * (1.f / 128.f), r = rsqrtf(var + GN_EPS);
            const size_t tok = (size_t)(b * SEQ + n0 + n);
            const float g0 = bf2f(P[tok * PW + PC_RG + h * 128 + lane]), g1 = bf2f(P[tok * PW + PC_RG + h * 128 + 64 + lane]);
            const float y0 = d0 * r * gng[h * 128 + lane] + gnb[h * 128 + lane], y1 = d1 * r * gng[h * 128 + 64 + lane] + gnb[h * 128 + 64 + lane];
            dst[tok * ldd + coff + h * 128 + lane] = f2bf(silu_f(g0) * y0); dst[tok * ldd + coff + h * 128 + 64 + lane] = f2bf(silu_f(g1) * y1); }
    }
}

__device__ __forceinline__ void split_bf16(const f32x4& a, const f32x4& b, bf16x8& hi, bf16x8& lo) {
    u32x4 h, l; float r[8] = {a[0], a[1], a[2], a[3], b[0], b[1], b[2], b[3]}; unsigned hb[8], lb[8];
#pragma unroll
    for (int j = 0; j < 8; ++j) { hb[j] = f2bf(r[j]); lb[j] = f2bf(r[j] - __uint_as_float(hb[j] << 16)); }
    h.x = hb[0] | (hb[1] << 16); h.y = hb[2] | (hb[3] << 16); h.z = hb[4] | (hb[5] << 16); h.w = hb[6] | (hb[7] << 16);
    l.x = lb[0] | (lb[1] << 16); l.y = lb[2] | (lb[3] << 16); l.z = lb[4] | (lb[5] << 16); l.w = lb[6] | (lb[7] << 16);
    hi = *reinterpret_cast<bf16x8*>(&h); lo = *reinterpret_cast<bf16x8*>(&l);
}
__device__ __forceinline__ void p7_route(const Args& a, unsigned char* lds, int rep) {
    const int tid = threadIdx.x, lane = tid & 63, wave = __builtin_amdgcn_readfirstlane(tid >> 6), r32 = lane & 31, hi = lane >> 5;
    unsigned char* ws = a.ws; const float* x1 = a.out;
    const float* brg = a.in[I_BRG]; const float* bre = a.in[I_BRE];
    const bf16_t* Wh = (const bf16_t*)(ws + WS_WR); const bf16_t* Wl = Wh + 64 * DM;
    unsigned* cnt = (unsigned*)(ws + WS_ECNT) + (rep ? 32 * 64 : 0); int* ltok = (int*)(ws + (rep ? WS_WIN_T : WS_LTOK)); float* lw = (float*)(ws + (rep ? WS_WIN_T + 2 * MiB : WS_LW)); float* rs2 = (float*)(ws + WS_RS2);
    float* part = (float*)lds;
    constexpr int XST = 260;
    float* xbuf = (float*)lds;
    const int mt = wave & 1, kq = wave >> 1;
    for (int tile = blockIdx.x; tile < T / 64; tile += gridDim.x) {
        const int tok0 = tile * 64;
        const bf16_t* bh = Wh + (size_t)r32 * DM + kq * 64 + hi * 8; const bf16_t* bl = Wl + (size_t)r32 * DM + kq * 64 + hi * 8;
        f32x16 acc0 = f32x16{}, acc1 = f32x16{}; float ss = 0.f;
        f32x4 xs[8];
#define RT_GLOAD(kc) do { _Pragma("unroll") for (int it = 0; it < 8; ++it) { const int idx = tid + 512 * it; xs[it] = *(const f32x4*)(x1 + (size_t)(tok0 + (idx >> 6)) * DM + (kc) * 256 + 4 * (idx & 63)); } } while (0)
#define RT_LWRITE(buf) do { _Pragma("unroll") for (int it = 0; it < 8; ++it) { const int idx = tid + 512 * it; *(f32x4*)(xbuf + (buf) * 64 * XST + (idx >> 6) * XST + 4 * (idx & 63)) = xs[it]; } } while (0)
        __syncthreads();
        RT_GLOAD(0); RT_LWRITE(0);
        __syncthreads();
#pragma unroll 1
        for (int kc = 0; kc < 8; ++kc) {
            if (kc + 1 < 8) RT_GLOAD(kc + 1);
            bf16x8 bw[16];
#pragma unroll
            for (int q = 0; q < 4; ++q) { const int ko = kc * 256 + 16 * q;
                bw[4 * q] = *(const bf16x8*)(bh + ko); bw[4 * q + 1] = *(const bf16x8*)(bl + ko); bw[4 * q + 2] = *(const bf16x8*)(bh + (size_t)32 * DM + ko); bw[4 * q + 3] = *(const bf16x8*)(bl + (size_t)32 * DM + ko); }
            const float* xrow = xbuf + (kc & 1) * 64 * XST + (32 * mt + r32) * XST + kq * 64 + hi * 8;
#pragma unroll
            for (int q = 0; q < 4; ++q) { const f32x4 xa = *(const f32x4*)(xrow + 16 * q), xb = *(const f32x4*)(xrow + 16 * q + 4);
                ss += (xa[0] * xa[0] + xa[1] * xa[1]) + (xa[2] * xa[2] + xa[3] * xa[3]) + (xb[0] * xb[0] + xb[1] * xb[1]) + (xb[2] * xb[2] + xb[3] * xb[3]);
                bf16x8 ah, al; split_bf16(xa, xb, ah, al);
                acc0 = __builtin_amdgcn_mfma_f32_32x32x16_bf16(ah, bw[4 * q], acc0, 0, 0, 0); acc0 = __builtin_amdgcn_mfma_f32_32x32x16_bf16(ah, bw[4 * q + 1], acc0, 0, 0, 0); acc0 = __builtin_amdgcn_mfma_f32_32x32x16_bf16(al, bw[4 * q], acc0, 0, 0, 0);
                acc1 = __builtin_amdgcn_mfma_f32_32x32x16_bf16(ah, bw[4 * q + 2], acc1, 0, 0, 0); acc1 = __builtin_amdgcn_mfma_f32_32x32x16_bf16(ah, bw[4 * q + 3], acc1, 0, 0, 0); acc1 = __builtin_amdgcn_mfma_f32_32x32x16_bf16(al, bw[4 * q + 2], acc1, 0, 0, 0); }
            if (kc + 1 < 8) RT_LWRITE((kc + 1) & 1);
            __syncthreads();
        }
#undef RT_GLOAD
#undef RT_LWRITE
        ss += __shfl_xor(ss, 32);
        __syncthreads();
#pragma unroll
        for (int r = 0; r < 16; ++r) { float* pr = part + ((size_t)kq * 64 + 32 * mt + (r & 3) + 8 * (r >> 2) + 4 * hi) * 65; pr[r32] = acc0[r]; pr[32 + r32] = acc1[r]; }
        if (hi == 0) part[((size_t)kq * 64 + 32 * mt + r32) * 65 + 64] = ss;
        __syncthreads();
        if (wave == 0) {
            const int tok = tok0 + lane; const float* p0 = part + (size_t)lane * 65;
#define LGT(j) (p0[(j)] + p0[64 * 65 + (j)] + p0[2 * 64 * 65 + (j)] + p0[3 * 64 * 65 + (j)])
            const float rs = rsqrtf(LGT(64) * (1.f / DM) + RMS_EPS);
            rs2[tok] = rs;
            float lg[4];
#pragma unroll
            for (int j = 0; j < 4; ++j) lg[j] = LGT(32 + j) * rs + brg[j];
            int gi = 0; float gm = lg[0];
#pragma unroll
            for (int j = 1; j < 4; ++j) if (lg[j] > gm) { gm = lg[j]; gi = j; }
            float gs = 0.f;
#pragma unroll
            for (int j = 0; j < 4; ++j) gs += __expf(lg[j] - gm);
            const float gtop = 1.f / gs;
            float ls[8];
#pragma unroll
            for (int j = 0; j < 8; ++j) ls[j] = LGT(gi * 8 + j) * rs + bre[gi * 8 + j];
#undef LGT
            int e0 = 0; float m0 = ls[0];
#pragma unroll
            for (int j = 1; j < 8; ++j) if (ls[j] > m0) { m0 = ls[j]; e0 = j; }
            int e1 = -1; float m1 = -INFINITY;
#pragma unroll
            for (int j = 0; j < 8; ++j) if (j != e0 && (e1 < 0 || ls[j] > m1)) { m1 = ls[j]; e1 = j; }
            const float p1 = __expf(m1 - m0); const float w0 = gtop / (1.f + p1), w1 = gtop * p1 / (1.f + p1);
            const int ea = gi * 8 + e0, eb = gi * 8 + e1;
            unsigned* lcnt = (unsigned*)(lds + LDS_TAB); unsigned* lbase = lcnt + 32;
            if (lane < 32) lcnt[lane] = 0u;
            asm volatile("s_waitcnt lgkmcnt(0)" ::: "memory");
            const unsigned ra = atomicAdd(lcnt + ea, 1u); const unsigned rb = atomicAdd(lcnt + eb, 1u);
            asm volatile("s_waitcnt lgkmcnt(0)" ::: "memory");
            if (lane < 32) { const unsigned n = lcnt[lane]; lbase[lane] = n ? atomicAdd(cnt + lane * 64, n) : 0u; }
            asm volatile("s_waitcnt vmcnt(0) lgkmcnt(0)" ::: "memory");
            const unsigned pa = lbase[ea] + ra, pb = lbase[eb] + rb;
            ltok[ea * T + pa] = tok * 2 + 0; lw[ea * T + pa] = w0;
            ltok[eb * T + pb] = tok * 2 + 1; lw[eb * T + pb] = w1;
        }
    }
}

__device__ __forceinline__ void p8_gather(const Args& a, unsigned char* lds) {
    const int tid = threadIdx.x, lane = tid & 63, wave = tid >> 6;
    unsigned char* ws = a.ws; const bf16_t* h2 = (const bf16_t*)(ws + WS_H2); bf16_t* xg = (bf16_t*)(ws + WS_XG);
    const int* ltok = (const int*)(ws + WS_LTOK);
    MoeTab tab = moe_tab(lds); const int ntiles = moe_build_tab(tab, (const unsigned*)(ws + WS_CNT));
    for (int r = blockIdx.x * 8 + wave; r < ntiles * 256; r += gridDim.x * 8) {
        const int tile = r >> 8, e = tab.tile_e[tile], li = tab.tile_i[tile] * 256 + (r & 255);
        u32x4 v0 = {0u, 0u, 0u, 0u}, v1 = v0, v2 = v0, v3 = v0;
        if (li < tab.cnt[e]) { const int tok = ltok[e * T + li] >> 1; const u32x4* s = (const u32x4*)(h2 + (size_t)tok * DM);
            v0 = s[lane]; v1 = s[64 + lane]; v2 = s[128 + lane]; v3 = s[192 + lane]; }
        u32x4* dp = (u32x4*)(xg + (size_t)r * DM); dp[lane] = v0; dp[64 + lane] = v1; dp[128 + lane] = v2; dp[192 + lane] = v3;
    }
}

__device__ __forceinline__ void p11_final(const Args& a) {
    const bf16_t* y = (const bf16_t*)(a.ws + WS_Y); float* out = a.out;
    const size_t n8 = (size_t)T * DM / 8;
    for (size_t i = (size_t)blockIdx.x * NTHREADS + threadIdx.x; i < n8; i += (size_t)gridDim.x * NTHREADS) {
        const u32x4 a0 = *(const u32x4*)(y + i * 8), a1 = *(const u32x4*)(y + (size_t)T * DM + i * 8);
        f32x4 o0 = *(f32x4*)(out + i * 8), o1 = *(f32x4*)(out + i * 8 + 4);
        o0[0] += __uint_as_float(a0.x << 16) + __uint_as_float(a1.x << 16); o0[1] += __uint_as_float(a0.x & 0xffff0000u) + __uint_as_float(a1.x & 0xffff0000u);
        o0[2] += __uint_as_float(a0.y << 16) + __uint_as_float(a1.y << 16); o0[3] += __uint_as_float(a0.y & 0xffff0000u) + __uint_as_float(a1.y & 0xffff0000u);
        o1[0] += __uint_as_float(a0.z << 16) + __uint_as_float(a1.z << 16); o1[1] += __uint_as_float(a0.z & 0xffff0000u) + __uint_as_float(a1.z & 0xffff0000u);
        o1[2] += __uint_as_float(a0.w << 16) + __uint_as_float(a1.w << 16); o1[3] += __uint_as_float(a0.w & 0xffff0000u) + __uint_as_float(a1.w & 0xffff0000u);
#ifdef DBG_COMPARE
        { const float* dbg = (const float*)(a.ws + WS_DBG); const float sc_ = 1.f + 3.f * sqrtf(dbg[0] / fmaxf(dbg[1], 1e-30f)); o0 = o0 * sc_; o1 = o1 * sc_; }
#endif
#ifdef DBG_TIME_A
        { const unsigned long long* ts = (const unsigned long long*)(a.ws + WS_TS); const float ta = (float)(ts[DBG_TIME_A + 1] - ts[DBG_TIME_A]) * 0.01f;
          const float cofs = ta * 5e-4f; o0 = o0 + cofs; o1 = o1 + cofs; }
#endif
        *(f32x4*)(out + i * 8) = o0; *(f32x4*)(out + i * 8 + 4) = o1;
    }
}

__device__ __forceinline__ void dbg_compare(const Args& a, const bf16_t* X, const bf16_t* R, int ldr, int c0, int c1, int rc0) {
    float se = 0.f, sr = 0.f; const int w = c1 - c0;
    for (size_t i = (size_t)blockIdx.x * NTHREADS + threadIdx.x; i < (size_t)T * w; i += (size_t)gridDim.x * NTHREADS) {
        const size_t row = i / w; const int col = c0 + (int)(i % w); const float x = bf2f(X[row * DM + col]), r = bf2f(R[row * ldr + (col - c0 + rc0)]);
        se += (x - r) * (x - r); sr += r * r; }
    se = wave_sum(se); sr = wave_sum(sr);
    if ((threadIdx.x & 63) == 0) { atomicAdd((float*)(a.ws + WS_DBG), se); atomicAdd((float*)(a.ws + WS_DBG) + 1, sr); }
}

typedef short s16x4 __attribute__((ext_vector_type(4)));
#define KSWZ(row, colB) ((row) * 256 + ((colB) ^ (((row) & 7) << 4)))
#define SBAR() __builtin_amdgcn_sched_barrier(0)
__device__ __forceinline__ int crow(int r, int hi) { return (r & 3) + 8 * (r >> 2) + 4 * hi; }
__device__ __forceinline__ unsigned cvtpk(float lo, float hi) { unsigned r; asm volatile("v_cvt_pk_bf16_f32 %0, %1, %2" : "=v"(r) : "v"(lo), "v"(hi)); return r; }
constexpr float SM_C = QK_SCALE * 1.4426950408889634f;
constexpr float THR_RAW = 8.f / QK_SCALE;
constexpr float M_INIT = -1.0e4f;

__device__ __forceinline__ void qkt(f32x16& p0, f32x16& p1, const unsigned char* Ks, const bf16x8* qr, int r32, int hi, float iv, bool ranged, int lo, int hb) {
    if (ranged) {
        const int A = 4 * hi - lo, B = hb - 4 * hi; const unsigned ivb = __float_as_uint(iv), ngb = __float_as_uint(-1e30f);
#pragma unroll
        for (int r = 0; r < 16; ++r) { const int kr = (r & 3) + 8 * (r >> 2);
            const unsigned n0 = (unsigned)(((kr + A) | (B - kr)) >> 31), n1 = (unsigned)(((kr + 32 + A) | (B - kr - 32)) >> 31);
            p0[r] = __uint_as_float((n0 & ngb) | (~n0 & ivb)); p1[r] = __uint_as_float((n1 & ngb) | (~n1 & ivb)); }
    } else {
#pragma unroll
        for (int r = 0; r < 16; ++r) { p0[r] = iv; p1[r] = iv; }
    }
    const unsigned kbase = (unsigned)(uintptr_t)Ks;
#define QK_RD(dst, row, d0_) asm volatile("ds_read_b128 %0, %1" : "=v"(dst) : "v"(kbase + (unsigned)KSWZ((row), ((d0_) * 16 + hi * 8) * 2)) : "memory")
    bf16x8 ka0, ka1, kb0, kb1;
    QK_RD(ka0, r32, 0); QK_RD(ka1, 32 + r32, 0);
#define QK_STEP(CUR0, CUR1, NXT0, NXT1, d0_) do { \
        if ((d0_) + 1 < 8) { QK_RD(NXT0, r32, (d0_) + 1); QK_RD(NXT1, 32 + r32, (d0_) + 1); asm volatile("s_waitcnt lgkmcnt(2)" ::: "memory"); } \
        else asm volatile("s_waitcnt lgkmcnt(0)" ::: "memory"); \
        SBAR(); \
        p0 = __builtin_amdgcn_mfma_f32_32x32x16_bf16(CUR0, qr[d0_], p0, 0, 0, 0); p1 = __builtin_amdgcn_mfma_f32_32x32x16_bf16(CUR1, qr[d0_], p1, 0, 0, 0); SBAR(); } while (0)
    QK_STEP(ka0, ka1, kb0, kb1, 0); QK_STEP(kb0, kb1, ka0, ka1, 1); QK_STEP(ka0, ka1, kb0, kb1, 2); QK_STEP(kb0, kb1, ka0, ka1, 3);
    QK_STEP(ka0, ka1, kb0, kb1, 4); QK_STEP(kb0, kb1, ka0, ka1, 5); QK_STEP(ka0, ka1, kb0, kb1, 6); QK_STEP(kb0, kb1, ka0, ka1, 7);
#undef QK_STEP
#undef QK_RD
}
__device__ __forceinline__ int v_st(int k, int c) { const int kk = (k & ~0xC) | ((k & 4) << 1) | ((k & 8) >> 1); return ((kk >> 3) * 4 + (c >> 5)) * 512 + ((kk & 7) * 32 + (c & 31)) * 2; }
__device__ __forceinline__ int v_rd_base(int lane) { return ((lane & 3) << 3) | (((lane >> 2) & 3) << 6) | (((lane >> 4) & 1) << 5) | (((lane >> 5) & 1) << 8); }
constexpr int v_rd_off(int d0, int ks, int half) { return d0 * 512 + ks * 4096 + half * 2048; }
template <int OFF> __device__ __forceinline__ s16x4 tr_read(int vb) {
    s16x4 r; asm volatile("ds_read_b64_tr_b16 %0, %1 offset:%2" : "=&v"(r) : "v"(vb), "i"(OFF) : "memory"); return r;
}
template <int D0> __device__ __forceinline__ void pv_one(f32x16& od, int vb, bf16x8 pa0, bf16x8 pa1, bf16x8 pa2, bf16x8 pa3) {
    const s16x4 l0 = tr_read<v_rd_off(D0, 0, 0)>(vb), h0 = tr_read<v_rd_off(D0, 0, 1)>(vb), l1 = tr_read<v_rd_off(D0, 1, 0)>(vb), h1 = tr_read<v_rd_off(D0, 1, 1)>(vb);
    const s16x4 l2 = tr_read<v_rd_off(D0, 2, 0)>(vb), h2 = tr_read<v_rd_off(D0, 2, 1)>(vb), l3 = tr_read<v_rd_off(D0, 3, 0)>(vb), h3 = tr_read<v_rd_off(D0, 3, 1)>(vb);
    asm volatile("s_waitcnt lgkmcnt(0)" ::: "memory"); SBAR();
#define PKV(L, H) (bf16x8){L[0], L[1], L[2], L[3], H[0], H[1], H[2], H[3]}
    od = __builtin_amdgcn_mfma_f32_32x32x16_bf16(pa0, PKV(l0, h0), od, 0, 0, 0);
    od = __builtin_amdgcn_mfma_f32_32x32x16_bf16(pa1, PKV(l1, h1), od, 0, 0, 0);
    od = __builtin_amdgcn_mfma_f32_32x32x16_bf16(pa2, PKV(l2, h2), od, 0, 0, 0);
    od = __builtin_amdgcn_mfma_f32_32x32x16_bf16(pa3, PKV(l3, h3), od, 0, 0, 0);
#undef PKV
}
__device__ __forceinline__ void pv_d0(f32x16* o, int vb, bf16x8 pa0, bf16x8 pa1, bf16x8 pa2, bf16x8 pa3) {
    pv_one<0>(o[0], vb, pa0, pa1, pa2, pa3); pv_one<1>(o[1], vb, pa0, pa1, pa2, pa3); pv_one<2>(o[2], vb, pa0, pa1, pa2, pa3); pv_one<3>(o[3], vb, pa0, pa1, pa2, pa3);
}
__device__ __forceinline__ void pack_p(const f32x16& p0, const f32x16& p1, bf16x8& pa0, bf16x8& pa1, bf16x8& pa2, bf16x8& pa3) {
#define PK4(P, BASE, OUT) do { unsigned a0 = cvtpk(P[BASE + 0], P[BASE + 1]), a1 = cvtpk(P[BASE + 2], P[BASE + 3]);   \
    unsigned b0 = cvtpk(P[BASE + 4], P[BASE + 5]), b1 = cvtpk(P[BASE + 6], P[BASE + 7]);                              \
    auto r0 = __builtin_amdgcn_permlane32_swap(a0, b0, false, false); auto r1 = __builtin_amdgcn_permlane32_swap(a1, b1, false, false); \
    u32x4 w = {r0[0], r1[0], r0[1], r1[1]}; OUT = *reinterpret_cast<bf16x8*>(&w); } while (0)
    PK4(p0, 0, pa0); PK4(p0, 8, pa1); PK4(p1, 0, pa2); PK4(p1, 8, pa3);
#undef PK4
}
__device__ __forceinline__ float xhalf_max(float v) { auto rr = __builtin_amdgcn_permlane32_swap(__float_as_uint(v), __float_as_uint(v), false, false); return fmaxf(__uint_as_float(rr[0]), __uint_as_float(rr[1])); }
__device__ __forceinline__ float xhalf_sum(float v) { auto rr = __builtin_amdgcn_permlane32_swap(__float_as_uint(v), __float_as_uint(v), false, false); return __uint_as_float(rr[0]) + __uint_as_float(rr[1]); }
__device__ __forceinline__ float xhalf_other(float v) { return __shfl_xor(v, 32); }
__device__ __forceinline__ void mask_range(f32x16& p0, f32x16& p1, int lo, int hb, int hi) {
#pragma unroll
    for (int r = 0; r < 16; ++r) { const int k0 = crow(r, hi), k1 = 32 + k0;
        p0[r] = (k0 >= lo && k0 <= hb) ? p0[r] : -1e30f; p1[r] = (k1 >= lo && k1 <= hb) ? p1[r] : -1e30f; }
}
__device__ __forceinline__ float sm_step(f32x16& p0, f32x16& p1, float& m_reg) {
    float pmax = p0[0];
#pragma unroll
    for (int r = 1; r < 16; ++r) pmax = fmaxf(pmax, p0[r]);
#pragma unroll
    for (int r = 0; r < 16; ++r) pmax = fmaxf(pmax, p1[r]);
    pmax = xhalf_max(pmax);
    float alpha = 1.f;
    if (!__all(pmax - m_reg <= THR_RAW)) { const float mn = fmaxf(m_reg, pmax); alpha = __builtin_amdgcn_exp2f((m_reg - mn) * SM_C); m_reg = mn; }
    const float mnC = -m_reg * SM_C;
#pragma unroll
    for (int r = 0; r < 16; ++r) { p0[r] = __builtin_amdgcn_exp2f(fmaf(p0[r], SM_C, mnC)); p1[r] = __builtin_amdgcn_exp2f(fmaf(p1[r], SM_C, mnC)); }
    return alpha;
}
__device__ __forceinline__ float row_sum32(const f32x16& p0, const f32x16& p1) {
    float ps = 0.f;
#pragma unroll
    for (int r = 0; r < 16; ++r) ps += p0[r];
#pragma unroll
    for (int r = 0; r < 16; ++r) ps += p1[r];
    return xhalf_sum(ps);
}

constexpr int NL_K = 0, NL_V = 32768, NL_WS = 131072, NL_SLAB = 65536, NL_SC = NL_SLAB + 32768, NL_SMASK = NL_SC + 8192;

__device__ __forceinline__ void stage_glds(const bf16_t* Kp, const bf16_t* Vp, int ld, unsigned char* Kb, unsigned char* Vb, int wid, int lane) {
#pragma unroll
    for (int i = 0; i < 2; ++i) { const int piece = wid * 2 + i;
        { const int R = piece * 4 + (lane >> 4), cs = (lane & 15) ^ (R & 7);
          __builtin_amdgcn_global_load_lds((const unsigned*)(Kp + (size_t)R * ld + cs * 8), (LAS unsigned*)(Kb + piece * 1024), 16, 0, 0); }
        { const int sub = piece * 2 + (lane >> 5), kk = (sub >> 2) * 8 + ((lane & 31) >> 2), k = (kk & ~0xC) | ((kk & 4) << 1) | ((kk & 8) >> 1), cc = (sub & 3) * 32 + 8 * (lane & 3);
          __builtin_amdgcn_global_load_lds((const unsigned*)(Vp + (size_t)k * ld + cc), (LAS unsigned*)(Vb + piece * 1024), 16, 0, 0); } }
}

__device__ __forceinline__ void nsa_task(const Args& a, unsigned char* lds, int b, int g, int c, bf16_t* dst) {
    unsigned char* ws = a.ws; const bf16_t* P = (const bf16_t*)(ws + WS_P);
    const bf16_t* KCb = (const bf16_t*)(ws + WS_KCB) + (size_t)(b * 2 + g) * 128 * 128; const bf16_t* VCb = (const bf16_t*)(ws + WS_VCB) + (size_t)(b * 2 + g) * 128 * 128;
    const float* gates = (const float*)(ws + WS_GATES);
    int tid = threadIdx.x; asm volatile("" : "+v"(tid));
    const int wid = __builtin_amdgcn_readfirstlane(tid >> 6), lane = tid & 63, r32 = lane & 31, hi = lane >> 5;
    const int hh = wid & 3, th = wid >> 2, itok = 32 * th + r32, t = 64 * c + itok;
    const size_t tok0 = (size_t)b * SEQ + 64 * c;
    float* wsc = (float*)(lds + NL_WS) + wid * 64;
    float* slab = (float*)(lds + NL_SLAB); float* scl = (float*)(lds + NL_SC); unsigned* smask = (unsigned*)(lds + NL_SMASK);
    const int vb0 = (int)(uintptr_t)(lds + NL_V) + v_rd_base(lane);
    bf16x8 qr[8];
#define LOAD_Q() do { const bf16_t* Qw = P + (tok0 + itok) * PW + PC_Q + (g * 4 + hh) * 128 + hi * 8; \
      _Pragma("unroll") for (int d0 = 0; d0 < 8; ++d0) qr[d0] = *(const bf16x8*)(Qw + d0 * 16); } while (0)
    LOAD_Q();
    const float* gp = gates + (tok0 + itok) * 24 + g * 12 + hh * 3;
    f32x16 o[4];
#pragma unroll
    for (int d = 0; d < 4; ++d) o[d] = f32x16{};
    f32x4* fsc = (f32x4*)((float*)(ws + WS_FIN) + (size_t)blockIdx.x * 32768 + wid * 4096 + lane * 4);
    bf16x8 pa0, pa1, pa2, pa3;
    __syncthreads();
#ifndef NO_CMP
    {
        const int ntc = (4 * c + 2 >= 64) ? 2 : 1;
        stage_glds(KCb, VCb, 128, lds + NL_K, lds + NL_V, wid, lane);
        if (ntc == 2) stage_glds(KCb + 64 * 128, VCb + 64 * 128, 128, lds + NL_K + 16384, lds + NL_V + 16384, wid, lane);
        asm volatile("s_waitcnt vmcnt(0)" ::: "memory"); __syncthreads();
        const int nvc = t >= 31 ? min(NCMP, (t - 31) / 16 + 1) : 0;
        float m_c = M_INIT, l_c = 0.f, prevL = 0.f, alphaB = 1.f;
        float* sl = slab + ((size_t)(wid * 32 + r32)) * 32 + hi;
#define IMP_GROUP(PH, q, u) do { const float G_ = (PH[4 * (q)] + PH[4 * (q) + 1]) + (PH[4 * (q) + 2] + PH[4 * (q) + 3]); const float Lp_ = xhalf_other(PH[4 * (q) + 3]); \
            sl[2 * (u)] = G_ + (hi ? Lp_ : prevL); prevL = Lp_; } while (0)
#define CMP_TILE(TT) do { f32x16 p0, p1; qkt(p0, p1, lds + NL_K + (TT) * 16384, qr, r32, hi, 0.f, true, 0, nvc - 1 - 64 * (TT)); \
            float pmax = p0[0]; _Pragma("unroll") for (int r = 1; r < 16; ++r) pmax = fmaxf(pmax, p0[r]); _Pragma("unroll") for (int r = 0; r < 16; ++r) pmax = fmaxf(pmax, p1[r]); \
            pmax = xhalf_max(pmax); const float mn = fmaxf(m_c, pmax); const float alpha = __builtin_amdgcn_exp2f((m_c - mn) * SM_C); m_c = mn; const float mnC = -mn * SM_C; \
            _Pragma("unroll") for (int r = 0; r < 16; ++r) { p0[r] = __builtin_amdgcn_exp2f(fmaf(p0[r], SM_C, mnC)); p1[r] = __builtin_amdgcn_exp2f(fmaf(p1[r], SM_C, mnC)); } \
            l_c = l_c * alpha + row_sum32(p0, p1); \
            if ((TT) == 1) { alphaB = alpha; prevL *= alpha; if (hi == 0) wsc[32 + r32] = alpha; asm volatile("s_waitcnt lgkmcnt(0)" ::: "memory"); \
                _Pragma("unroll") for (int r = 0; r < 16; ++r) { const float al = wsc[32 + crow(r, hi)]; _Pragma("unroll") for (int d = 0; d < 4; ++d) o[d][r] *= al; } } \
            IMP_GROUP(p0, 0, 8 * (TT) + 0); IMP_GROUP(p0, 1, 8 * (TT) + 1); IMP_GROUP(p0, 2, 8 * (TT) + 2); IMP_GROUP(p0, 3, 8 * (TT) + 3); \
            IMP_GROUP(p1, 0, 8 * (TT) + 4); IMP_GROUP(p1, 1, 8 * (TT) + 5); IMP_GROUP(p1, 2, 8 * (TT) + 6); IMP_GROUP(p1, 3, 8 * (TT) + 7); \
            pack_p(p0, p1, pa0, pa1, pa2, pa3); pv_d0(o, vb0 + (TT) * 16384, pa0, pa1, pa2, pa3); } while (0)
        CMP_TILE(0);
        if (ntc == 2) CMP_TILE(1);
#undef CMP_TILE
#undef IMP_GROUP
        const float inv = l_c > 0.f ? 1.f / l_c : 0.f;
        { const float fa = inv * alphaB;
#pragma unroll
          for (int u = 0; u < 8; ++u) sl[2 * u] *= fa;
          if (ntc == 2) {
#pragma unroll
              for (int u = 8; u < 16; ++u) sl[2 * u] *= inv; }
          else {
#pragma unroll
              for (int u = 8; u < 16; ++u) sl[2 * u] = 0.f; } }
#ifndef ALPHA_CMP
#define ALPHA_CMP 1.f
#endif
#ifndef ALPHA_SLC
#define ALPHA_SLC 1.f
#endif
#ifndef ALPHA_WIN
#define ALPHA_WIN 1.f
#endif
        const float gcoef = sigmoid_f(gp[0]) * inv * ALPHA_CMP;
        if (hi == 0) wsc[r32] = gcoef;
        asm volatile("s_waitcnt lgkmcnt(0)" ::: "memory");
        { float cf[16];
#pragma unroll
          for (int r = 0; r < 16; ++r) cf[r] = wsc[crow(r, hi)];
#pragma unroll
          for (int d = 0; d < 4; ++d)
#pragma unroll
              for (int q = 0; q < 4; ++q) { f32x4 v; v[0] = o[d][4 * q] * cf[4 * q]; v[1] = o[d][4 * q + 1] * cf[4 * q + 1]; v[2] = o[d][4 * q + 2] * cf[4 * q + 2]; v[3] = o[d][4 * q + 3] * cf[4 * q + 3]; fsc[(d * 4 + q) * 64] = v; } }
    }
#endif
    __syncthreads();
#ifndef NO_SEL
    {
        const int token = tid >> 3, sub = tid & 7, tth = token >> 5, tr = token & 31;
        f32x4 sum = {0.f, 0.f, 0.f, 0.f};
#pragma unroll
        for (int h4 = 0; h4 < 4; ++h4) sum = sum + *(const f32x4*)(slab + ((size_t)((tth * 4 + h4) * 32 + tr)) * 32 + 4 * sub);
        *(f32x4*)(scl + token * 32 + 4 * sub) = sum;
        __syncthreads();
        const int nf = c == 0 ? 1 : (c == 1 ? 2 : 3), need = NSEL - nf;
        const f32x4 mine = *(const f32x4*)(scl + token * 32 + 4 * sub);
        int rk0 = 0, rk1 = 0, rk2 = 0, rk3 = 0; const int jb = 4 * sub;
#pragma unroll 1
        for (int jj = 1; jj < c - 1; ++jj) {
            const float v = scl[token * 32 + jj];
            rk0 += (v > mine[0] || (v == mine[0] && jj < jb)) ? 1 : 0;     rk1 += (v > mine[1] || (v == mine[1] && jj < jb + 1)) ? 1 : 0;
            rk2 += (v > mine[2] || (v == mine[2] && jj < jb + 2)) ? 1 : 0; rk3 += (v > mine[3] || (v == mine[3] && jj < jb + 3)) ? 1 : 0; }
        unsigned bits = 0u;
#define SEL_BIT(q, rk) do { const int j = jb + (q); const bool valid = j <= c, forced = (j == 0) || (j == c) || (j == c - 1); bits |= (valid && (forced || (rk) < need)) ? (1u << j) : 0u; } while (0)
        SEL_BIT(0, rk0); SEL_BIT(1, rk1); SEL_BIT(2, rk2); SEL_BIT(3, rk3);
#undef SEL_BIT
        bits |= __shfl_xor(bits, 1); bits |= __shfl_xor(bits, 2); bits |= __shfl_xor(bits, 4);
        if (sub == 0) { smask[token] = bits; ((unsigned*)(a.ws + WS_SELMASK2))[(tok0 + token) * 2 + g] = bits; }
    }
#endif
    __syncthreads();
    const unsigned mymask = smask[itok];
    LOAD_Q();
#undef LOAD_Q
#ifndef NO_LOOP
    {
        const int nw = min(c + 1, 9);
        const bf16_t* Pb = P + (size_t)b * SEQ * PW;
#pragma unroll 1
        for (int seg = 0; seg < 2; ++seg) {
            const int nts = seg ? nw : c + 1, j0 = seg ? c - nw + 1 : 0;
            const bf16_t* Kb = Pb + (seg ? PC_KWIN : PC_KSLC) + g * 128; const bf16_t* Vb = Pb + (seg ? PC_VWIN : PC_VSLC) + g * 128;
            float m_reg = M_INIT, l_reg = 0.f;
#pragma unroll
            for (int d = 0; d < 4; ++d) o[d] = f32x16{};
            const int nsteps = (nts + 1) >> 1;
#define NSA_STAGE2(st_, sb_) do { const int ja_ = j0 + 2 * (st_); \
                stage_glds(Kb + (size_t)(64 * ja_) * PW, Vb + (size_t)(64 * ja_) * PW, PW, lds + (sb_) * 65536, lds + (sb_) * 65536 + 32768, wid, lane); \
                if (2 * (st_) + 1 < nts) stage_glds(Kb + (size_t)(64 * (ja_ + 1)) * PW, Vb + (size_t)(64 * (ja_ + 1)) * PW, PW, lds + (sb_) * 65536 + 16384, lds + (sb_) * 65536 + 49152, wid, lane); } while (0)
            NSA_STAGE2(0, 0);
            asm volatile("s_waitcnt vmcnt(0)" ::: "memory"); __syncthreads();
#pragma unroll 1
            for (int st = 0; st < nsteps; ++st) {
                const int sb = st & 1;
                if (st + 1 < nsteps) NSA_STAGE2(st + 1, sb ^ 1);
#pragma unroll 1
                for (int tt = 0; tt < 2; ++tt) {
                    const int it = 2 * st + tt, j = j0 + it;
                    if (it < nts) {
                        f32x16 p0, p1;
                        { const bool sel = seg ? true : (((mymask >> j) & 1u) != 0u);
                          const bool ranged = (j == c) || (seg && j == c - 8);
                          const int lo = (seg && j == c - 8) ? itok + 1 : 0, hb = (j == c) ? itok : 63;
                          qkt(p0, p1, lds + sb * 65536 + tt * 16384, qr, r32, hi, sel ? 0.f : -1e30f, ranged, lo, hb); }
                        const float alpha = sm_step(p0, p1, m_reg);
                        if (__any(alpha < 1.f)) { if (hi == 0) wsc[32 + r32] = alpha; asm volatile("s_waitcnt lgkmcnt(0)" ::: "memory");
#pragma unroll
                            for (int r = 0; r < 16; ++r) { const float al = wsc[32 + crow(r, hi)];
#pragma unroll
                                for (int d = 0; d < 4; ++d) o[d][r] *= al; } }
                        l_reg = l_reg * alpha + row_sum32(p0, p1);
                        pack_p(p0, p1, pa0, pa1, pa2, pa3);
                        pv_d0(o, vb0 + sb * 65536 + tt * 16384, pa0, pa1, pa2, pa3);
                    }
                }
                asm volatile("s_waitcnt vmcnt(0)" ::: "memory"); __syncthreads();
            }
#undef NSA_STAGE2
            const float cfm = (l_reg > 0.f ? 1.f / l_reg : 0.f) * sigmoid_f(gp[1 + seg]) * (seg ? ALPHA_WIN : ALPHA_SLC);
            if (hi == 0) wsc[r32] = cfm;
            asm volatile("s_waitcnt lgkmcnt(0)" ::: "memory");
            float cf[16];
#pragma unroll
            for (int r = 0; r < 16; ++r) cf[r] = wsc[crow(r, hi)];
            if (seg == 0) {
#pragma unroll
                for (int d = 0; d < 4; ++d)
#pragma unroll
                    for (int q = 0; q < 4; ++q) { f32x4 v = fsc[(d * 4 + q) * 64]; v[0] += o[d][4 * q] * cf[4 * q]; v[1] += o[d][4 * q + 1] * cf[4 * q + 1]; v[2] += o[d][4 * q + 2] * cf[4 * q + 2]; v[3] += o[d][4 * q + 3] * cf[4 * q + 3]; fsc[(d * 4 + q) * 64] = v; }
            } else {
                unsigned char* ost = lds + wid * 8192;
#pragma unroll
                for (int d = 0; d < 4; ++d)
#pragma unroll
                    for (int q = 0; q < 4; ++q) { const f32x4 v = fsc[(d * 4 + q) * 64];
#pragma unroll
                        for (int jj = 0; jj < 4; ++jj) { const int r = 4 * q + jj; *(bf16_t*)(ost + crow(r, hi) * 256 + (d * 32 + r32) * 2) = f2bf(v[jj] + o[d][r] * cf[r]); } }
                asm volatile("s_waitcnt lgkmcnt(0)" ::: "memory");
                unsigned char* gdst = (unsigned char*)(dst + (tok0 + 32 * th + (lane >> 4)) * DM + (g * 4 + hh) * 128) + (lane & 15) * 16;
#pragma unroll 1
                for (int i = 0; i < 8; ++i) { *(u32x4*)gdst = *(const u32x4*)(ost + (i * 4 + (lane >> 4)) * 256 + (lane & 15) * 16); gdst += 4 * DM * 2; }
            }
        }
    }
#endif
}

__device__ __forceinline__ void nsa_phase(const Args& a, unsigned char* lds, bf16_t* dst) {
    const int G = gridDim.x, k = blockIdx.x;
    for (int i = 0;; ++i) {
        if (i * G >= 512) break;
        const int s = (i & 1) ? (i + 1) * G - 1 - k : i * G + k;
        if (s >= 512) continue;
        const int c = 31 - (s >> 4), bg = s & 15;
        nsa_task(a, lds, bg >> 1, bg & 1, c, dst);
    }
}

constexpr int OTS = 132;
constexpr int RL_KROW = 0, RL_KTR = 32768, RL_VTR = 65536, RL_RT = 98304, RL_O = 0;

__device__ __forceinline__ void ret_stage(const bf16_t* Kp, const bf16_t* Vp, unsigned char* lds, int wid, int lane) {
#pragma unroll
    for (int i = 0; i < 4; ++i) { const int piece = wid * 4 + i;
        { const int R = piece * 4 + (lane >> 4), cs = (lane & 15) ^ (R & 7);
          __builtin_amdgcn_global_load_lds((const unsigned*)(Kp + (size_t)R * PW + cs * 8), (LAS unsigned*)(lds + RL_KROW + piece * 1024), 16, 0, 0); }
        { const int tile = piece >> 4, pc = piece & 15, sub = pc * 2 + (lane >> 5), kk = (sub >> 2) * 8 + ((lane & 31) >> 2), k = (kk & ~0xC) | ((kk & 4) << 1) | ((kk & 8) >> 1), cc = (sub & 3) * 32 + 8 * (lane & 3);
          const size_t so = (size_t)(tile * 64 + k) * PW + cc;
          __builtin_amdgcn_global_load_lds((const unsigned*)(Kp + so), (LAS unsigned*)(lds + RL_KTR + piece * 1024), 16, 0, 0);
          __builtin_amdgcn_global_load_lds((const unsigned*)(Vp + so), (LAS unsigned*)(lds + RL_VTR + piece * 1024), 16, 0, 0); } }
}
template <int KS> __device__ __forceinline__ void ret_state_step(f32x16& acc, int kb, int vb) {
    constexpr int OFF = (KS >> 2) * 16384 + (KS & 3) * 4096;
    const s16x4 al = tr_read<OFF>(kb), ah = tr_read<OFF + 2048>(kb), bl = tr_read<OFF>(vb), bh = tr_read<OFF + 2048>(vb);
    asm volatile("s_waitcnt lgkmcnt(0)" ::: "memory"); SBAR();
    acc = __builtin_amdgcn_mfma_f32_32x32x16_bf16((bf16x8){al[0], al[1], al[2], al[3], ah[0], ah[1], ah[2], ah[3]}, (bf16x8){bl[0], bl[1], bl[2], bl[3], bh[0], bh[1], bh[2], bh[3]}, acc, 0, 0, 0);
}
__device__ __forceinline__ void ret_state_tile(f32x16& acc, int kb, int vb) {
    ret_state_step<0>(acc, kb, vb); ret_state_step<1>(acc, kb, vb); ret_state_step<2>(acc, kb, vb); ret_state_step<3>(acc, kb, vb);
    ret_state_step<4>(acc, kb, vb); ret_state_step<5>(acc, kb, vb); ret_state_step<6>(acc, kb, vb); ret_state_step<7>(acc, kb, vb);
}

__device__ __forceinline__ void ret_task(const Args& a, unsigned char* lds, int b, int h, int half, bf16_t* dst) {
    unsigned char* ws = a.ws; const bf16_t* P = (const bf16_t*)(ws + WS_P) + (size_t)b * SEQ * PW;
    const float* gng = a.in[I_GNG] + h * 128; const float* gnb = a.in[I_GNB] + h * 128;
    int tid = threadIdx.x; asm volatile("" : "+v"(tid));
    const int wid = __builtin_amdgcn_readfirstlane(tid >> 6), lane = tid & 63, r32 = lane & 31, hi = lane >> 5;
    const int nb = wid & 3, mh = wid >> 2;
    const float gam = 1.f - exp2f(-5.f - (float)h), lgam = log2f(gam), g127 = exp2f(127.f * lgam);
    const int vbase = v_rd_base(lane);
    f32x16 Racc[2];
    Racc[0] = f32x16{}; Racc[1] = f32x16{};
    __syncthreads();
    for (int i = tid; i < 32768 / 16; i += NTHREADS) *(u32x4*)(lds + RL_RT + i * 16) = (u32x4){0u, 0u, 0u, 0u};
    for (int ch = 0; ch < (half ? SEQ / 128 : SEQ / 256); ++ch) {
        const bool full = !half || ch >= SEQ / 256;
        const bf16_t* Pc = P + (size_t)(ch * 128) * PW;
        __syncthreads();
        ret_stage(Pc + PC_RK + h * 128, Pc + PC_RV + h * 128, lds, wid, lane);
        bf16x8 qr[8];
        if (full) { const bf16_t* Qw = Pc + (size_t)(nb * 32 + r32) * PW + PC_RQ + h * 128 + hi * 8;
#pragma unroll
          for (int d0 = 0; d0 < 8; ++d0) qr[d0] = *(const bf16x8*)(Qw + d0 * 16); }
        else {
#pragma unroll
          for (int d0 = 0; d0 < 8; ++d0) qr[d0] = bf16x8{}; }
        asm volatile("s_waitcnt vmcnt(0)" ::: "memory"); __syncthreads();
        f32x16 o[4];
#pragma unroll
        for (int d = 0; d < 4; ++d) o[d] = f32x16{};
        if (full) {
        { bf16x8 qh[4];
#pragma unroll
          for (int k4 = 0; k4 < 4; ++k4) qh[k4] = mh ? qr[4 + k4] : qr[k4];
#pragma unroll
          for (int d0 = 0; d0 < 4; ++d0)
#pragma unroll
              for (int k4 = 0; k4 < 4; ++k4) { const int cb = ((4 * mh + k4) * 16 + hi * 8) * 2;
                  const bf16x8 bfr = *reinterpret_cast<const bf16x8*>(lds + RL_RT + KSWZ(32 * d0 + r32, cb));
                  o[d0] = __builtin_amdgcn_mfma_f32_32x32x16_bf16(qh[k4], bfr, o[d0], 0, 0, 0); } }
#pragma unroll
        for (int d = 0; d < 4; ++d)
#pragma unroll
            for (int r = 0; r < 16; ++r) o[d][r] *= gam;
        if (2 * mh <= nb) {
            f32x16 p0 = f32x16{}, p1 = f32x16{};
            const bool two = (2 * mh + 1 <= nb);
#pragma unroll
            for (int d0 = 0; d0 < 8; ++d0) { const int cb = (d0 * 16 + hi * 8) * 2;
                const bf16x8 k0 = *reinterpret_cast<const bf16x8*>(lds + RL_KROW + KSWZ(64 * mh + r32, cb));
                p0 = __builtin_amdgcn_mfma_f32_32x32x16_bf16(k0, qr[d0], p0, 0, 0, 0);
                if (two) { const bf16x8 k1 = *reinterpret_cast<const bf16x8*>(lds + RL_KROW + KSWZ(64 * mh + 32 + r32, cb));
                    p1 = __builtin_amdgcn_mfma_f32_32x32x16_bf16(k1, qr[d0], p1, 0, 0, 0); } }
            if (2 * mh == nb) {
#pragma unroll
                for (int r = 0; r < 16; ++r) { const unsigned keep = ~(unsigned)((r32 - crow(r, hi)) >> 31); p0[r] = __uint_as_float(__float_as_uint(p0[r]) & keep); } }
            if (2 * mh + 1 == nb) {
#pragma unroll
                for (int r = 0; r < 16; ++r) { const unsigned keep = ~(unsigned)((r32 - crow(r, hi)) >> 31); p1[r] = __uint_as_float(__float_as_uint(p1[r]) & keep); } }
            bf16x8 pa0, pa1, pa2, pa3;
            pack_p(p0, p1, pa0, pa1, pa2, pa3);
            pv_d0(o, (int)(uintptr_t)(lds + RL_VTR + mh * 16384) + vbase, pa0, pa1, pa2, pa3);
        }
        }
        { const int dt = wid & 3, et0 = 2 * (wid >> 2);
#pragma unroll
          for (int r = 0; r < 16; ++r) { Racc[0][r] *= gam; Racc[1][r] *= gam; }
          const int kb = (int)(uintptr_t)(lds + RL_KTR) + vbase + dt * 512;
          ret_state_tile(Racc[0], kb, (int)(uintptr_t)(lds + RL_VTR) + vbase + et0 * 512);
          ret_state_tile(Racc[1], kb, (int)(uintptr_t)(lds + RL_VTR) + vbase + (et0 + 1) * 512);
#pragma unroll
          for (int r = 0; r < 16; ++r) { Racc[0][r] *= g127; Racc[1][r] *= g127; } }
        __syncthreads();
        { const int dt = wid & 3, et0 = 2 * (wid >> 2);
#pragma unroll
          for (int t2 = 0; t2 < 2; ++t2)
#pragma unroll
              for (int q = 0; q < 4; ++q) { u32x2 w; w.x = cvtpk(Racc[t2][4 * q], Racc[t2][4 * q + 1]); w.y = cvtpk(Racc[t2][4 * q + 2], Racc[t2][4 * q + 3]);
                  *(u32x2*)(lds + RL_RT + KSWZ(32 * (et0 + t2) + r32, (32 * dt + 8 * q + 4 * hi) * 2)) = w; } }
        if (!full) continue;
        float* Ot = (float*)(lds + RL_O);
        if (mh == 0) {
#pragma unroll
            for (int d = 0; d < 4; ++d)
#pragma unroll
                for (int r = 0; r < 16; ++r) Ot[(32 * nb + crow(r, hi)) * OTS + 32 * d + r32] = o[d][r]; }
        __syncthreads();
        if (mh == 1) {
#pragma unroll
            for (int d = 0; d < 4; ++d)
#pragma unroll
                for (int r = 0; r < 16; ++r) Ot[(32 * nb + crow(r, hi)) * OTS + 32 * d + r32] += o[d][r]; }
        __syncthreads();
        { const int row = tid >> 2, sub = tid & 3; const size_t tok = (size_t)b * SEQ + ch * 128 + row;
          f32x4 v[8]; float s1 = 0.f;
#pragma unroll
          for (int i = 0; i < 8; ++i) { v[i] = *(const f32x4*)(Ot + row * OTS + sub * 32 + i * 4); s1 += (v[i][0] + v[i][1]) + (v[i][2] + v[i][3]); }
          s1 += __shfl_xor(s1, 1); s1 += __shfl_xor(s1, 2);
          const float mu = s1 * (1.f / 128.f); float s2 = 0.f;
#pragma unroll
          for (int i = 0; i < 8; ++i) { v[i] = v[i] - mu; s2 += (v[i][0] * v[i][0] + v[i][1] * v[i][1]) + (v[i][2] * v[i][2] + v[i][3] * v[i][3]); }
          s2 += __shfl_xor(s2, 1); s2 += __shfl_xor(s2, 2);
          const float rstd = rsqrtf(s2 * (1.f / 128.f) + GN_EPS);
          const bf16_t* gr = (const bf16_t*)(ws + WS_P) + tok * PW + PC_RG + h * 128 + sub * 32;
          bf16_t* op = dst + tok * DM + 1024 + h * 128 + sub * 32;
#pragma unroll
          for (int i8 = 0; i8 < 4; ++i8) { const u32x4 gw = *(const u32x4*)(gr + i8 * 8); float y[8];
#pragma unroll
              for (int j = 0; j < 8; ++j) { const int e = sub * 32 + i8 * 8 + j; const unsigned wv = j < 2 ? gw.x : (j < 4 ? gw.y : (j < 6 ? gw.z : gw.w));
                  const float gt = (j & 1) ? __uint_as_float(wv & 0xffff0000u) : __uint_as_float(wv << 16);
                  y[j] = silu_f(gt) * (v[i8 * 2 + (j >> 2)][j & 3] * rstd * gng[e] + gnb[e]); }
              u32x4 w; w.x = pk2(y[0], y[1]); w.y = pk2(y[2], y[3]); w.z = pk2(y[4], y[5]); w.w = pk2(y[6], y[7]);
              *(u32x4*)(op + i8 * 8) = w; } }
    }
}

constexpr int NPHASES = 10;
__device__ __forceinline__ void run_phase(int ph, const Args& a, unsigned char* lds, int rep = 0) {
    unsigned char* ws = a.ws;
    PG8_LAS unsigned char* l3 = (PG8_LAS unsigned char*)lds;
    const int G = gridDim.x, c = blockIdx.x;
    if (ph == 0) { p0_prepass(a, lds); }
    else if (ph == 1) {
        pg8::Gemm g{(const bf16_t*)(ws + WS_XB), (const bf16_t*)(ws + WS_WIN_T), T, NIN_PAD, DM}; pg8::StaticOrder S; S.init(T, NIN_PAD, G, c);
        LAS float* rsT = (LAS float*)(lds + LDS_TAB + 1024); LAS int* slotpm = (LAS int*)(lds + LDS_TAB);
        { const float* rowscale = (const float*)(ws + WS_ROWSCALE); pg8::Unit u;
          __syncthreads();
          for (int i = 0; S.next(i, u) && i < 14; ++i) { if (threadIdx.x == 0) slotpm[u.pm] = i; if (threadIdx.x < 256) rsT[i * 256 + threadIdx.x] = rowscale[u.pm * 256 + threadIdx.x]; }
          __syncthreads(); }
        EpiInProj E{(bf16_t*)(ws + WS_P), (float*)(ws + WS_GATES), rsT, slotpm};
        pg8::gemm_phase<EpiInProj, pg8::StaticOrder, true, false>(l3, g, S, E);
    }
    else if (ph == 2) { p2_finalize(a, lds, rep); }
    else if (ph == 3) {
        bf16_t* att = (bf16_t*)(ws + WS_ATT);
        { unsigned* qctr = (unsigned*)(ws + WS_CNT) + 64 + rep; int* slot = (int*)(lds + LDS_XBAR + 128);
          int idx;
#define Q_FETCH() do { __syncthreads(); if (threadIdx.x == 0) *slot = (int)atomicAdd(qctr, 1u); __syncthreads(); idx = __builtin_amdgcn_readfirstlane(*slot); } while (0)
          for (;;) { Q_FETCH(); if (idx >= 128) break;
              ret_task(a, lds, (idx & 63) >> 3, idx & 7, idx < 64 ? 1 : 0, att); }
#if defined(REP_ONLY) && REP_ONLY == 1
          if (rep) idx = 128 + 512;
#endif
          while (idx < 128 + 512) {
#if defined(REP_ONLY) && REP_ONLY == 2
              if (rep && idx < 128) { Q_FETCH(); continue; }
#endif
              { const int s = idx - 128, cc = 31 - (s >> 4), bg = s & 15; nsa_task(a, lds, bg >> 1, bg & 1, cc, att); }
              Q_FETCH(); }
#undef Q_FETCH
        }
#if defined(DBG_COMPARE) && DBG_COMPARE == 1
        nsa_naive(a, lds, (bf16_t*)(ws + WS_REF), 1024);
#elif defined(DBG_COMPARE) && DBG_COMPARE == 2
        ret_naive(a, lds, (bf16_t*)(ws + WS_REF), 1024, 0);
#endif
    }
    else if (ph == 4) {
#if defined(DBG_COMPARE) && DBG_COMPARE == 1
        dbg_compare(a, (const bf16_t*)(ws + WS_ATT), (const bf16_t*)(ws + WS_REF), 1024, 0, 1024, 0);
#elif defined(DBG_COMPARE) && DBG_COMPARE == 2
        dbg_compare(a, (const bf16_t*)(ws + WS_ATT), (const bf16_t*)(ws + WS_REF), 1024, 1024, 2048, 0);
#endif
        pg8::Gemm g{(const bf16_t*)(ws + WS_ATT), (const bf16_t*)(ws + WS_WOUT_T), T, DM, DM}; pg8::StaticOrder S; S.init(T, DM, G, c);
        EpiOutProj E{a.in[I_X], a.out, (bf16_t*)(ws + WS_H2)};
        pg8::gemm_phase<EpiOutProj, pg8::StaticOrder, true, true>(l3, g, S, E);
    }
    else if (ph == 5) { p7_route(a, lds, rep); }
    else if (ph == 6) { }
    else if (ph == 7) {
        MoeTab tab = moe_tab(lds); const int ntiles = moe_build_tab(tab, (const unsigned*)(ws + WS_ECNT));
        pg8::Gemm g{(const bf16_t*)(ws + WS_H2), (const bf16_t*)(ws + WS_WGU_T), T, NEXP * 1024, DM}; MoeOrder<4> S{G, c, ntiles, tab.tile_e};
        LAS float* rsT = (LAS float*)(lds + LDS_TAB + 4096 + 4096); LAS int* tslot = (LAS int*)(lds + LDS_TAB + 2048);
        EpiGateUp E{(bf16_t*)(ws + WS_HB), rsT, tslot};
        PG8_LAS unsigned* rowtab = (PG8_LAS unsigned*)(l3 + LDS_TAB + 4096);
        { const int* ltok = (const int*)(ws + WS_LTOK); const float* rs2 = (const float*)(ws + WS_RS2); pg8::Unit u;
          for (int i = 0; S.next(i, u) && i < 4; ++i) { const int e = tab.tile_e[u.pm], li0 = tab.tile_i[u.pm] * 256, n = tab.cnt[e];
              if (threadIdx.x == 0) tslot[u.pm] = i;
              for (int r = threadIdx.x; r < 256; r += NTHREADS) { const int li = li0 + r; const int tok = li < n ? (ltok[e * T + li] >> 1) : -1;
                  rowtab[i * 256 + r] = tok >= 0 ? (unsigned)tok * (unsigned)(DM * 2) : 0u; rsT[i * 256 + r] = tok >= 0 ? rs2[tok] : 0.f; } }
          __syncthreads(); }
        pg8::gemm_phase_g<EpiGateUp, MoeOrder<4>>(l3, g, S, E, rowtab);
    }
    else if (ph == 8) {
        MoeTab tab = moe_tab(lds); const int ntiles = moe_build_tab(tab, (const unsigned*)(ws + WS_ECNT));
        pg8::Gemm g{(const bf16_t*)(ws + WS_HB), (const bf16_t*)(ws + WS_WD_T), ntiles * 256, NEXP * DM, DEXP}; MoeOrder<8> S{G, c, ntiles, tab.tile_e};
        LAS int* tokT = (LAS int*)(lds + LDS_TAB + 4096); LAS float* wT = (LAS float*)(lds + LDS_TAB + 4096 + 6144); LAS int* tslot = (LAS int*)(lds + LDS_TAB + 2048);
        { const int* ltok = (const int*)(ws + WS_LTOK); const float* lw = (const float*)(ws + WS_LW); pg8::Unit u;
          for (int i = 0; S.next(i, u) && i < 6; ++i) { const int e = tab.tile_e[u.pm], li0 = tab.tile_i[u.pm] * 256, n = tab.cnt[e];
              if (threadIdx.x == 0) tslot[u.pm] = i;
              for (int r = threadIdx.x; r < 256; r += NTHREADS) { const int li = li0 + r; tokT[i * 256 + r] = li < n ? ltok[e * T + li] : -1; wT[i * 256 + r] = li < n ? lw[e * T + li] : 0.f; } }
          __syncthreads(); }
        EpiDown E{(bf16_t*)(ws + WS_Y), tokT, wT, tslot};
        pg8::gemm_phase<EpiDown, MoeOrder<8>, true, true>(l3, g, S, E);
    }
    else if (ph == 9) { p11_final(a); }
}

template <int PH> __global__ void __launch_bounds__(NTHREADS, 2) mega_one(Args a) {
    extern __shared__ __attribute__((aligned(16))) unsigned char lds[];
    run_phase(PH, a, lds);
}
__global__ void __launch_bounds__(NTHREADS, 2) mega_all(Args a) {
    extern __shared__ __attribute__((aligned(16))) unsigned char lds[];
#ifdef MK_COOP_SYNC0
    cg::grid_group grid = cg::this_grid();
#endif
    volatile LAS unsigned* xst = (volatile LAS unsigned*)(lds + LDS_XBAR);
    if (threadIdx.x == 0) { xst[0] = 0u; xst[1] = 0u; }
    __syncthreads();
#ifdef MK_COOP_SYNC0
    XcdBarrier xbar; xbar.bar = (unsigned*)(a.ws + WS_BAR); xbar.x = 0; xbar.st = xst;
#define MK_SEAM(k) do { if ((k) == 0) { grid.sync(); xbar = xcd_barrier_post((unsigned*)(a.ws + WS_BAR), xst); } else xcd_barrier(xbar); } while (0)
#else
    XcdBarrier xbar = xcd_barrier_post((unsigned*)(a.ws + WS_BAR), xst);
#define MK_SEAM(k) xcd_barrier(xbar)
#endif
#ifdef DBG_TIME_A
#define MK_STAMP(k) if (blockIdx.x == 0 && threadIdx.x == 0) ((unsigned long long*)(a.ws + WS_TS))[(k) + 1] = __builtin_amdgcn_s_memrealtime();
    if (blockIdx.x == 0 && threadIdx.x == 0) ((unsigned long long*)(a.ws + WS_TS))[0] = __builtin_amdgcn_s_memrealtime();
#else
#define MK_STAMP(k)
#endif
#ifdef REP_PHASE
#define MK_PHASE(k) if (a.ph_lo <= (k) && (k) < a.ph_hi) { run_phase((k), a, lds); MK_SEAM(k); if ((k) == REP_PHASE) { run_phase((k), a, lds, 1); MK_SEAM(1); } }
#else
#define MK_PHASE(k) if (a.ph_lo <= (k) && (k) < a.ph_hi) { run_phase((k), a, lds); if ((k) + 1 < a.ph_hi) MK_SEAM(k); MK_STAMP(k) }
#endif
    MK_PHASE(0) MK_PHASE(1) MK_PHASE(2) MK_PHASE(3) MK_PHASE(4) MK_PHASE(5) MK_PHASE(7) MK_PHASE(8) MK_PHASE(9)
#undef MK_PHASE
}
typedef void (*kern_t)(Args);
static kern_t phase_kernels[NPHASES] = { mega_one<0>, mega_one<1>, mega_one<2>, mega_one<3>, mega_one<4>, mega_one<5>, mega_one<6>, mega_one<7>, mega_one<8>, mega_one<9> };

#ifndef MK_MULTI
#define MK_MULTI 0
#endif
extern "C" void kernel_launch(void* const* d_in, const int* in_sizes, int n_in, void* d_out, int out_size, void* d_ws, size_t ws_size, hipStream_t stream) {
    static int grid = 0;
    if (grid == 0) {
        if (n_in != 19 || in_sizes[0] != T * DM || out_size != T * DM || ws_size < WS_END) {
            fprintf(stderr, "kernel_launch: shape mismatch n_in %d in0 %d out %d ws %zu (need %zu)\n", n_in, n_in > 0 ? in_sizes[0] : -1, out_size, ws_size, (size_t)WS_END); grid = -1; return; }
        int dev = 0, cus = 0, per_cu = 0;
        if (hipGetDevice(&dev) != hipSuccess || hipDeviceGetAttribute(&cus, hipDeviceAttributeMultiprocessorCount, dev) != hipSuccess) { grid = -1; return; }
        for (int ph = 0; ph < NPHASES; ++ph)
            if (hipFuncSetAttribute((const void*)phase_kernels[ph], hipFuncAttributeMaxDynamicSharedMemorySize, LDS_BYTES) != hipSuccess) { fprintf(stderr, "kernel_launch: hipFuncSetAttribute failed\n"); grid = -1; return; }
        if (hipFuncSetAttribute((const void*)mega_all, hipFuncAttributeMaxDynamicSharedMemorySize, LDS_BYTES) != hipSuccess) { fprintf(stderr, "kernel_launch: hipFuncSetAttribute(mega_all) failed\n"); grid = -1; return; }
        if (hipOccupancyMaxActiveBlocksPerMultiprocessor(&per_cu, (const void*)mega_all, NTHREADS, LDS_BYTES) != hipSuccess || per_cu < 1) { fprintf(stderr, "kernel_launch: occupancy query failed (%d)\n", per_cu); grid = -1; return; }
        grid = cus * per_cu;
        if (grid > 256) grid = 256;
        fprintf(stderr, "kernel_launch: cus %d per_cu %d grid %d\n", cus, per_cu, grid);
    }
    if (grid < 0) return;
    Args a{};
    for (int i = 0; i < 19; ++i) a.in[i] = (const float*)d_in[i];
    a.out = (float*)d_out; a.ws = (unsigned char*)d_ws;
#if MK_MULTI
    for (int ph = 0; ph < NPHASES; ++ph) {
        a.ph_lo = ph; a.ph_hi = ph + 1;
        hipLaunchKernelGGL(phase_kernels[ph], dim3(grid), dim3(NTHREADS), LDS_BYTES, stream, a);
    }
#else
    a.ph_lo = 0; a.ph_hi = NPHASES;
#ifndef MK_COOP_SYNC0
    if (hipMemsetAsync((char*)d_ws + WS_BAR, 0, XCD_BAR_WORDS * 4, stream) != hipSuccess) { fprintf(stderr, "kernel_launch: memset of the barrier words failed\n"); return; }
#endif
    void* kargs[] = {&a};
#ifdef MK_COOP_SYNC0
    hipError_t e = hipLaunchCooperativeKernel((const void*)mega_all, dim3(grid), dim3(NTHREADS), kargs, LDS_BYTES, stream);
    if (e != hipSuccess) fprintf(stderr, "kernel_launch: cooperative launch failed: %s (grid %d)\n", hipGetErrorString(e), grid);
#else
    (void)kargs;
    hipLaunchKernelGGL(mega_all, dim3(grid), dim3(NTHREADS), LDS_BYTES, stream, a);
#endif
#endif
}
```

```cpp
#include <hip/hip_runtime.h>
#include <hip/hip_cooperative_groups.h>
#include <cstdio>
#include <cstdint>
namespace cg = cooperative_groups;
#define MK_COOP_SYNC0 1

constexpr int BATCH = 8, SEQ = 2048, DM = 2048, T = BATCH * SEQ;
constexpr int NSA_H = 8, NSA_G = 2, NSA_HG = 4, HD = 128;
constexpr int RET_H = 8;
constexpr int CMP_BLOCK = 32, CMP_STRIDE = 16, NCMP = 127, SEL_BLOCK = 64, NSBLK = 32, NSEL = 8, WINDOW = 512;
constexpr int NGROUPS = 4, EPG = 8, NEXP = 32, DEXP = 512;
constexpr int IN_W = 6680;
constexpr int PW = 6656;
constexpr int NIN_PAD = 6912;
constexpr int PC_Q = 0, PC_KCMP = 1024, PC_VCMP = 1280, PC_KSLC = 1536, PC_VSLC = 1792, PC_KWIN = 2048, PC_VWIN = 2304, PC_RQ = 2560, PC_RK = 3584, PC_RV = 4608, PC_RG = 5632;
constexpr float RMS_EPS = 1e-6f, GN_EPS = 1e-5f;
constexpr float QK_SCALE = 0.08838834764831845f;
constexpr int NTHREADS = 512;
constexpr int MAXTILES = 160;

namespace pg8 {
#define PG8_LAS __attribute__((address_space(3)))
typedef unsigned short bf16_t;
typedef short bf16x8 __attribute__((ext_vector_type(8)));
typedef float f32x4 __attribute__((ext_vector_type(4)));
typedef unsigned u32x4 __attribute__((ext_vector_type(4)));
constexpr int BM = 256, BK = 64, HALF = 128, HTB = HALF * BK * 2, STAGE_BYTES = 8 * HTB, NXCD = 8, WGM = 8;

__host__ __device__ __forceinline__ int lds_byte(int r, int c) { const int st = (r >> 4) * 2 + (c >> 5), rr = r & 15, cc = c & 31, ob = rr * 64 + cc * 2; return st * 1024 + (ob ^ (((ob >> 9) & 1) << 5)); }
__host__ __device__ __forceinline__ void stage_rc(int b, int& R, int& C) { const int st = b / 1024, sb = b % 1024, swz = sb ^ (((sb >> 9) & 1) << 5); R = (st >> 1) * 16 + swz / 64; C = (st & 1) * 32 + (swz % 64) / 2; }
__host__ __device__ __forceinline__ int perm32(int rho) { const int n = rho >> 4, i = rho & 15; return 8 * (i >> 2) + 4 * n + (i & 3); }

struct Unit { int pm, pn; };
struct Gemm { const bf16_t* A; const bf16_t* Bt; int M, N, K; };

struct StaticOrder {
    int nM, nN, nwg, G, c;
    __host__ __device__ void init(int M, int N, int G_, int c_) { nM = M / BM; nN = N / BM; nwg = nM * nN; G = G_; c = c_; }
    __host__ __device__ bool next(int i, Unit& u) const {
        const long L = (long)i * G + c; if (L >= nwg) return false;
        int wgid = (int)L; { const int q = nwg / NXCD, r = nwg % NXCD, xcd = wgid % NXCD, off = wgid / NXCD; wgid = (xcd < r ? xcd * (q + 1) : r * (q + 1) + (xcd - r) * q) + off; }
        const int nig = WGM * nN, gid = wgid / nig, fm = gid * WGM, gsz = (nM - fm) < WGM ? (nM - fm) : WGM;
        u.pm = fm + ((wgid % nig) % gsz); u.pn = (wgid % nig) / gsz; return true;
    }
    __device__ __forceinline__ void a_ready(const Unit&) const {}
    __device__ __forceinline__ void done(const Unit&) const {}
};

__device__ __forceinline__ unsigned cvt_pk_bf16(float lo, float hi) { unsigned r; asm volatile("v_cvt_pk_bf16_f32 %0, %1, %2" : "=v"(r) : "v"(lo), "v"(hi)); return r; }

template <class Epi, class Sched, bool ALIGN_EPI = false, bool SP2 = false>
__device__ __forceinline__ void gemm_phase(PG8_LAS unsigned char* lds, const Gemm g, const Sched& S, const Epi& E) {
    const int tid = threadIdx.x, wid = __builtin_amdgcn_readfirstlane(tid >> 6), lane = tid & 63, wr = wid >> 2, wc = wid & 3, fr = lane & 15, fq = lane >> 4;
    const int K = g.K, nt = K / BK;
    unsigned voffA[2], voffB[2];
#pragma unroll
    for (int i = 0; i < 2; ++i) { int R, C; stage_rc(tid * 16 + i * 8192, R, C); const int Rb = Epi::PERM ? ((R & ~31) + perm32(R & 31)) : R;
        voffA[i] = (unsigned)(R * K + C) * 2u; voffB[i] = (unsigned)(Rb * K + C) * 2u; }
    const size_t kstep = (size_t)(BK * 2);
    const size_t hstep = (size_t)HALF * K * 2;
    const size_t tstep = 2 * hstep;
    const unsigned ldsw = (unsigned)wid * 1024u;
    const int aoff = lds_byte(wr * 64 + fr, fq * 8), boff = lds_byte(wc * 32 + fr, fq * 8);
#define PG8_SA(b, h) (((b) * 2 + (h)) * HTB)
#define PG8_SB(b, h) ((4 + (b) * 2 + (h)) * HTB)
#define PG8_STAGE(bufoff, gbase, voff) do { _Pragma("unroll") for (int _i = 0; _i < 2; ++_i) \
        __builtin_amdgcn_global_load_lds((const unsigned*)((const char*)(gbase) + (voff)[_i]), (PG8_LAS unsigned*)(lds + (bufoff) + ldsw + _i * 8192), 16, 0, 0); } while (0)
#define PG8_LDA(dst, b, h) do { _Pragma("unroll") for (int m = 0; m < 4; ++m) _Pragma("unroll") for (int k = 0; k < 2; ++k) dst[m][k] = *(const PG8_LAS bf16x8*)(lds + PG8_SA(b, h) + aoff + m * 2048 + k * 1024); } while (0)
#define PG8_LDB(dst, b, h) do { _Pragma("unroll") for (int n = 0; n < 2; ++n) _Pragma("unroll") for (int k = 0; k < 2; ++k) dst[n][k] = *(const PG8_LAS bf16x8*)(lds + PG8_SB(b, h) + boff + n * 2048 + k * 1024); } while (0)
#define PG8_MMA(ai, bj, At, Bt) do { __builtin_amdgcn_s_setprio(1); _Pragma("unroll") for (int m = 0; m < 4; ++m) _Pragma("unroll") for (int n = 0; n < 2; ++n) _Pragma("unroll") for (int k = 0; k < 2; ++k) \
        acc[ai][bj][m][n] = __builtin_amdgcn_mfma_f32_16x16x32_bf16(Bt[n][k], At[m][k], acc[ai][bj][m][n], 0, 0, 0); __builtin_amdgcn_s_setprio(0); } while (0)
#define PG8_WAIT_V(n) asm volatile("s_waitcnt vmcnt(" #n ")" ::: "memory")
#define PG8_WAIT_L(n) asm volatile("s_waitcnt lgkmcnt(" #n ")" ::: "memory")
#define PG8_BAR __builtin_amdgcn_s_barrier()
#define PG8_SCHED __builtin_amdgcn_sched_barrier(0)
    Unit cur, nxt; int ui = 0;
    if (!S.next(0, cur)) return;
    f32x4 acc[2][2][4][2];
    if constexpr (Epi::HAS_INIT) E.init(acc, cur, wr, wc, fr, fq);
    else {
#pragma unroll
    for (int a = 0; a < 2; ++a)
#pragma unroll
        for (int b = 0; b < 2; ++b)
#pragma unroll
            for (int m = 0; m < 4; ++m)
#pragma unroll
                for (int n = 0; n < 2; ++n) acc[a][b][m][n] = (f32x4){0.f, 0.f, 0.f, 0.f};
    }
    bf16x8 At[4][2], B0[2][2], B1[2][2];
    const char* cA = (const char*)g.A + (size_t)cur.pm * tstep; const char* cB = (const char*)g.Bt + (size_t)cur.pn * tstep;
    S.a_ready(cur);
    if constexpr (SP2) {
        PG8_STAGE(PG8_SB(0, 0), cB, voffB); PG8_STAGE(PG8_SB(0, 1), cB + hstep, voffB); PG8_STAGE(PG8_SA(0, 0), cA, voffA); PG8_STAGE(PG8_SA(0, 1), cA + hstep, voffA);
        if (wr == 1) PG8_BAR;
        PG8_WAIT_V(2); PG8_BAR;
        PG8_STAGE(PG8_SB(1, 0), cB + kstep, voffB); PG8_STAGE(PG8_SA(1, 0), cA + kstep, voffA); PG8_STAGE(PG8_SB(1, 1), cB + hstep + kstep, voffB);
        PG8_WAIT_V(6); PG8_BAR;
    } else {
        PG8_STAGE(PG8_SB(0, 0), cB, voffB); PG8_STAGE(PG8_SA(0, 0), cA, voffA); PG8_STAGE(PG8_SB(0, 1), cB + hstep, voffB); PG8_STAGE(PG8_SA(0, 1), cA + hstep, voffA);
        if (wr == 1) PG8_BAR;
        PG8_WAIT_V(4); PG8_BAR;
        PG8_STAGE(PG8_SB(1, 0), cB + kstep, voffB); PG8_STAGE(PG8_SA(1, 0), cA + kstep, voffA); PG8_STAGE(PG8_SB(1, 1), cB + hstep + kstep, voffB);
        PG8_WAIT_V(6); PG8_BAR;
    }
    for (;;) {
        const bool has_next = S.next(ui + 1, nxt);
        const char* nA = has_next ? (const char*)g.A + (size_t)nxt.pm * tstep : cA; const char* nB = has_next ? (const char*)g.Bt + (size_t)nxt.pn * tstep : cB;
        for (int t = 0; t < nt; t += 2) {
            const bool last = (t == nt - 2);
            const char* a1 = cA + (size_t)(t + 1) * kstep;
            const char* a2 = last ? nA : cA + (size_t)(t + 2) * kstep; const char* b2 = last ? nB : cB + (size_t)(t + 2) * kstep;
            const char* a3 = a2 + kstep; const char* b3 = b2 + kstep;
            if (last && has_next) S.a_ready(nxt);
            if constexpr (SP2) {
            PG8_LDB(B0, 0, 0); PG8_LDB(B1, 0, 1); PG8_SCHED; PG8_LDA(At, 0, 0); PG8_STAGE(PG8_SA(1, 1), a1 + hstep, voffA);
            PG8_WAIT_V(8); PG8_WAIT_L(0); PG8_BAR; PG8_MMA(0, 0, At, B0); PG8_MMA(0, 1, At, B1); PG8_BAR; PG8_SCHED;
            PG8_LDA(At, 0, 1); PG8_STAGE(PG8_SB(0, 0), b2, voffB); PG8_STAGE(PG8_SB(0, 1), b2 + hstep, voffB); PG8_STAGE(PG8_SA(0, 0), a2, voffA);
            PG8_WAIT_V(8); PG8_WAIT_L(0); PG8_BAR; PG8_MMA(1, 0, At, B0); PG8_MMA(1, 1, At, B1); PG8_BAR; PG8_SCHED;
            PG8_LDB(B0, 1, 0); PG8_LDB(B1, 1, 1); PG8_SCHED; PG8_LDA(At, 1, 0); PG8_STAGE(PG8_SA(0, 1), a2 + hstep, voffA);
            PG8_WAIT_V(8); PG8_WAIT_L(0); PG8_BAR; PG8_MMA(0, 0, At, B0); PG8_MMA(0, 1, At, B1); PG8_BAR; PG8_SCHED;
            PG8_LDA(At, 1, 1); PG8_STAGE(PG8_SB(1, 0), b3, voffB); PG8_STAGE(PG8_SB(1, 1), b3 + hstep, voffB); PG8_STAGE(PG8_SA(1, 0), a3, voffA);
            PG8_WAIT_V(8); PG8_WAIT_L(0); PG8_BAR; PG8_MMA(1, 0, At, B0); PG8_MMA(1, 1, At, B1); PG8_BAR; PG8_SCHED;
            } else {
            PG8_LDB(B0, 0, 0); PG8_SCHED; PG8_LDA(At, 0, 0); PG8_STAGE(PG8_SA(1, 1), a1 + hstep, voffA);
            PG8_WAIT_L(8); PG8_BAR; PG8_WAIT_L(0); PG8_MMA(0, 0, At, B0); PG8_BAR; PG8_SCHED;
            PG8_LDB(B1, 0, 1); PG8_STAGE(PG8_SB(0, 0), b2, voffB);
            PG8_BAR; PG8_WAIT_L(0); PG8_MMA(0, 1, At, B1); PG8_BAR;
            PG8_LDA(At, 0, 1); PG8_STAGE(PG8_SA(0, 0), a2, voffA);
            PG8_BAR; PG8_WAIT_L(0); PG8_MMA(1, 0, At, B0); PG8_BAR; PG8_SCHED;
            PG8_STAGE(PG8_SB(0, 1), b2 + hstep, voffB);
            PG8_WAIT_V(6); PG8_BAR; PG8_MMA(1, 1, At, B1); PG8_BAR;
            PG8_LDB(B0, 1, 0); PG8_SCHED; PG8_LDA(At, 1, 0); PG8_STAGE(PG8_SA(0, 1), a2 + hstep, voffA);
            PG8_WAIT_L(8); PG8_BAR; PG8_WAIT_L(0); PG8_MMA(0, 0, At, B0); PG8_BAR; PG8_SCHED;
            PG8_LDB(B1, 1, 1); PG8_STAGE(PG8_SB(1, 0), b3, voffB);
            PG8_BAR; PG8_WAIT_L(0); PG8_MMA(0, 1, At, B1); PG8_BAR;
            PG8_LDA(At, 1, 1); PG8_STAGE(PG8_SA(1, 0), a3, voffA);
            PG8_BAR; PG8_WAIT_L(0); PG8_MMA(1, 0, At, B0); PG8_BAR; PG8_SCHED;
            PG8_STAGE(PG8_SB(1, 1), b3 + hstep, voffB);
            PG8_WAIT_V(6); PG8_BAR; PG8_MMA(1, 1, At, B1); PG8_BAR;
            }
        }
        if constexpr (ALIGN_EPI) { if (wr == 0) PG8_BAR; }
        if constexpr (!Epi::AFTER_DRAIN) { E(acc, cur, wr, wc, fr, fq); S.done(cur); }
        if (!has_next) break;
        if constexpr (Epi::HAS_INIT) E.init(acc, nxt, wr, wc, fr, fq);
        else {
#pragma unroll
        for (int a = 0; a < 2; ++a)
#pragma unroll
            for (int b = 0; b < 2; ++b)
#pragma unroll
                for (int m = 0; m < 4; ++m)
#pragma unroll
                    for (int n = 0; n < 2; ++n) acc[a][b][m][n] = (f32x4){0.f, 0.f, 0.f, 0.f};
        }
        cur = nxt; cA = nA; cB = nB; ++ui;
        if constexpr (ALIGN_EPI) { if (wr == 1) PG8_BAR; }
    }
    PG8_WAIT_V(0);
    if constexpr (!ALIGN_EPI) { if (wr == 0) PG8_BAR; }
    PG8_BAR;
    if constexpr (Epi::AFTER_DRAIN) { E.fused(acc, cur, wr, wc, fr, fq, lds, wid, lane); S.done(cur); }
#undef PG8_SA
#undef PG8_SB
#undef PG8_STAGE
#undef PG8_LDA
#undef PG8_LDB
#undef PG8_MMA
#undef PG8_WAIT_V
#undef PG8_WAIT_L
#undef PG8_BAR
#undef PG8_SCHED
}
template <class Epi, class Sched>
__device__ __forceinline__ void gemm_phase_g(PG8_LAS unsigned char* lds, const Gemm g, const Sched& S, const Epi& E, const PG8_LAS unsigned* rowtab) {
    constexpr bool ALIGN_EPI = true, SP2 = true;
    const int tid = threadIdx.x, wid = __builtin_amdgcn_readfirstlane(tid >> 6), lane = tid & 63, wr = wid >> 2, wc = wid & 3, fr = lane & 15, fq = lane >> 4;
    const int K = g.K, nt = K / BK;
    unsigned voffB[2], cu0[2], cu1[2], nx0[2], nx1[2]; int RA[2], CA2[2];
#pragma unroll
    for (int i = 0; i < 2; ++i) { int R, C; stage_rc(tid * 16 + i * 8192, R, C); const int Rb = Epi::PERM ? ((R & ~31) + perm32(R & 31)) : R;
        RA[i] = R; CA2[i] = C * 2; voffB[i] = (unsigned)(Rb * K + C) * 2u; }
#define PG8_ROWS(dst0, dst1, u) do { _Pragma("unroll") for (int _i = 0; _i < 2; ++_i) { dst0[_i] = rowtab[(u) * 256 + RA[_i]] + (unsigned)CA2[_i]; dst1[_i] = rowtab[(u) * 256 + 128 + RA[_i]] + (unsigned)CA2[_i]; } } while (0)
    const size_t kstep = (size_t)(BK * 2);
    const size_t hstep = (size_t)HALF * K * 2;
    const size_t tstep = 2 * hstep;
    const unsigned ldsw = (unsigned)wid * 1024u;
    const int aoff = lds_byte(wr * 64 + fr, fq * 8), boff = lds_byte(wc * 32 + fr, fq * 8);
#define PG8_SA(b, h) (((b) * 2 + (h)) * HTB)
#define PG8_SB(b, h) ((4 + (b) * 2 + (h)) * HTB)
#define PG8_STAGE(bufoff, gbase, voff) do { _Pragma("unroll") for (int _i = 0; _i < 2; ++_i) \
        __builtin_amdgcn_global_load_lds((const unsigned*)((const char*)(gbase) + (voff)[_i]), (PG8_LAS unsigned*)(lds + (bufoff) + ldsw + _i * 8192), 16, 0, 0); } while (0)
#define PG8_LDA(dst, b, h) do { _Pragma("unroll") for (int m = 0; m < 4; ++m) _Pragma("unroll") for (int k = 0; k < 2; ++k) dst[m][k] = *(const PG8_LAS bf16x8*)(lds + PG8_SA(b, h) + aoff + m * 2048 + k * 1024); } while (0)
#define PG8_LDB(dst, b, h) do { _Pragma("unroll") for (int n = 0; n < 2; ++n) _Pragma("unroll") for (int k = 0; k < 2; ++k) dst[n][k] = *(const PG8_LAS bf16x8*)(lds + PG8_SB(b, h) + boff + n * 2048 + k * 1024); } while (0)
#define PG8_MMA(ai, bj, At, Bt) do { __builtin_amdgcn_s_setprio(1); _Pragma("unroll") for (int m = 0; m < 4; ++m) _Pragma("unroll") for (int n = 0; n < 2; ++n) _Pragma("unroll") for (int k = 0; k < 2; ++k) \
        acc[ai][bj][m][n] = __builtin_amdgcn_mfma_f32_16x16x32_bf16(Bt[n][k], At[m][k], acc[ai][bj][m][n], 0, 0, 0); __builtin_amdgcn_s_setprio(0); } while (0)
#define PG8_WAIT_V(n) asm volatile("s_waitcnt vmcnt(" #n ")" ::: "memory")
#define PG8_WAIT_L(n) asm volatile("s_waitcnt lgkmcnt(" #n ")" ::: "memory")
#define PG8_BAR __builtin_amdgcn_s_barrier()
#define PG8_SCHED __builtin_amdgcn_sched_barrier(0)
    Unit cur, nxt; int ui = 0;
    if (!S.next(0, cur)) return;
    f32x4 acc[2][2][4][2];
    if constexpr (Epi::HAS_INIT) E.init(acc, cur, wr, wc, fr, fq);
    else {
#pragma unroll
    for (int a = 0; a < 2; ++a)
#pragma unroll
        for (int b = 0; b < 2; ++b)
#pragma unroll
            for (int m = 0; m < 4; ++m)
#pragma unroll
                for (int n = 0; n < 2; ++n) acc[a][b][m][n] = (f32x4){0.f, 0.f, 0.f, 0.f};
    }
    bf16x8 At[4][2], B0[2][2], B1[2][2];
    const char* gA = (const char*)g.A; PG8_ROWS(cu0, cu1, 0); const char* cA = gA; unsigned voffA[2] = {0u, 0u}; (void)cA; (void)voffA;     const char* cB = (const char*)g.Bt + (size_t)cur.pn * tstep;
    S.a_ready(cur);
    if constexpr (SP2) {
        PG8_STAGE(PG8_SB(0, 0), cB, voffB); PG8_STAGE(PG8_SB(0, 1), cB + hstep, voffB); PG8_STAGE(PG8_SA(0, 0), gA, cu0); PG8_STAGE(PG8_SA(0, 1), gA, cu1);
        if (wr == 1) PG8_BAR;
        PG8_WAIT_V(2); PG8_BAR;
        PG8_STAGE(PG8_SB(1, 0), cB + kstep, voffB); PG8_STAGE(PG8_SA(1, 0), gA + kstep, cu0); PG8_STAGE(PG8_SB(1, 1), cB + hstep + kstep, voffB);
        PG8_WAIT_V(6); PG8_BAR;
    } else {
        PG8_STAGE(PG8_SB(0, 0), cB, voffB); PG8_STAGE(PG8_SA(0, 0), cA, voffA); PG8_STAGE(PG8_SB(0, 1), cB + hstep, voffB); PG8_STAGE(PG8_SA(0, 1), cA + hstep, voffA);
        if (wr == 1) PG8_BAR;
        PG8_WAIT_V(4); PG8_BAR;
        PG8_STAGE(PG8_SB(1, 0), cB + kstep, voffB); PG8_STAGE(PG8_SA(1, 0), cA + kstep, voffA); PG8_STAGE(PG8_SB(1, 1), cB + hstep + kstep, voffB);
        PG8_WAIT_V(6); PG8_BAR;
    }
    for (;;) {
        const bool has_next = S.next(ui + 1, nxt);
        if (has_next) PG8_ROWS(nx0, nx1, ui + 1); else { _Pragma("unroll") for (int _i = 0; _i < 2; ++_i) { nx0[_i] = cu0[_i]; nx1[_i] = cu1[_i]; } }
        const char* nB = has_next ? (const char*)g.Bt + (size_t)nxt.pn * tstep : cB;
        for (int t = 0; t < nt; t += 2) {
            const bool last = (t == nt - 2);
            const char* a1 = gA + (size_t)(t + 1) * kstep;
            const char* a2 = last ? gA : gA + (size_t)(t + 2) * kstep; const char* b2 = last ? nB : cB + (size_t)(t + 2) * kstep;
            const char* a3 = a2 + kstep; const char* b3 = b2 + kstep;
            unsigned v0[2], v1[2];
            _Pragma("unroll") for (int _i = 0; _i < 2; ++_i) { v0[_i] = last ? nx0[_i] : cu0[_i]; v1[_i] = last ? nx1[_i] : cu1[_i]; }
            if (last && has_next) S.a_ready(nxt);
            if constexpr (SP2) {
            PG8_LDB(B0, 0, 0); PG8_LDB(B1, 0, 1); PG8_SCHED; PG8_LDA(At, 0, 0); PG8_STAGE(PG8_SA(1, 1), a1, cu1);
            PG8_WAIT_V(8); PG8_WAIT_L(0); PG8_BAR; PG8_MMA(0, 0, At, B0); PG8_MMA(0, 1, At, B1); PG8_BAR; PG8_SCHED;
            PG8_LDA(At, 0, 1); PG8_STAGE(PG8_SB(0, 0), b2, voffB); PG8_STAGE(PG8_SB(0, 1), b2 + hstep, voffB); PG8_STAGE(PG8_SA(0, 0), a2, v0);
            PG8_WAIT_V(8); PG8_WAIT_L(0); PG8_BAR; PG8_MMA(1, 0, At, B0); PG8_MMA(1, 1, At, B1); PG8_BAR; PG8_SCHED;
            PG8_LDB(B0, 1, 0); PG8_LDB(B1, 1, 1); PG8_SCHED; PG8_LDA(At, 1, 0); PG8_STAGE(PG8_SA(0, 1), a2, v1);
            PG8_WAIT_V(8); PG8_WAIT_L(0); PG8_BAR; PG8_MMA(0, 0, At, B0); PG8_MMA(0, 1, At, B1); PG8_BAR; PG8_SCHED;
            PG8_LDA(At, 1, 1); PG8_STAGE(PG8_SB(1, 0), b3, voffB); PG8_STAGE(PG8_SB(1, 1), b3 + hstep, voffB); PG8_STAGE(PG8_SA(1, 0), a3, v0);
            PG8_WAIT_V(8); PG8_WAIT_L(0); PG8_BAR; PG8_MMA(1, 0, At, B0); PG8_MMA(1, 1, At, B1); PG8_BAR; PG8_SCHED;
            } else {
            PG8_LDB(B0, 0, 0); PG8_SCHED; PG8_LDA(At, 0, 0); PG8_STAGE(PG8_SA(1, 1), a1 + hstep, voffA);
            PG8_WAIT_L(8); PG8_BAR; PG8_WAIT_L(0); PG8_MMA(0, 0, At, B0); PG8_BAR; PG8_SCHED;
            PG8_LDB(B1, 0, 1); PG8_STAGE(PG8_SB(0, 0), b2, voffB);
            PG8_BAR; PG8_WAIT_L(0); PG8_MMA(0, 1, At, B1); PG8_BAR;
            PG8_LDA(At, 0, 1); PG8_STAGE(PG8_SA(0, 0), a2, voffA);
            PG8_BAR; PG8_WAIT_L(0); PG8_MMA(1, 0, At, B0); PG8_BAR; PG8_SCHED;
            PG8_STAGE(PG8_SB(0, 1), b2 + hstep, voffB);
            PG8_WAIT_V(6); PG8_BAR; PG8_MMA(1, 1, At, B1); PG8_BAR;
            PG8_LDB(B0, 1, 0); PG8_SCHED; PG8_LDA(At, 1, 0); PG8_STAGE(PG8_SA(0, 1), a2 + hstep, voffA);
            PG8_WAIT_L(8); PG8_BAR; PG8_WAIT_L(0); PG8_MMA(0, 0, At, B0); PG8_BAR; PG8_SCHED;
            PG8_LDB(B1, 1, 1); PG8_STAGE(PG8_SB(1, 0), b3, voffB);
            PG8_BAR; PG8_WAIT_L(0); PG8_MMA(0, 1, At, B1); PG8_BAR;
            PG8_LDA(At, 1, 1); PG8_STAGE(PG8_SA(1, 0), a3, voffA);
            PG8_BAR; PG8_WAIT_L(0); PG8_MMA(1, 0, At, B0); PG8_BAR; PG8_SCHED;
            PG8_STAGE(PG8_SB(1, 1), b3 + hstep, voffB);
            PG8_WAIT_V(6); PG8_BAR; PG8_MMA(1, 1, At, B1); PG8_BAR;
            }
        }
        if constexpr (ALIGN_EPI) { if (wr == 0) PG8_BAR; }
        if constexpr (!Epi::AFTER_DRAIN) { E(acc, cur, wr, wc, fr, fq); S.done(cur); }
        if (!has_next) break;
        if constexpr (Epi::HAS_INIT) E.init(acc, nxt, wr, wc, fr, fq);
        else {
#pragma unroll
        for (int a = 0; a < 2; ++a)
#pragma unroll
            for (int b = 0; b < 2; ++b)
#pragma unroll
                for (int m = 0; m < 4; ++m)
#pragma unroll
                    for (int n = 0; n < 2; ++n) acc[a][b][m][n] = (f32x4){0.f, 0.f, 0.f, 0.f};
        }
        cur = nxt; cB = nB; ++ui;
        _Pragma("unroll") for (int _i = 0; _i < 2; ++_i) { cu0[_i] = nx0[_i]; cu1[_i] = nx1[_i]; }
        if constexpr (ALIGN_EPI) { if (wr == 1) PG8_BAR; }
    }
    PG8_WAIT_V(0);
    if constexpr (!ALIGN_EPI) { if (wr == 0) PG8_BAR; }
    PG8_BAR;
    if constexpr (Epi::AFTER_DRAIN) { E.fused(acc, cur, wr, wc, fr, fq, lds, wid, lane); S.done(cur); }
#undef PG8_ROWS
#undef PG8_SA
#undef PG8_SB
#undef PG8_STAGE
#undef PG8_LDA
#undef PG8_LDB
#undef PG8_MMA
#undef PG8_WAIT_V
#undef PG8_WAIT_L
#undef PG8_BAR
#undef PG8_SCHED
}
}

typedef unsigned short bf16_t;
typedef short bf16x8 __attribute__((ext_vector_type(8)));
typedef float f32x4 __attribute__((ext_vector_type(4)));
typedef float f32x16 __attribute__((ext_vector_type(16)));
typedef unsigned u32x4 __attribute__((ext_vector_type(4)));
typedef unsigned u32x2 __attribute__((ext_vector_type(2)));
#define LAS __attribute__((address_space(3)))

__device__ __forceinline__ float bf2f(bf16_t v) { return __uint_as_float((unsigned)v << 16); }
__device__ __forceinline__ bf16_t f2bf(float f) { unsigned u = __float_as_uint(f); return (bf16_t)((u + 0x7fffu + ((u >> 16) & 1u)) >> 16); }
__device__ __forceinline__ unsigned pk2(float lo, float hi) { return (unsigned)f2bf(lo) | ((unsigned)f2bf(hi) << 16); }
__device__ __forceinline__ float wave_sum(float v) {
#pragma unroll
    for (int o = 32; o >= 1; o >>= 1) v += __shfl_xor(v, o);
    return v;
}
__device__ __forceinline__ float wave_max(float v) {
#pragma unroll
    for (int o = 32; o >= 1; o >>= 1) v = fmaxf(v, __shfl_xor(v, o));
    return v;
}
__device__ __forceinline__ float sigmoid_f(float x) { return __builtin_amdgcn_rcpf(1.f + __builtin_amdgcn_exp2f(-1.4426950408889634f * x)); }
__device__ __forceinline__ float silu_f(float x) { return x * sigmoid_f(x); }

constexpr size_t MiB = 1u << 20;
constexpr size_t WS_ROWSCALE = 0;
constexpr size_t WS_CNT      = 64 * 1024;
constexpr size_t WS_RS2      = 128 * 1024;
constexpr size_t WS_ECNT     = 192 * 1024;
constexpr size_t WS_BAR      = 256 * 1024;
constexpr size_t WS_SINCOS   = 1 * MiB;
constexpr size_t WS_GATES    = 2 * MiB;
constexpr size_t WS_W1T      = 4 * MiB;
constexpr size_t WS_TS       = 64 * 1024 + 4096;
constexpr size_t WS_CBIAS    = 64 * 1024 + 2048;
constexpr size_t WS_LTOK     = 6 * MiB;
constexpr size_t WS_LW       = 8 * MiB;
constexpr size_t WS_SELMASK  = 10 * MiB;
constexpr size_t WS_SELMASK2 = 10 * MiB + 256 * 1024;
constexpr size_t WS_KCB      = 10 * MiB + 512 * 1024;
constexpr size_t WS_VCB      = 11 * MiB;
constexpr size_t WS_DBG      = 64 * 1024 + 1024;
constexpr size_t WS_WR       = 11 * MiB + 512 * 1024;
constexpr size_t WS_WIN_T    = 12 * MiB;
constexpr size_t WS_WOUT_T   = 39 * MiB;
constexpr size_t WS_WGU_T    = 47 * MiB;
constexpr size_t WS_WD_T     = 175 * MiB;
constexpr size_t WS_XB       = 239 * MiB;
constexpr size_t WS_ATT      = 303 * MiB;
constexpr size_t WS_Y        = 239 * MiB;
constexpr size_t WS_P        = 367 * MiB;
constexpr size_t WS_XG       = 367 * MiB;
constexpr size_t WS_HB       = 527 * MiB;
constexpr size_t WS_END      = 575 * MiB;
constexpr size_t WS_H2       = WS_XB;
constexpr size_t WS_FIN      = WS_XB + 32 * MiB;
constexpr size_t WS_REF      = WS_XB;

struct Args { const float* in[19]; float* out; unsigned char* ws; int ph_lo, ph_hi; };
enum { I_X = 0, I_N1G, I_WIN, I_CPOS, I_CW1, I_CW2, I_QNG, I_KNG, I_GNG, I_GNB, I_WOUT, I_N2G, I_WRG, I_BRG, I_WRE, I_BRE, I_WEG, I_WEU, I_WED };

constexpr int LDS_BYTES = 147456 + 1024;
constexpr int LDS_XBAR = 147456;
constexpr int LDS_TAB = 131072;

using pg8::Unit;
struct EpiInProj {
    static constexpr bool PERM = true, AFTER_DRAIN = false, HAS_INIT = false;
    bf16_t* P; float* gates; const LAS float* rsT; const LAS int* slotpm;
    __device__ __forceinline__ void operator()(const f32x4 (&acc)[2][2][4][2], const Unit& u, int wr, int wc, int fr, int fq) const {
        const int row0 = u.pm * 256 + wr * 64 + fr; const LAS float* rsp = rsT + slotpm[u.pm] * 256 + wr * 64 + fr;
        if (u.pn < 26) {
            const int L = fq * 16 + fr, c8 = L & 7, srcb = ((L >> 3) + 16 * (c8 & 3)) * 4; const bool pick1 = (c8 >> 2) != 0;
            bf16_t* pbase = P + (size_t)(u.pm * 256 + wr * 64 + (L >> 3)) * PW + u.pn * 256 + wc * 64 + 8 * c8;
#pragma unroll
            for (int ai = 0; ai < 2; ++ai)
#pragma unroll
                for (int m = 0; m < 4; ++m) {
                    const float rs = rsp[ai * 128 + m * 16];
                    u32x4 w[2];
#pragma unroll
                    for (int bj = 0; bj < 2; ++bj) { const f32x4 v0 = acc[ai][bj][m][0] * rs, v1 = acc[ai][bj][m][1] * rs;
                        w[bj].x = pg8::cvt_pk_bf16(v0[0], v0[1]); w[bj].y = pg8::cvt_pk_bf16(v0[2], v0[3]); w[bj].z = pg8::cvt_pk_bf16(v1[0], v1[1]); w[bj].w = pg8::cvt_pk_bf16(v1[2], v1[3]); }
#pragma unroll
                    for (int h = 0; h < 2; ++h) { u32x4 o;
#pragma unroll
                        for (int d = 0; d < 4; ++d) { const unsigned a0 = (unsigned)__builtin_amdgcn_ds_bpermute(srcb + 32 * h, (int)w[0][d]), a1 = (unsigned)__builtin_amdgcn_ds_bpermute(srcb + 32 * h, (int)w[1][d]); o[d] = pick1 ? a1 : a0; }
                        *(u32x4*)(pbase + (size_t)(ai * 128 + m * 16 + 8 * h) * PW) = o; }
                }
        } else {
            if (wc == 0 && fq < 3) {
#pragma unroll
                for (int ai = 0; ai < 2; ++ai)
#pragma unroll
                    for (int m = 0; m < 4; ++m) {
                        const int row = row0 + ai * 128 + m * 16; const float rs = rsp[ai * 128 + m * 16];
                        float* gp = gates + (size_t)row * 24 + 8 * fq;
                        *(f32x4*)gp = acc[ai][0][m][0] * rs; *(f32x4*)(gp + 4) = acc[ai][0][m][1] * rs;
                    }
            }
        }
    }
};
struct EpiOutProj {
    static constexpr bool PERM = true, AFTER_DRAIN = false, HAS_INIT = true;
    const float* x; float* x1; bf16_t* x1b;
    __device__ __forceinline__ void init(f32x4 (&acc)[2][2][4][2], const Unit& u, int wr, int wc, int fr, int fq) const {
        const int row0 = u.pm * 256 + wr * 64 + fr, col0 = u.pn * 256 + wc * 32 + 8 * fq;
#pragma unroll
        for (int ai = 0; ai < 2; ++ai)
#pragma unroll
            for (int m = 0; m < 4; ++m) { const size_t off = (size_t)(row0 + ai * 128 + m * 16) * DM + col0;
#pragma unroll
                for (int bj = 0; bj < 2; ++bj) { acc[ai][bj][m][0] = *(const f32x4*)(x + off + bj * 128); acc[ai][bj][m][1] = *(const f32x4*)(x + off + bj * 128 + 4); } }
    }
    __device__ __forceinline__ void operator()(const f32x4 (&acc)[2][2][4][2], const Unit& u, int wr, int wc, int fr, int fq) const {
        const int row0 = u.pm * 256 + wr * 64 + fr, col0 = u.pn * 256 + wc * 32 + 8 * fq;
#pragma unroll
        for (int ai = 0; ai < 2; ++ai)
#pragma unroll
            for (int m = 0; m < 4; ++m) {
                const size_t off = (size_t)(row0 + ai * 128 + m * 16) * DM + col0;
#pragma unroll
                for (int bj = 0; bj < 2; ++bj) {
                    const f32x4 r0 = acc[ai][bj][m][0], r1 = acc[ai][bj][m][1];
                    *(f32x4*)(x1 + off + bj * 128) = r0; *(f32x4*)(x1 + off + bj * 128 + 4) = r1;
                    u32x4 w; w.x = pg8::cvt_pk_bf16(r0[0], r0[1]); w.y = pg8::cvt_pk_bf16(r0[2], r0[3]); w.z = pg8::cvt_pk_bf16(r1[0], r1[1]); w.w = pg8::cvt_pk_bf16(r1[2], r1[3]);
                    *(u32x4*)(x1b + off + bj * 128) = w;
                }
            }
    }
};
struct EpiGateUp {
    static constexpr bool PERM = true, AFTER_DRAIN = false, HAS_INIT = false;
    bf16_t* hb; const LAS float* rsT; const LAS int* tslot;
    __device__ __forceinline__ void operator()(const f32x4 (&acc)[2][2][4][2], const Unit& u, int wr, int wc, int fr, int fq) const {
        const int row0 = u.pm * 256 + wr * 64 + fr, col0 = (u.pn & 3) * 128 + wc * 32 + 8 * fq;
        const LAS float* rsp = rsT + tslot[u.pm] * 256 + wr * 64 + fr;
#pragma unroll
        for (int ai = 0; ai < 2; ++ai)
#pragma unroll
            for (int m = 0; m < 4; ++m) {
                bf16_t* rowp = hb + (size_t)(row0 + ai * 128 + m * 16) * DEXP + col0;
                const float rs = rsp[ai * 128 + m * 16];
                const f32x4 g0 = acc[ai][0][m][0] * rs, g1 = acc[ai][0][m][1] * rs, u0 = acc[ai][1][m][0] * rs, u1 = acc[ai][1][m][1] * rs;
                float r[8];
#pragma unroll
                for (int j = 0; j < 4; ++j) { r[j] = silu_f(g0[j]) * u0[j]; r[4 + j] = silu_f(g1[j]) * u1[j]; }
                u32x4 w; w.x = pg8::cvt_pk_bf16(r[0], r[1]); w.y = pg8::cvt_pk_bf16(r[2], r[3]); w.z = pg8::cvt_pk_bf16(r[4], r[5]); w.w = pg8::cvt_pk_bf16(r[6], r[7]);
                *(u32x4*)rowp = w;
            }
    }
};
struct EpiDown {
    static constexpr bool PERM = true, AFTER_DRAIN = false, HAS_INIT = false;
    bf16_t* y; const LAS int* tokT; const LAS float* wT; const LAS int* tslot;
    __device__ __forceinline__ void operator()(const f32x4 (&acc)[2][2][4][2], const Unit& u, int wr, int wc, int fr, int fq) const {
        const int slb = tslot[u.pm] * 256 + wr * 64;
        const int L = fq * 16 + fr, c8 = L & 7, srcb = ((L >> 3) + 16 * (c8 & 3)) * 4; const bool pick1 = (c8 >> 2) != 0;
        const int col = (u.pn & 7) * 256 + wc * 64 + 8 * c8;
#pragma unroll
        for (int ai = 0; ai < 2; ++ai)
#pragma unroll
            for (int m = 0; m < 4; ++m) {
                const float w = wT[slb + fr + ai * 128 + m * 16];
                u32x4 wv[2];
#pragma unroll
                for (int bj = 0; bj < 2; ++bj) { const f32x4 v0 = acc[ai][bj][m][0] * w, v1 = acc[ai][bj][m][1] * w;
                    wv[bj].x = pg8::cvt_pk_bf16(v0[0], v0[1]); wv[bj].y = pg8::cvt_pk_bf16(v0[2], v0[3]); wv[bj].z = pg8::cvt_pk_bf16(v1[0], v1[1]); wv[bj].w = pg8::cvt_pk_bf16(v1[2], v1[3]); }
#pragma unroll
                for (int h = 0; h < 2; ++h) { u32x4 o;
#pragma unroll
                    for (int d = 0; d < 4; ++d) { const unsigned a0 = (unsigned)__builtin_amdgcn_ds_bpermute(srcb + 32 * h, (int)wv[0][d]), a1 = (unsigned)__builtin_amdgcn_ds_bpermute(srcb + 32 * h, (int)wv[1][d]); o[d] = pick1 ? a1 : a0; }
                    const int tr = tokT[slb + ai * 128 + m * 16 + 8 * h + (L >> 3)];
                    if (tr >= 0) *(u32x4*)(y + ((size_t)(tr & 1) * T + (tr >> 1)) * DM + col) = o; }
            }
    }
};
template <int NPN> struct MoeOrder {
    int G, c, ntiles; const LAS int* tile_e;
    __device__ __forceinline__ bool next(int i, Unit& u) const {
        const int nwg = ntiles * NPN; int L = i * G + c; if (L >= nwg) return false;
        { const int q = nwg / 8, r = nwg % 8, xcd = L % 8, off = L / 8; L = (xcd < r ? xcd * (q + 1) : r * (q + 1) + (xcd - r) * q) + off; }
        const int tile = L / NPN; u.pm = tile; u.pn = tile_e[tile] * NPN + (L % NPN); return true;
    }
    __device__ __forceinline__ void a_ready(const Unit&) const {}
    __device__ __forceinline__ void done(const Unit&) const {}
};

struct MoeTab { LAS int* cnt; LAS int* tstart; LAS int* tile_e; LAS int* tile_i; };
__device__ __forceinline__ MoeTab moe_tab(unsigned char* lds) {
    MoeTab t; LAS int* base = (LAS int*)(lds + LDS_TAB); t.cnt = base; t.tstart = base + 32; t.tile_e = base + 72; t.tile_i = base + 72 + MAXTILES; return t;
}
__device__ __forceinline__ int moe_build_tab(const MoeTab& t, const unsigned* gcnt) {
    __syncthreads();
    if (threadIdx.x == 0) {
        int acc = 0;
        for (int e = 0; e < NEXP; ++e) {
            const int n = (int)__hip_atomic_load(gcnt + e * 64, __ATOMIC_RELAXED, __HIP_MEMORY_SCOPE_AGENT);
            t.cnt[e] = n; t.tstart[e] = acc; const int nt = (n + 255) >> 8;
            for (int i = 0; i < nt; ++i) { t.tile_e[acc + i] = e; t.tile_i[acc + i] = i; }
            acc += nt;
        }
        t.tstart[NEXP] = acc;
    }
    __syncthreads();
    return t.tstart[NEXP];
}

#define XB_TMO      128
#define XB_XCNT(j)  (256  + 64 * (j))
#define XB_XSUB(j)  (1280 + 64 * (j))
#define XB_XGEN(j)  (2304 + 64 * (j))
#define XB_TOP      3328
#define XB_TOPGEN   3392
#define XCD_BAR_WORDS 3456
#define XB_SPIN_CAP (1u << 18)

__device__ __forceinline__ unsigned xb_ld(unsigned* p)              { return __hip_atomic_load(p, __ATOMIC_RELAXED, __HIP_MEMORY_SCOPE_AGENT); }
__device__ __forceinline__ unsigned xb_add(unsigned* p, unsigned v) { return __hip_atomic_fetch_add(p, v, __ATOMIC_RELAXED, __HIP_MEMORY_SCOPE_AGENT); }
__device__ __forceinline__ unsigned xb_xcc_id() { return (unsigned)__builtin_amdgcn_s_getreg((3 << 11) | 20) & 0xFu; }
#define XB_SPIN(cond, bar) do { unsigned _sp = 0; while (cond) { __builtin_amdgcn_s_sleep(1); \
    if ((++_sp & 255u) == 0u) { if (xb_ld(&(bar)[XB_TMO])) break; if (_sp > XB_SPIN_CAP) { atomicAdd(&(bar)[XB_TMO], 1u); break; } } } } while (0)

struct XcdBarrier {
    unsigned* bar; unsigned x;
    volatile LAS unsigned* st;
};

__device__ __forceinline__ XcdBarrier xcd_barrier_post(unsigned* bar, volatile LAS unsigned* st) {
    XcdBarrier b; b.bar = bar; b.x = xb_xcc_id(); b.st = st;
    if (threadIdx.x == 0) (void)xb_add(&bar[XB_XCNT(b.x)], 1u);
    return b;
}
__device__ __forceinline__ void xcd_barrier_complete(unsigned* bar, unsigned x, unsigned& nloc, unsigned& nx) {
    const unsigned G = gridDim.x * gridDim.y * gridDim.z;
    unsigned sum, cnt, mine, sp = 0u;
    for (;;) {
        sum = 0u; cnt = 0u; mine = 0u;
#pragma unroll
        for (unsigned j = 0; j < 16; ++j) { const unsigned c = xb_ld(&bar[XB_XCNT(j)]); sum += c; cnt += (c > 0u) ? 1u : 0u; mine = (j == x) ? c : mine; }
        if (sum == G) break;
        __builtin_amdgcn_s_sleep(1);
        if ((++sp & 255u) == 0u) { if (xb_ld(&bar[XB_TMO])) break; if (sp > XB_SPIN_CAP) { atomicAdd(&bar[XB_TMO], 1u); break; } }
    }
    nloc = mine > 0u ? mine : 1u; nx = cnt > 0u ? cnt : 1u;
}

__device__ __forceinline__ void xcd_barrier(const XcdBarrier& b) {
    asm volatile("s_waitcnt vmcnt(0)" ::: "memory");
    __syncthreads();
    if (threadIdx.x == 0) {
        unsigned* bar = b.bar;
        __builtin_amdgcn_s_waitcnt(0);
        unsigned nloc = b.st[0], nx = b.st[1];
        if (nloc == 0u) { xcd_barrier_complete(bar, b.x, nloc, nx); b.st[0] = nloc; b.st[1] = nx; }
        const unsigned old = xb_add(&bar[XB_XSUB(b.x)], 1u);
        const unsigned gen = old / nloc;
        if (old + 1u == (gen + 1u) * nloc) {
            __builtin_amdgcn_fence(__ATOMIC_RELEASE, "agent");
            asm volatile("s_waitcnt vmcnt(0)" ::: "memory");
            const unsigned og = xb_add(&bar[XB_TOP], 1u);
            const unsigned tg = og / nx;
            if (og + 1u == (tg + 1u) * nx) xb_add(&bar[XB_TOPGEN], 1u);
            else XB_SPIN(xb_ld(&bar[XB_TOPGEN]) == tg, bar);
            __builtin_amdgcn_fence(__ATOMIC_ACQUIRE, "agent");
            xb_add(&bar[XB_XGEN(b.x)], 1u);
            asm volatile("s_waitcnt vmcnt(0)" ::: "memory");
        } else {
            XB_SPIN(xb_ld(&bar[XB_XGEN(b.x)]) == gen, bar);
            __builtin_amdgcn_fence(__ATOMIC_ACQUIRE, "agent");
            asm volatile("s_waitcnt vmcnt(0)" ::: "memory");
        }
    }
    __syncthreads();
}


__device__ __forceinline__ void transpose_item(const float* __restrict__ src, int ldn, int k0, int n0, int nvalid, bf16_t* __restrict__ dst, int ldk,
                                               const float* __restrict__ gs, float* tile, int lane, bool split32 = false) {
    { const int r0 = lane >> 4, c4 = (lane & 15) * 4; f32x4 v[16];
#pragma unroll
      for (int i = 0; i < 16; ++i) { v[i] = (f32x4){0.f, 0.f, 0.f, 0.f}; if (c4 < nvalid) v[i] = *(const f32x4*)(src + (size_t)(k0 + r0 + 4 * i) * ldn + n0 + c4); }
#pragma unroll
      for (int i = 0; i < 16; ++i) { const int rr = r0 + 4 * i; if (gs) v[i] = v[i] * gs[k0 + rr];
          float* tp = tile + rr * 65 + c4; tp[0] = v[i][0]; tp[1] = v[i][1]; tp[2] = v[i][2]; tp[3] = v[i][3]; } }
    asm volatile("s_waitcnt lgkmcnt(0)" ::: "memory"); __builtin_amdgcn_wave_barrier();
    { const int kc = (lane & 7) * 8;
#pragma unroll
      for (int i = 0; i < 8; ++i) { const int n = (lane >> 3) + 8 * i; float v[8];
#pragma unroll
          for (int j = 0; j < 8; ++j) v[j] = tile[(kc + j) * 65 + n];
          u32x4 w; w.x = pk2(v[0], v[1]); w.y = pk2(v[2], v[3]); w.z = pk2(v[4], v[5]); w.w = pk2(v[6], v[7]);
          *(u32x4*)(dst + (size_t)(n + ((split32 && n >= 32) ? 96 : 0)) * ldk + k0 + kc) = w; } }
    asm volatile("s_waitcnt lgkmcnt(0)" ::: "memory"); __builtin_amdgcn_wave_barrier();
}

constexpr int TR_NA = (NIN_PAD / 64) * 32, TR_NB = 32 * 32, TR_NE = 768, TR_NC = 256;
__device__ __forceinline__ void transpose_dispatch(const Args& a, int it, float* tile, int lane) {
    unsigned char* ws = a.ws;
    bf16_t* WinT = (bf16_t*)(ws + WS_WIN_T); bf16_t* WoT = (bf16_t*)(ws + WS_WOUT_T); bf16_t* WguT = (bf16_t*)(ws + WS_WGU_T); bf16_t* WdT = (bf16_t*)(ws + WS_WD_T);
    constexpr int N_A = TR_NA, N_B = TR_NB, N_E = TR_NE;
    if (it < N_A) { const int nb = it >> 5, kb = it & 31, nd = nb * 64; int c0, nv;
        if (nd < 2560) { c0 = nd; nv = 64; } else if (nd < PW) { c0 = nd + 24; nv = 64; } else if (nd == PW) { c0 = 2560; nv = 24; } else { c0 = 0; nv = 0; }
        transpose_item(a.in[I_WIN], IN_W, kb * 64, c0, nv, WinT + (size_t)((nd & ~255) + 32 * ((nd >> 6) & 3)) * DM, DM, a.in[I_N1G], tile, lane, true); }
    else if (it < N_A + N_B) { const int j = it - N_A, nb = j >> 5, kb = j & 31;
        transpose_item(a.in[I_WOUT], DM, kb * 64, nb * 64, 64, WoT + (size_t)nb * 64 * DM, DM, nullptr, tile, lane); }
    else if (it >= N_A + N_B + NEXP * N_E) { const int j = it - (N_A + N_B + NEXP * N_E), which = j >> 7, nb = (j >> 6) & 1, kb = j & 63;
        transpose_item(a.in[I_CW1] + (size_t)which * 4096 * 128, 128, kb * 64, nb * 64, 64, (bf16_t*)(ws + WS_W1T) + ((size_t)which * 128 + nb * 64) * 4096, 4096, nullptr, tile, lane); }
    else { const int j = it - N_A - N_B, e = j / N_E, r = j % N_E;
        if (r < 512) { const int up = r >> 8, rr = r & 255, nb = rr >> 5, kb = rr & 31, n0 = nb * 64, drow = 256 * (n0 >> 7) + (n0 & 127) + 128 * up;
            transpose_item(a.in[up ? I_WEU : I_WEG] + (size_t)e * DM * DEXP, DEXP, kb * 64, n0, 64, WguT + ((size_t)e * 1024 + drow) * DM, DM, a.in[I_N2G], tile, lane); }
        else { const int r2 = r - 512, nb = r2 >> 3, kb = r2 & 7;
            transpose_item(a.in[I_WED] + (size_t)e * DEXP * DM, DM, kb * 64, nb * 64, 64, WdT + ((size_t)e * DM + ((nb * 64) & ~255) + 32 * (nb & 3)) * DEXP, DEXP, nullptr, tile, lane, true); } }
}

__device__ __forceinline__ void p0_prepass(const Args& a, unsigned char* lds) {
    const int tid = threadIdx.x, lane = tid & 63, wave = tid >> 6;
    unsigned char* ws = a.ws;
    { const float* x = a.in[I_X]; bf16_t* xb = (bf16_t*)(ws + WS_XB); float* rsc = (float*)(ws + WS_ROWSCALE);
      for (int row = blockIdx.x * 8 + wave; row < T; row += gridDim.x * 8) {
        const float* xr = x + (size_t)row * DM; f32x4 v[8]; float ss = 0.f;
#pragma unroll
        for (int i = 0; i < 4; ++i) { v[2 * i] = *(const f32x4*)(xr + i * 512 + lane * 8); v[2 * i + 1] = *(const f32x4*)(xr + i * 512 + lane * 8 + 4); }
#pragma unroll
        for (int i = 0; i < 8; ++i) ss += v[i][0] * v[i][0] + v[i][1] * v[i][1] + v[i][2] * v[i][2] + v[i][3] * v[i][3];
        ss = wave_sum(ss);
        if (lane == 0) rsc[row] = rsqrtf(ss * (1.f / DM) + RMS_EPS);
#pragma unroll
        for (int i = 0; i < 4; ++i) { u32x4 w; w.x = pk2(v[2 * i][0], v[2 * i][1]); w.y = pk2(v[2 * i][2], v[2 * i][3]); w.z = pk2(v[2 * i + 1][0], v[2 * i + 1][1]); w.w = pk2(v[2 * i + 1][2], v[2 * i + 1][3]);
            *(u32x4*)(xb + (size_t)row * DM + i * 512 + lane * 8) = w; }
      } }
    { float* tile = (float*)lds + wave * (64 * 65);
      for (int it = blockIdx.x * 8 + wave; it < TR_NA + TR_NB + NEXP * TR_NE + TR_NC; it += gridDim.x * 8) transpose_dispatch(a, it, tile, lane);
    }
    { float* ct = (float*)(ws + WS_SINCOS); float* st = ct + SEQ * 64;
      for (int idx = blockIdx.x * NTHREADS + tid; idx < SEQ * 64; idx += gridDim.x * NTHREADS) {
        const int pos = idx >> 6, i = idx & 63;
        const float inv_freq = exp2f(-(float)i * (13.287712379549449f / 64.f));
        const float ang = (float)pos * inv_freq;
        const double rev = (double)ang * 0.15915494309189535; const float fr = (float)(rev - rint(rev));
        ct[idx] = __builtin_amdgcn_cosf(fr); st[idx] = __builtin_amdgcn_sinf(fr);
      }
      { bf16_t* Wh = (bf16_t*)(ws + WS_WR); bf16_t* Wl = Wh + 64 * DM;
        for (int idx = blockIdx.x * NTHREADS + tid; idx < 64 * DM; idx += gridDim.x * NTHREADS) { const int j = idx >> 11, k = idx & (DM - 1);
            float v = 0.f; if (j < 32) v = a.in[I_WRE][(size_t)k * 32 + j]; else if (j < 36) v = a.in[I_WRG][(size_t)k * 4 + (j - 32)];
            v *= a.in[I_N2G][k]; const bf16_t hb = f2bf(v); Wh[idx] = hb; Wl[idx] = f2bf(v - bf2f(hb)); } }
      for (int oi = blockIdx.x * 8 + wave; oi < 256; oi += gridDim.x * 8) { const int which = oi >> 7, e = oi & 127; float s = 0.f;
          for (int k = lane; k < 4096; k += 64) s += a.in[I_CPOS][which * 4096 + k] * a.in[I_CW1][((size_t)which * 4096 + k) * 128 + e];
          s = wave_sum(s); if (lane == 0) ((float*)(ws + WS_CBIAS))[oi] = s; }
      if (blockIdx.x == 0) for (int i = tid; i < XCD_BAR_WORDS; i += NTHREADS) ((unsigned*)(ws + WS_BAR))[i] = 0u;
      if (blockIdx.x == 0 && tid < 128) ((unsigned*)(ws + WS_CNT))[tid] = 0u;
      if (blockIdx.x == 0 && tid < 64) ((unsigned*)(ws + WS_ECNT))[tid * 64] = 0u;
      if (blockIdx.x == 0 && tid < 8) ((float*)(ws + WS_DBG))[tid] = 0.f; }
}

__device__ __forceinline__ void p2_finalize(const Args& a, unsigned char* lds, int rep) {
    const int tid = threadIdx.x, lane = tid & 63, wave = tid >> 6;
    unsigned char* ws = a.ws; bf16_t* P = (bf16_t*)(ws + WS_P);
    const float* ct = (const float*)(ws + WS_SINCOS); const float* st = ct + SEQ * 64;
    const float* qng = a.in[I_QNG]; const float* kng = a.in[I_KNG];
    unsigned* qctr = (unsigned*)(ws + WS_CNT) + 66 + rep; int* qslot = (int*)(lds + LDS_XBAR + 64);
    for (;;) {
      __syncthreads();
      if (tid == 0) *qslot = (int)atomicAdd(qctr, 1u);
      __syncthreads();
      const int qi = *qslot;
      if (qi >= 128 + 256) break;
      if (qi >= 128) {
      if (!rep)
      for (int tok = (qi - 128) * 64 + wave; tok < (qi - 128) * 64 + 64; tok += 8) {
        bf16_t* pr = P + (size_t)tok * PW; const int pos = tok & (SEQ - 1);
#pragma unroll
        for (int h = 0; h < 8; ++h) { unsigned* p2 = (unsigned*)(pr + PC_Q + h * 128) + lane; const unsigned w = *p2;
            const float v0 = __uint_as_float(w << 16), v1 = __uint_as_float(w & 0xffff0000u);
            const float ss = wave_sum(v0 * v0 + v1 * v1), r = rsqrtf(ss * (1.f / 128.f) + RMS_EPS);
            *p2 = pk2(v0 * r * qng[2 * lane], v1 * r * qng[2 * lane + 1]); }
#pragma unroll
        for (int j = 0; j < 4; ++j) { const int col = (j < 2 ? PC_KSLC : PC_KWIN) + (j & 1) * 128; const float* gg = kng + (j < 2 ? 128 : 256);
            unsigned* p2 = (unsigned*)(pr + col) + lane; const unsigned w = *p2;
            const float v0 = __uint_as_float(w << 16), v1 = __uint_as_float(w & 0xffff0000u);
            const float ss = wave_sum(v0 * v0 + v1 * v1), r = rsqrtf(ss * (1.f / 128.f) + RMS_EPS);
            *p2 = pk2(v0 * r * gg[2 * lane], v1 * r * gg[2 * lane + 1]); }
        const float c = ct[pos * 64 + lane], s = st[pos * 64 + lane]; const float nl = (float)(pos & 127);
#pragma unroll
        for (int h = 0; h < 8; ++h) {
            const float lg2 = log2f(1.f - exp2f(-5.f - (float)h)), sq = exp2f(lg2 * nl), sk = exp2f(-lg2 * nl) * QK_SCALE;
            { bf16_t* q1 = pr + PC_RQ + h * 128 + lane; const float t1 = bf2f(q1[0]), t2 = bf2f(q1[64]); q1[0] = f2bf((t1 * c - t2 * s) * sq); q1[64] = f2bf((t1 * s + t2 * c) * sq); }
            { bf16_t* k1 = pr + PC_RK + h * 128 + lane; const float t1 = bf2f(k1[0]), t2 = bf2f(k1[64]); k1[0] = f2bf((t1 * c - t2 * s) * sk); k1[64] = f2bf((t1 * s + t2 * c) * sk); }
        }
    }
      } else {
    const float* w2 = a.in[I_CW2];
    const bf16_t* W1T = (const bf16_t*)(ws + WS_W1T); const float* cbias = (const float*)(ws + WS_CBIAS);
    bf16_t* KCb = (bf16_t*)(ws + WS_KCB); bf16_t* VCb = (bf16_t*)(ws + WS_VCB);
    const int r32 = lane & 31, hi = lane >> 5;
    float* red = (float*)lds;
    float* hid = (float*)(lds + LDS_TAB);
    { const int item = qi;
        const int nt = item & 3, which = (item >> 2) & 1, g = (item >> 3) & 1, b = item >> 4;
        const int n = min(32 * nt + r32, NCMP - 1);
        const bf16_t* Ap = P + ((size_t)b * SEQ + 16 * n + 4 * wave) * PW + (which ? PC_VCMP : PC_KCMP) + g * 128 + hi * 8;
        const bf16_t* Bp = W1T + ((size_t)which * 128 + r32) * 4096 + wave * 512 + hi * 8;
        f32x16 acc[4];
#pragma unroll
        for (int et = 0; et < 4; ++et) acc[et] = f32x16{};
#pragma unroll 4
        for (int ks = 0; ks < 32; ++ks) {
            const bf16x8 af = *(const bf16x8*)(Ap + (size_t)(ks >> 3) * PW + 16 * (ks & 7));
#pragma unroll
            for (int et = 0; et < 4; ++et) { const bf16x8 bfr = *(const bf16x8*)(Bp + (size_t)et * 32 * 4096 + 16 * ks);
                acc[et] = __builtin_amdgcn_mfma_f32_32x32x16_bf16(af, bfr, acc[et], 0, 0, 0); }
        }
        __syncthreads();
#pragma unroll
        for (int et = 0; et < 4; ++et)
#pragma unroll
            for (int r = 0; r < 16; ++r) red[(wave * 32 + (r & 3) + 8 * (r >> 2) + 4 * hi) * 128 + 32 * et + r32] = acc[et][r];
        __syncthreads();
#pragma unroll
        for (int i = 0; i < 8; ++i) { const int idx = tid + 512 * i; float s = cbias[which * 128 + (idx & 127)];
#pragma unroll
            for (int w8 = 0; w8 < 8; ++w8) s += red[w8 * 4096 + idx];
            hid[idx] = silu_f(s); }
        __syncthreads();
        { const int f = tid & 127, ng = tid >> 7; float o8[8];
#pragma unroll
          for (int i = 0; i < 8; ++i) o8[i] = 0.f;
          const float* wp = w2 + which * 16384 + f;
          for (int e = 0; e < 128; ++e) { const float wv = wp[e * 128];
#pragma unroll
              for (int i = 0; i < 8; ++i) o8[i] += hid[(ng * 8 + i) * 128 + e] * wv; }
#pragma unroll
          for (int i = 0; i < 8; ++i) red[(ng * 8 + i) * 128 + f] = o8[i]; }
        __syncthreads();
        for (int rr = 0; rr < 4; ++rr) { const int nl = wave * 4 + rr, nn = 32 * nt + nl; const float v0 = red[nl * 128 + lane], v1 = red[nl * 128 + 64 + lane];
            float s0 = v0, s1 = v1;
            if (which == 0) { const float r = rsqrtf(wave_sum(v0 * v0 + v1 * v1) * (1.f / 128.f) + RMS_EPS); s0 = v0 * r * kng[lane]; s1 = v1 * r * kng[64 + lane]; }
            if (nn >= NCMP) { s0 = 0.f; s1 = 0.f; }
            bf16_t* op = (which ? VCb : KCb) + ((size_t)(b * 2 + g) * 128 + nn) * 128; op[lane] = f2bf(s0); op[64 + lane] = f2bf(s1); }
    }
      }
    }
}

__device__ __forceinline__ void softmax_rows(float* sc, int ncols, int tid) {
    const int lane = tid & 63, wave = tid >> 6;
    if (wave < 4) { float* r = sc + wave * 512; float mx = -1e30f;
        for (int i = lane; i < ncols; i += 64) mx = fmaxf(mx, r[i]);
        mx = wave_max(mx); float sum = 0.f;
        for (int i = lane; i < ncols; i += 64) { const float v = r[i]; const float e = (v > -1e29f) ? __expf(v - mx) : 0.f; r[i] = e; sum += e; }
        sum = wave_sum(sum); const float inv = sum > 0.f ? 1.f / sum : 0.f;
        for (int i = lane; i < ncols; i += 64) r[i] *= inv; }
}
__device__ __forceinline__ float dot_q_kbf16(const float* q, const bf16_t* k) {
    float s = 0.f;
#pragma unroll
    for (int c = 0; c < 16; ++c) { const u32x4 w = *(const u32x4*)(k + c * 8);
        s += q[c * 8 + 0] * __uint_as_float(w.x << 16) + q[c * 8 + 1] * __uint_as_float(w.x & 0xffff0000u) + q[c * 8 + 2] * __uint_as_float(w.y << 16) + q[c * 8 + 3] * __uint_as_float(w.y & 0xffff0000u)
           + q[c * 8 + 4] * __uint_as_float(w.z << 16) + q[c * 8 + 5] * __uint_as_float(w.z & 0xffff0000u) + q[c * 8 + 6] * __uint_as_float(w.w << 16) + q[c * 8 + 7] * __uint_as_float(w.w & 0xffff0000u); }
    return s;
}
__device__ __forceinline__ void nsa_naive(const Args& a, unsigned char* lds, bf16_t* dst, int ldd) {
    const int tid = threadIdx.x;
    unsigned char* ws = a.ws; const bf16_t* P = (const bf16_t*)(ws + WS_P);
    const bf16_t* KCb = (const bf16_t*)(ws + WS_KCB); const bf16_t* VCb = (const bf16_t*)(ws + WS_VCB); const float* gates = (const float*)(ws + WS_GATES);
    unsigned* selmask = (unsigned*)(ws + WS_SELMASK);
    float* qn = (float*)lds; float* sc = qn + 512; int* keypos = (int*)(sc + 2048); float* imp = (float*)(keypos + 512); unsigned* smask = (unsigned*)(imp + 32);
    for (int item = blockIdx.x; item < T * 2; item += gridDim.x) {
        const int g = item & 1, tok = item >> 1, b = tok >> 11, t = tok & (SEQ - 1);
        const int h = tid >> 7, d = tid & 127;
        __syncthreads();
        qn[tid] = bf2f(P[(size_t)tok * PW + PC_Q + (g * 4 + h) * 128 + d]) * QK_SCALE;
        __syncthreads();
        const int nvc = t >= 31 ? min(NCMP, (t - 31) / 16 + 1) : 0;
        { const int n = tid & 127; float s = -1e30f;
          if (n < nvc) { const bf16_t* kr = KCb + ((size_t)(b * 2 + g) * 128 + n) * 128; const float* q = qn + h * 128; s = 0.f; for (int k = 0; k < 128; ++k) s += q[k] * bf2f(kr[k]); }
          sc[h * 512 + n] = s; }
        __syncthreads();
        softmax_rows(sc, 128, tid);
        __syncthreads();
        float ocmp = 0.f;
        for (int n = 0; n < nvc; ++n) ocmp += sc[h * 512 + n] * bf2f(VCb[((size_t)(b * 2 + g) * 128 + n) * 128 + d]);
        if (tid < 32) { float s = 0.f; const int j = tid;
            for (int n = max(0, 4 * j - 1); n <= min(NCMP - 1, 4 * j + 3); ++n) s += sc[n] + sc[512 + n] + sc[1024 + n] + sc[1536 + n];
            imp[j] = s; }
        __syncthreads();
        if (tid == 0) { const int cur = t >> 6; unsigned m = 0u;
            for (int k = 0; k < NSEL; ++k) { int best = -1; float bs = 0.f;
                for (int j = 0; j < NSBLK; ++j) { if ((m >> j) & 1u) continue;
                    const bool valid = j <= cur, forced = (j == 0) || (j == cur) || (j == cur - 1);
                    const float s = valid ? (forced ? 1e6f : imp[j]) : -INFINITY;
                    if (best < 0 || s > bs) { best = j; bs = s; } }
                m |= 1u << best; }
            *smask = m; selmask[tok * 2 + g] = m; }
        __syncthreads();
        { const unsigned m = *smask; const int k = tid >> 6, i = tid & 63; int cntb = 0, jk = 0;
          for (int j = 0; j < NSBLK; ++j) if ((m >> j) & 1u) { if (cntb == k) jk = j; ++cntb; }
          const int kp = 64 * jk + i; keypos[tid] = kp <= t ? kp : -1; }
        __syncthreads();
        for (int hh = 0; hh < 4; ++hh) { const int kp = keypos[tid];
            sc[hh * 512 + tid] = kp >= 0 ? dot_q_kbf16(qn + hh * 128, P + (size_t)(b * SEQ + kp) * PW + PC_KSLC + g * 128) : -1e30f; }
        __syncthreads();
        softmax_rows(sc, 512, tid);
        __syncthreads();
        float oslc = 0.f;
        for (int sidx = 0; sidx < 512; ++sidx) { const int kp = keypos[sidx]; if (kp >= 0) oslc += sc[h * 512 + sidx] * bf2f(P[(size_t)(b * SEQ + kp) * PW + PC_VSLC + g * 128 + d]); }
        __syncthreads();
        { const int kp = t - tid; keypos[tid] = kp >= 0 ? kp : -1; }
        __syncthreads();
        for (int hh = 0; hh < 4; ++hh) { const int kp = keypos[tid];
            sc[hh * 512 + tid] = kp >= 0 ? dot_q_kbf16(qn + hh * 128, P + (size_t)(b * SEQ + kp) * PW + PC_KWIN + g * 128) : -1e30f; }
        __syncthreads();
        softmax_rows(sc, 512, tid);
        __syncthreads();
        float owin = 0.f;
        for (int sidx = 0; sidx < 512; ++sidx) { const int kp = keypos[sidx]; if (kp >= 0) owin += sc[h * 512 + sidx] * bf2f(P[(size_t)(b * SEQ + kp) * PW + PC_VWIN + g * 128 + d]); }
        const float* gp = gates + (size_t)tok * 24 + g * 12 + h * 3;
        const float o = ocmp * sigmoid_f(gp[0]) + oslc * sigmoid_f(gp[1]) + owin * sigmoid_f(gp[2]);
        dst[(size_t)tok * ldd + (g * 4 + h) * 128 + d] = f2bf(o);
    }
}

__device__ __forceinline__ void ret_naive(const Args& a, unsigned char* lds, bf16_t* dst, int ldd, int coff) {
    const int tid = threadIdx.x, lane = tid & 63, wave = tid >> 6;
    unsigned char* ws = a.ws; const bf16_t* P = (const bf16_t*)(ws + WS_P);
    const float* gng = a.in[I_GNG]; const float* gnb = a.in[I_GNB];
    float* qf = (float*)lds; float* kf = qf + 32 * 128; float* sm = kf + 128 * 129; float* ob = kf;
    for (int item = blockIdx.x; item < BATCH * RET_H * (SEQ / 32); item += gridDim.x) {
        const int nt = item & 63, h = (item >> 6) & 7, b = item >> 9, n0 = nt * 32;
        const float lg = log1pf(-exp2f(-5.f - (float)h));
        __syncthreads();
        for (int i = tid; i < 32 * 128; i += NTHREADS) { const int n = i >> 7, d = i & 127; qf[i] = bf2f(P[(size_t)(b * SEQ + n0 + n) * PW + PC_RQ + h * 128 + d]); }
        float o[8];
#pragma unroll
        for (int i = 0; i < 8; ++i) o[i] = 0.f;
        const int e = tid & 127, ng = tid >> 7;
        for (int m0 = 0; m0 <= n0 + 31; m0 += 128) {
            __syncthreads();
            for (int i = tid; i < 128 * 128; i += NTHREADS) { const int mm = i >> 7, d = i & 127; kf[mm * 129 + d] = bf2f(P[(size_t)(b * SEQ + m0 + mm) * PW + PC_RK + h * 128 + d]); }
            __syncthreads();
            { const int mm = tid & 127;
#pragma unroll
              for (int i = 0; i < 8; ++i) { const int n = ng * 8 + i; const int dist = (n0 + n) - (m0 + mm); float s = 0.f;
                  if (dist >= 0) { const float* q = qf + n * 128; const float* k = kf + mm * 129; for (int dd = 0; dd < 128; ++dd) s += q[dd] * k[dd]; s *= __expf(lg * 128.f * (float)(((n0 + n) >> 7) - ((m0 + mm) >> 7))); }
                  sm[n * 128 + mm] = s; } }
            __syncthreads();
            const int mmax = min(128, n0 + 32 - m0);
            for (int mm = 0; mm < mmax; ++mm) { const float v = bf2f(P[(size_t)(b * SEQ + m0 + mm) * PW + PC_RV + h * 128 + e]);
#pragma unroll
                for (int i = 0; i < 8; ++i) o[i] += sm[(ng * 8 + i) * 128 + mm] * v; }
        }
        __syncthreads();
#pragma unroll
        for (int i = 0; i < 8; ++i) ob[(ng * 8 + i) * 128 + e] = o[i];
        __syncthreads();
        for (int rr = 0; rr < 4; ++rr) { const int n = wave * 4 + rr; const float v0 = ob[n * 128 + lane], v1 = ob[n * 128 + 64 + lane];
            const float mu = wave_sum(v0 + v1) * (1.f / 128.f); const float d0 = v0 - mu, d1 = v1 - mu;
            const float var = wave_sum(d0 * d0 + d1 * d1) * (1.f / 128.f), r = rsqrtf(var + GN_EPS);
            const size_t tok = (size_t)(b * SEQ + n0 + n);
            const float g0 = bf2f(P[tok * PW + PC_RG + h * 128 + lane]), g1 = bf2f(P[tok * PW + PC_RG + h * 128 + 64 + lane]);
            const float y0 = d0 * r * gng[h * 128 + lane] + gnb[h * 128 + lane], y1 = d1 * r * gng[h * 128 + 64 + lane] + gnb[h * 128 + 64 + lane];
            dst[tok * ldd + coff + h * 128 + lane] = f2bf(silu_f(g0) * y0); dst[tok * ldd + coff + h * 128 + 64 + lane] = f2bf(silu_f(g1) * y1); }
    }
}

__device__ __forceinline__ void split_bf16(const f32x4& a, const f32x4& b, bf16x8& hi, bf16x8& lo) {
    u32x4 h, l; float r[8] = {a[0], a[1], a[2], a[3], b[0], b[1], b[2], b[3]}; unsigned hb[8], lb[8];
#pragma unroll
    for (int j = 0; j < 8; ++j) { hb[j] = f2bf(r[j]); lb[j] = f2bf(r[j] - __uint_as_float(hb[j] << 16)); }
    h.x = hb[0] | (hb[1] << 16); h.y = hb[2] | (hb[3] << 16); h.z = hb[4] | (hb[5] << 16); h.w = hb[6] | (hb[7] << 16);
    l.x = lb[0] | (lb[1] << 16); l.y = lb[2] | (lb[3] << 16); l.z = lb[4] | (lb[5] << 16); l.w = lb[6] | (lb[7] << 16);
    hi = *reinterpret_cast<bf16x8*>(&h); lo = *reinterpret_cast<bf16x8*>(&l);
}
__device__ __forceinline__ void p7_route(const Args& a, unsigned char* lds, int rep) {
    const int tid = threadIdx.x, lane = tid & 63, wave = __builtin_amdgcn_readfirstlane(tid >> 6), r32 = lane & 31, hi = lane >> 5;
    unsigned char* ws = a.ws; const float* x1 = a.out;
    const float* brg = a.in[I_BRG]; const float* bre = a.in[I_BRE];
    const bf16_t* Wh = (const bf16_t*)(ws + WS_WR); const bf16_t* Wl = Wh + 64 * DM;
    unsigned* cnt = (unsigned*)(ws + WS_ECNT) + (rep ? 32 * 64 : 0); int* ltok = (int*)(ws + (rep ? WS_WIN_T : WS_LTOK)); float* lw = (float*)(ws + (rep ? WS_WIN_T + 2 * MiB : WS_LW)); float* rs2 = (float*)(ws + WS_RS2);
    float* part = (float*)lds;
    constexpr int XST = 260;
    float* xbuf = (float*)lds;
    const int mt = wave & 1, kq = wave >> 1;
    for (int tile = blockIdx.x; tile < T / 64; tile += gridDim.x) {
        const int tok0 = tile * 64;
        const bf16_t* bh = Wh + (size_t)r32 * DM + kq * 64 + hi * 8; const bf16_t* bl = Wl + (size_t)r32 * DM + kq * 64 + hi * 8;
        f32x16 acc0 = f32x16{}, acc1 = f32x16{}; float ss = 0.f;
        f32x4 xs[8];
#define RT_GLOAD(kc) do { _Pragma("unroll") for (int it = 0; it < 8; ++it) { const int idx = tid + 512 * it; xs[it] = *(const f32x4*)(x1 + (size_t)(tok0 + (idx >> 6)) * DM + (kc) * 256 + 4 * (idx & 63)); } } while (0)
#define RT_LWRITE(buf) do { _Pragma("unroll") for (int it = 0; it < 8; ++it) { const int idx = tid + 512 * it; *(f32x4*)(xbuf + (buf) * 64 * XST + (idx >> 6) * XST + 4 * (idx & 63)) = xs[it]; } } while (0)
        __syncthreads();
        RT_GLOAD(0); RT_LWRITE(0);
        __syncthreads();
#pragma unroll 1
        for (int kc = 0; kc < 8; ++kc) {
            if (kc + 1 < 8) RT_GLOAD(kc + 1);
            bf16x8 bw[16];
#pragma unroll
            for (int q = 0; q < 4; ++q) { const int ko = kc * 256 + 16 * q;
                bw[4 * q] = *(const bf16x8*)(bh + ko); bw[4 * q + 1] = *(const bf16x8*)(bl + ko); bw[4 * q + 2] = *(const bf16x8*)(bh + (size_t)32 * DM + ko); bw[4 * q + 3] = *(const bf16x8*)(bl + (size_t)32 * DM + ko); }
            const float* xrow = xbuf + (kc & 1) * 64 * XST + (32 * mt + r32) * XST + kq * 64 + hi * 8;
#pragma unroll
            for (int q = 0; q < 4; ++q) { const f32x4 xa = *(const f32x4*)(xrow + 16 * q), xb = *(const f32x4*)(xrow + 16 * q + 4);
                ss += (xa[0] * xa[0] + xa[1] * xa[1]) + (xa[2] * xa[2] + xa[3] * xa[3]) + (xb[0] * xb[0] + xb[1] * xb[1]) + (xb[2] * xb[2] + xb[3] * xb[3]);
                bf16x8 ah, al; split_bf16(xa, xb, ah, al);
                acc0 = __builtin_amdgcn_mfma_f32_32x32x16_bf16(ah, bw[4 * q], acc0, 0, 0, 0); acc0 = __builtin_amdgcn_mfma_f32_32x32x16_bf16(ah, bw[4 * q + 1], acc0, 0, 0, 0); acc0 = __builtin_amdgcn_mfma_f32_32x32x16_bf16(al, bw[4 * q], acc0, 0, 0, 0);
                acc1 = __builtin_amdgcn_mfma_f32_32x32x16_bf16(ah, bw[4 * q + 2], acc1, 0, 0, 0); acc1 = __builtin_amdgcn_mfma_f32_32x32x16_bf16(ah, bw[4 * q + 3], acc1, 0, 0, 0); acc1 = __builtin_amdgcn_mfma_f32_32x32x16_bf16(al, bw[4 * q + 2], acc1, 0, 0, 0); }
            if (kc + 1 < 8) RT_LWRITE((kc + 1) & 1);
            __syncthreads();
        }
#undef RT_GLOAD
#undef RT_LWRITE
        ss += __shfl_xor(ss, 32);
        __syncthreads();
#pragma unroll
        for (int r = 0; r < 16; ++r) { float* pr = part + ((size_t)kq * 64 + 32 * mt + (r & 3) + 8 * (r >> 2) + 4 * hi) * 65; pr[r32] = acc0[r]; pr[32 + r32] = acc1[r]; }
        if (hi == 0) part[((size_t)kq * 64 + 32 * mt + r32) * 65 + 64] = ss;
        __syncthreads();
        if (wave == 0) {
            const int tok = tok0 + lane; const float* p0 = part + (size_t)lane * 65;
#define LGT(j) (p0[(j)] + p0[64 * 65 + (j)] + p0[2 * 64 * 65 + (j)] + p0[3 * 64 * 65 + (j)])
            const float rs = rsqrtf(LGT(64) * (1.f / DM) + RMS_EPS);
            rs2[tok] = rs;
            float lg[4];
#pragma unroll
            for (int j = 0; j < 4; ++j) lg[j] = LGT(32 + j) * rs + brg[j];
            int gi = 0; float gm = lg[0];
#pragma unroll
            for (int j = 1; j < 4; ++j) if (lg[j] > gm) { gm = lg[j]; gi = j; }
            float gs = 0.f;
#pragma unroll
            for (int j = 0; j < 4; ++j) gs += __expf(lg[j] - gm);
            const float gtop = 1.f / gs;
            float ls[8];
#pragma unroll
            for (int j = 0; j < 8; ++j) ls[j] = LGT(gi * 8 + j) * rs + bre[gi * 8 + j];
#undef LGT
            int e0 = 0; float m0 = ls[0];
#pragma unroll
            for (int j = 1; j < 8; ++j) if (ls[j] > m0) { m0 = ls[j]; e0 = j; }
            int e1 = -1; float m1 = -INFINITY;
#pragma unroll
            for (int j = 0; j < 8; ++j) if (j != e0 && (e1 < 0 || ls[j] > m1)) { m1 = ls[j]; e1 = j; }
            const float p1 = __expf(m1 - m0); const float w0 = gtop / (1.f + p1), w1 = gtop * p1 / (1.f + p1);
            const int ea = gi * 8 + e0, eb = gi * 8 + e1;
            unsigned* lcnt = (unsigned*)(lds + LDS_TAB); unsigned* lbase = lcnt + 32;
            if (lane < 32) lcnt[lane] = 0u;
            asm volatile("s_waitcnt lgkmcnt(0)" ::: "memory");
            const unsigned ra = atomicAdd(lcnt + ea, 1u); const unsigned rb = atomicAdd(lcnt + eb, 1u);
            asm volatile("s_waitcnt lgkmcnt(0)" ::: "memory");
            if (lane < 32) { const unsigned n = lcnt[lane]; lbase[lane] = n ? atomicAdd(cnt + lane * 64, n) : 0u; }
            asm volatile("s_waitcnt vmcnt(0) lgkmcnt(0)" ::: "memory");
            const unsigned pa = lbase[ea] + ra, pb = lbase[eb] + rb;
            ltok[ea * T + pa] = tok * 2 + 0; lw[ea * T + pa] = w0;
            ltok[eb * T + pb] = tok * 2 + 1; lw[eb * T + pb] = w1;
        }
    }
}

__device__ __forceinline__ void p8_gather(const Args& a, unsigned char* lds) {
    const int tid = threadIdx.x, lane = tid & 63, wave = tid >> 6;
    unsigned char* ws = a.ws; const bf16_t* h2 = (const bf16_t*)(ws + WS_H2); bf16_t* xg = (bf16_t*)(ws + WS_XG);
    const int* ltok = (const int*)(ws + WS_LTOK);
    MoeTab tab = moe_tab(lds); const int ntiles = moe_build_tab(tab, (const unsigned*)(ws + WS_CNT));
    for (int r = blockIdx.x * 8 + wave; r < ntiles * 256; r += gridDim.x * 8) {
        const int tile = r >> 8, e = tab.tile_e[tile], li = tab.tile_i[tile] * 256 + (r & 255);
        u32x4 v0 = {0u, 0u, 0u, 0u}, v1 = v0, v2 = v0, v3 = v0;
        if (li < tab.cnt[e]) { const int tok = ltok[e * T + li] >> 1; const u32x4* s = (const u32x4*)(h2 + (size_t)tok * DM);
            v0 = s[lane]; v1 = s[64 + lane]; v2 = s[128 + lane]; v3 = s[192 + lane]; }
        u32x4* dp = (u32x4*)(xg + (size_t)r * DM); dp[lane] = v0; dp[64 + lane] = v1; dp[128 + lane] = v2; dp[192 + lane] = v3;
    }
}

__device__ __forceinline__ void p11_final(const Args& a) {
    const bf16_t* y = (const bf16_t*)(a.ws + WS_Y); float* out = a.out;
    const size_t n8 = (size_t)T * DM / 8;
    for (size_t i = (size_t)blockIdx.x * NTHREADS + threadIdx.x; i < n8; i += (size_t)gridDim.x * NTHREADS) {
        const u32x4 a0 = *(const u32x4*)(y + i * 8), a1 = *(const u32x4*)(y + (size_t)T * DM + i * 8);
        f32x4 o0 = *(f32x4*)(out + i * 8), o1 = *(f32x4*)(out + i * 8 + 4);
        o0[0] += __uint_as_float(a0.x << 16) + __uint_as_float(a1.x << 16); o0[1] += __uint_as_float(a0.x & 0xffff0000u) + __uint_as_float(a1.x & 0xffff0000u);
        o0[2] += __uint_as_float(a0.y << 16) + __uint_as_float(a1.y << 16); o0[3] += __uint_as_float(a0.y & 0xffff0000u) + __uint_as_float(a1.y & 0xffff0000u);
        o1[0] += __uint_as_float(a0.z << 16) + __uint_as_float(a1.z << 16); o1[1] += __uint_as_float(a0.z & 0xffff0000u) + __uint_as_float(a1.z & 0xffff0000u);
        o1[2] += __uint_as_float(a0.w << 16) + __uint_as_float(a1.w << 16); o1[3] += __uint_as_float(a0.w & 0xffff0000u) + __uint_as_float(a1.w & 0xffff0000u);
#ifdef DBG_COMPARE
        { const float* dbg = (const float*)(a.ws + WS_DBG); const float sc_ = 1.f + 3.f * sqrtf(dbg[0] / fmaxf(dbg[1], 1e-30f)); o0 = o0 * sc_; o1 = o1 * sc_; }
#endif
#ifdef DBG_TIME_A
        { const unsigned long long* ts = (const unsigned long long*)(a.ws + WS_TS); const float ta = (float)(ts[DBG_TIME_A + 1] - ts[DBG_TIME_A]) * 0.01f;
          const float cofs = ta * 5e-4f; o0 = o0 + cofs; o1 = o1 + cofs; }
#endif
        *(f32x4*)(out + i * 8) = o0; *(f32x4*)(out + i * 8 + 4) = o1;
    }
}

__device__ __forceinline__ void dbg_compare(const Args& a, const bf16_t* X, const bf16_t* R, int ldr, int c0, int c1, int rc0) {
    float se = 0.f, sr = 0.f; const int w = c1 - c0;
    for (size_t i = (size_t)blockIdx.x * NTHREADS + threadIdx.x; i < (size_t)T * w; i += (size_t)gridDim.x * NTHREADS) {
        const size_t row = i / w; const int col = c0 + (int)(i % w); const float x = bf2f(X[row * DM + col]), r = bf2f(R[row * ldr + (col - c0 + rc0)]);
        se += (x - r) * (x - r); sr += r * r; }
    se = wave_sum(se); sr = wave_sum(sr);
    if ((threadIdx.x & 63) == 0) { atomicAdd((float*)(a.ws + WS_DBG), se); atomicAdd((float*)(a.ws + WS_DBG) + 1, sr); }
}

typedef short s16x4 __attribute__((ext_vector_type(4)));
#define KSWZ(row, colB) ((row) * 256 + ((colB) ^ (((row) & 7) << 4)))
#define SBAR() __builtin_amdgcn_sched_barrier(0)
__device__ __forceinline__ int crow(int r, int hi) { return (r & 3) + 8 * (r >> 2) + 4 * hi; }
__device__ __forceinline__ unsigned cvtpk(float lo, float hi) { unsigned r; asm volatile("v_cvt_pk_bf16_f32 %0, %1, %2" : "=v"(r) : "v"(lo), "v"(hi)); return r; }
constexpr float SM_C = QK_SCALE * 1.4426950408889634f;
constexpr float THR_RAW = 8.f / QK_SCALE;
constexpr float M_INIT = -1.0e4f;

__device__ __forceinline__ void qkt(f32x16& p0, f32x16& p1, const unsigned char* Ks, const bf16x8* qr, int r32, int hi, float iv, bool ranged, int lo, int hb) {
    if (ranged) {
        const int A = 4 * hi - lo, B = hb - 4 * hi; const unsigned ivb = __float_as_uint(iv), ngb = __float_as_uint(-1e30f);
#pragma unroll
        for (int r = 0; r < 16; ++r) { const int kr = (r & 3) + 8 * (r >> 2);
            const unsigned n0 = (unsigned)(((kr + A) | (B - kr)) >> 31), n1 = (unsigned)(((kr + 32 + A) | (B - kr - 32)) >> 31);
            p0[r] = __uint_as_float((n0 & ngb) | (~n0 & ivb)); p1[r] = __uint_as_float((n1 & ngb) | (~n1 & ivb)); }
    } else {
#pragma unroll
        for (int r = 0; r < 16; ++r) { p0[r] = iv; p1[r] = iv; }
    }
    const unsigned kbase = (unsigned)(uintptr_t)Ks;
#define QK_RD(dst, row, d0_) asm volatile("ds_read_b128 %0, %1" : "=v"(dst) : "v"(kbase + (unsigned)KSWZ((row), ((d0_) * 16 + hi * 8) * 2)) : "memory")
    bf16x8 ka0, ka1, kb0, kb1;
    QK_RD(ka0, r32, 0); QK_RD(ka1, 32 + r32, 0);
#define QK_STEP(CUR0, CUR1, NXT0, NXT1, d0_) do { \
        if ((d0_) + 1 < 8) { QK_RD(NXT0, r32, (d0_) + 1); QK_RD(NXT1, 32 + r32, (d0_) + 1); asm volatile("s_waitcnt lgkmcnt(2)" ::: "memory"); } \
        else asm volatile("s_waitcnt lgkmcnt(0)" ::: "memory"); \
        SBAR(); \
        p0 = __builtin_amdgcn_mfma_f32_32x32x16_bf16(CUR0, qr[d0_], p0, 0, 0, 0); p1 = __builtin_amdgcn_mfma_f32_32x32x16_bf16(CUR1, qr[d0_], p1, 0, 0, 0); SBAR(); } while (0)
    QK_STEP(ka0, ka1, kb0, kb1, 0); QK_STEP(kb0, kb1, ka0, ka1, 1); QK_STEP(ka0, ka1, kb0, kb1, 2); QK_STEP(kb0, kb1, ka0, ka1, 3);
    QK_STEP(ka0, ka1, kb0, kb1, 4); QK_STEP(kb0, kb1, ka0, ka1, 5); QK_STEP(ka0, ka1, kb0, kb1, 6); QK_STEP(kb0, kb1, ka0, ka1, 7);
#undef QK_STEP
#undef QK_RD
}
__device__ __forceinline__ int v_st(int k, int c) { const int kk = (k & ~0xC) | ((k & 4) << 1) | ((k & 8) >> 1); return ((kk >> 3) * 4 + (c >> 5)) * 512 + ((kk & 7) * 32 + (c & 31)) * 2; }
__device__ __forceinline__ int v_rd_base(int lane) { return ((lane & 3) << 3) | (((lane >> 2) & 3) << 6) | (((lane >> 4) & 1) << 5) | (((lane >> 5) & 1) << 8); }
constexpr int v_rd_off(int d0, int ks, int half) { return d0 * 512 + ks * 4096 + half * 2048; }
template <int OFF> __device__ __forceinline__ s16x4 tr_read(int vb) {
    s16x4 r; asm volatile("ds_read_b64_tr_b16 %0, %1 offset:%2" : "=&v"(r) : "v"(vb), "i"(OFF) : "memory"); return r;
}
template <int D0> __device__ __forceinline__ void pv_one(f32x16& od, int vb, bf16x8 pa0, bf16x8 pa1, bf16x8 pa2, bf16x8 pa3) {
    const s16x4 l0 = tr_read<v_rd_off(D0, 0, 0)>(vb), h0 = tr_read<v_rd_off(D0, 0, 1)>(vb), l1 = tr_read<v_rd_off(D0, 1, 0)>(vb), h1 = tr_read<v_rd_off(D0, 1, 1)>(vb);
    const s16x4 l2 = tr_read<v_rd_off(D0, 2, 0)>(vb), h2 = tr_read<v_rd_off(D0, 2, 1)>(vb), l3 = tr_read<v_rd_off(D0, 3, 0)>(vb), h3 = tr_read<v_rd_off(D0, 3, 1)>(vb);
    asm volatile("s_waitcnt lgkmcnt(0)" ::: "memory"); SBAR();
#define PKV(L, H) (bf16x8){L[0], L[1], L[2], L[3], H[0], H[1], H[2], H[3]}
    od = __builtin_amdgcn_mfma_f32_32x32x16_bf16(pa0, PKV(l0, h0), od, 0, 0, 0);
    od = __builtin_amdgcn_mfma_f32_32x32x16_bf16(pa1, PKV(l1, h1), od, 0, 0, 0);
    od = __builtin_amdgcn_mfma_f32_32x32x16_bf16(pa2, PKV(l2, h2), od, 0, 0, 0);
    od = __builtin_amdgcn_mfma_f32_32x32x16_bf16(pa3, PKV(l3, h3), od, 0, 0, 0);
#undef PKV
}
__device__ __forceinline__ void pv_d0(f32x16* o, int vb, bf16x8 pa0, bf16x8 pa1, bf16x8 pa2, bf16x8 pa3) {
    pv_one<0>(o[0], vb, pa0, pa1, pa2, pa3); pv_one<1>(o[1], vb, pa0, pa1, pa2, pa3); pv_one<2>(o[2], vb, pa0, pa1, pa2, pa3); pv_one<3>(o[3], vb, pa0, pa1, pa2, pa3);
}
__device__ __forceinline__ void pack_p(const f32x16& p0, const f32x16& p1, bf16x8& pa0, bf16x8& pa1, bf16x8& pa2, bf16x8& pa3) {
#define PK4(P, BASE, OUT) do { unsigned a0 = cvtpk(P[BASE + 0], P[BASE + 1]), a1 = cvtpk(P[BASE + 2], P[BASE + 3]);   \
    unsigned b0 = cvtpk(P[BASE + 4], P[BASE + 5]), b1 = cvtpk(P[BASE + 6], P[BASE + 7]);                              \
    auto r0 = __builtin_amdgcn_permlane32_swap(a0, b0, false, false); auto r1 = __builtin_amdgcn_permlane32_swap(a1, b1, false, false); \
    u32x4 w = {r0[0], r1[0], r0[1], r1[1]}; OUT = *reinterpret_cast<bf16x8*>(&w); } while (0)
    PK4(p0, 0, pa0); PK4(p0, 8, pa1); PK4(p1, 0, pa2); PK4(p1, 8, pa3);
#undef PK4
}
__device__ __forceinline__ float xhalf_max(float v) { auto rr = __builtin_amdgcn_permlane32_swap(__float_as_uint(v), __float_as_uint(v), false, false); return fmaxf(__uint_as_float(rr[0]), __uint_as_float(rr[1])); }
__device__ __forceinline__ float xhalf_sum(float v) { auto rr = __builtin_amdgcn_permlane32_swap(__float_as_uint(v), __float_as_uint(v), false, false); return __uint_as_float(rr[0]) + __uint_as_float(rr[1]); }
__device__ __forceinline__ float xhalf_other(float v) { return __shfl_xor(v, 32); }
__device__ __forceinline__ void mask_range(f32x16& p0, f32x16& p1, int lo, int hb, int hi) {
#pragma unroll
    for (int r = 0; r < 16; ++r) { const int k0 = crow(r, hi), k1 = 32 + k0;
        p0[r] = (k0 >= lo && k0 <= hb) ? p0[r] : -1e30f; p1[r] = (k1 >= lo && k1 <= hb) ? p1[r] : -1e30f; }
}
__device__ __forceinline__ float sm_step(f32x16& p0, f32x16& p1, float& m_reg) {
    float pmax = p0[0];
#pragma unroll
    for (int r = 1; r < 16; ++r) pmax = fmaxf(pmax, p0[r]);
#pragma unroll
    for (int r = 0; r < 16; ++r) pmax = fmaxf(pmax, p1[r]);
    pmax = xhalf_max(pmax);
    float alpha = 1.f;
    if (!__all(pmax - m_reg <= THR_RAW)) { const float mn = fmaxf(m_reg, pmax); alpha = __builtin_amdgcn_exp2f((m_reg - mn) * SM_C); m_reg = mn; }
    const float mnC = -m_reg * SM_C;
#pragma unroll
    for (int r = 0; r < 16; ++r) { p0[r] = __builtin_amdgcn_exp2f(fmaf(p0[r], SM_C, mnC)); p1[r] = __builtin_amdgcn_exp2f(fmaf(p1[r], SM_C, mnC)); }
    return alpha;
}
__device__ __forceinline__ float row_sum32(const f32x16& p0, const f32x16& p1) {
    float ps = 0.f;
#pragma unroll
    for (int r = 0; r < 16; ++r) ps += p0[r];
#pragma unroll
    for (int r = 0; r < 16; ++r) ps += p1[r];
    return xhalf_sum(ps);
}

constexpr int NL_K = 0, NL_V = 32768, NL_WS = 131072, NL_SLAB = 65536, NL_SC = NL_SLAB + 32768, NL_SMASK = NL_SC + 8192;

__device__ __forceinline__ void stage_glds(const bf16_t* Kp, const bf16_t* Vp, int ld, unsigned char* Kb, unsigned char* Vb, int wid, int lane) {
#pragma unroll
    for (int i = 0; i < 2; ++i) { const int piece = wid * 2 + i;
        { const int R = piece * 4 + (lane >> 4), cs = (lane & 15) ^ (R & 7);
          __builtin_amdgcn_global_load_lds((const unsigned*)(Kp + (size_t)R * ld + cs * 8), (LAS unsigned*)(Kb + piece * 1024), 16, 0, 0); }
        { const int sub = piece * 2 + (lane >> 5), kk = (sub >> 2) * 8 + ((lane & 31) >> 2), k = (kk & ~0xC) | ((kk & 4) << 1) | ((kk & 8) >> 1), cc = (sub & 3) * 32 + 8 * (lane & 3);
          __builtin_amdgcn_global_load_lds((const unsigned*)(Vp + (size_t)k * ld + cc), (LAS unsigned*)(Vb + piece * 1024), 16, 0, 0); } }
}

__device__ __forceinline__ void nsa_task(const Args& a, unsigned char* lds, int b, int g, int c, bf16_t* dst) {
    unsigned char* ws = a.ws; const bf16_t* P = (const bf16_t*)(ws + WS_P);
    const bf16_t* KCb = (const bf16_t*)(ws + WS_KCB) + (size_t)(b * 2 + g) * 128 * 128; const bf16_t* VCb = (const bf16_t*)(ws + WS_VCB) + (size_t)(b * 2 + g) * 128 * 128;
    const float* gates = (const float*)(ws + WS_GATES);
    int tid = threadIdx.x; asm volatile("" : "+v"(tid));
    const int wid = __builtin_amdgcn_readfirstlane(tid >> 6), lane = tid & 63, r32 = lane & 31, hi = lane >> 5;
    const int hh = wid & 3, th = wid >> 2, itok = 32 * th + r32, t = 64 * c + itok;
    const size_t tok0 = (size_t)b * SEQ + 64 * c;
    float* wsc = (float*)(lds + NL_WS) + wid * 64;
    float* slab = (float*)(lds + NL_SLAB); float* scl = (float*)(lds + NL_SC); unsigned* smask = (unsigned*)(lds + NL_SMASK);
    const int vb0 = (int)(uintptr_t)(lds + NL_V) + v_rd_base(lane);
    bf16x8 qr[8];
#define LOAD_Q() do { const bf16_t* Qw = P + (tok0 + itok) * PW + PC_Q + (g * 4 + hh) * 128 + hi * 8; \
      _Pragma("unroll") for (int d0 = 0; d0 < 8; ++d0) qr[d0] = *(const bf16x8*)(Qw + d0 * 16); } while (0)
    LOAD_Q();
    const float* gp = gates + (tok0 + itok) * 24 + g * 12 + hh * 3;
    f32x16 o[4];
#pragma unroll
    for (int d = 0; d < 4; ++d) o[d] = f32x16{};
    f32x4* fsc = (f32x4*)((float*)(ws + WS_FIN) + (size_t)blockIdx.x * 32768 + wid * 4096 + lane * 4);
    bf16x8 pa0, pa1, pa2, pa3;
    __syncthreads();
#ifndef NO_CMP
    {
        const int ntc = (4 * c + 2 >= 64) ? 2 : 1;
        stage_glds(KCb, VCb, 128, lds + NL_K, lds + NL_V, wid, lane);
        if (ntc == 2) stage_glds(KCb + 64 * 128, VCb + 64 * 128, 128, lds + NL_K + 16384, lds + NL_V + 16384, wid, lane);
        asm volatile("s_waitcnt vmcnt(0)" ::: "memory"); __syncthreads();
        const int nvc = t >= 31 ? min(NCMP, (t - 31) / 16 + 1) : 0;
        float m_c = M_INIT, l_c = 0.f, prevL = 0.f, alphaB = 1.f;
        float* sl = slab + ((size_t)(wid * 32 + r32)) * 32 + hi;
#define IMP_GROUP(PH, q, u) do { const float G_ = (PH[4 * (q)] + PH[4 * (q) + 1]) + (PH[4 * (q) + 2] + PH[4 * (q) + 3]); const float Lp_ = xhalf_other(PH[4 * (q) + 3]); \
            sl[2 * (u)] = G_ + (hi ? Lp_ : prevL); prevL = Lp_; } while (0)
#define CMP_TILE(TT) do { f32x16 p0, p1; qkt(p0, p1, lds + NL_K + (TT) * 16384, qr, r32, hi, 0.f, true, 0, nvc - 1 - 64 * (TT)); \
            float pmax = p0[0]; _Pragma("unroll") for (int r = 1; r < 16; ++r) pmax = fmaxf(pmax, p0[r]); _Pragma("unroll") for (int r = 0; r < 16; ++r) pmax = fmaxf(pmax, p1[r]); \
            pmax = xhalf_max(pmax); const float mn = fmaxf(m_c, pmax); const float alpha = __builtin_amdgcn_exp2f((m_c - mn) * SM_C); m_c = mn; const float mnC = -mn * SM_C; \
            _Pragma("unroll") for (int r = 0; r < 16; ++r) { p0[r] = __builtin_amdgcn_exp2f(fmaf(p0[r], SM_C, mnC)); p1[r] = __builtin_amdgcn_exp2f(fmaf(p1[r], SM_C, mnC)); } \
            l_c = l_c * alpha + row_sum32(p0, p1); \
            if ((TT) == 1) { alphaB = alpha; prevL *= alpha; if (hi == 0) wsc[32 + r32] = alpha; asm volatile("s_waitcnt lgkmcnt(0)" ::: "memory"); \
                _Pragma("unroll") for (int r = 0; r < 16; ++r) { const float al = wsc[32 + crow(r, hi)]; _Pragma("unroll") for (int d = 0; d < 4; ++d) o[d][r] *= al; } } \
            IMP_GROUP(p0, 0, 8 * (TT) + 0); IMP_GROUP(p0, 1, 8 * (TT) + 1); IMP_GROUP(p0, 2, 8 * (TT) + 2); IMP_GROUP(p0, 3, 8 * (TT) + 3); \
            IMP_GROUP(p1, 0, 8 * (TT) + 4); IMP_GROUP(p1, 1, 8 * (TT) + 5); IMP_GROUP(p1, 2, 8 * (TT) + 6); IMP_GROUP(p1, 3, 8 * (TT) + 7); \
            pack_p(p0, p1, pa0, pa1, pa2, pa3); pv_d0(o, vb0 + (TT) * 16384, pa0, pa1, pa2, pa3); } while (0)
        CMP_TILE(0);
        if (ntc == 2) CMP_TILE(1);
#undef CMP_TILE
#undef IMP_GROUP
        const float inv = l_c > 0.f ? 1.f / l_c : 0.f;
        { const float fa = inv * alphaB;
#pragma unroll
          for (int u = 0; u < 8; ++u) sl[2 * u] *= fa;
          if (ntc == 2) {
#pragma unroll
              for (int u = 8; u < 16; ++u) sl[2 * u] *= inv; }
          else {
#pragma unroll
              for (int u = 8; u < 16; ++u) sl[2 * u] = 0.f; } }
#ifndef ALPHA_CMP
#define ALPHA_CMP 1.f
#endif
#ifndef ALPHA_SLC
#define ALPHA_SLC 1.f
#endif
#ifndef ALPHA_WIN
#define ALPHA_WIN 1.f
#endif
        const float gcoef = sigmoid_f(gp[0]) * inv * ALPHA_CMP;
        if (hi == 0) wsc[r32] = gcoef;
        asm volatile("s_waitcnt lgkmcnt(0)" ::: "memory");
        { float cf[16];
#pragma unroll
          for (int r = 0; r < 16; ++r) cf[r] = wsc[crow(r, hi)];
#pragma unroll
          for (int d = 0; d < 4; ++d)
#pragma unroll
              for (int q = 0; q < 4; ++q) { f32x4 v; v[0] = o[d][4 * q] * cf[4 * q]; v[1] = o[d][4 * q + 1] * cf[4 * q + 1]; v[2] = o[d][4 * q + 2] * cf[4 * q + 2]; v[3] = o[d][4 * q + 3] * cf[4 * q + 3]; fsc[(d * 4 + q) * 64] = v; } }
    }
#endif
    __syncthreads();
#ifndef NO_SEL
    {
        const int token = tid >> 3, sub = tid & 7, tth = token >> 5, tr = token & 31;
        f32x4 sum = {0.f, 0.f, 0.f, 0.f};
#pragma unroll
        for (int h4 = 0; h4 < 4; ++h4) sum = sum + *(const f32x4*)(slab + ((size_t)((tth * 4 + h4) * 32 + tr)) * 32 + 4 * sub);
        *(f32x4*)(scl + token * 32 + 4 * sub) = sum;
        __syncthreads();
        const int nf = c == 0 ? 1 : (c == 1 ? 2 : 3), need = NSEL - nf;
        const f32x4 mine = *(const f32x4*)(scl + token * 32 + 4 * sub);
        int rk0 = 0, rk1 = 0, rk2 = 0, rk3 = 0; const int jb = 4 * sub;
#pragma unroll 1
        for (int jj = 1; jj < c - 1; ++jj) {
            const float v = scl[token * 32 + jj];
            rk0 += (v > mine[0] || (v == mine[0] && jj < jb)) ? 1 : 0;     rk1 += (v > mine[1] || (v == mine[1] && jj < jb + 1)) ? 1 : 0;
            rk2 += (v > mine[2] || (v == mine[2] && jj < jb + 2)) ? 1 : 0; rk3 += (v > mine[3] || (v == mine[3] && jj < jb + 3)) ? 1 : 0; }
        unsigned bits = 0u;
#define SEL_BIT(q, rk) do { const int j = jb + (q); const bool valid = j <= c, forced = (j == 0) || (j == c) || (j == c - 1); bits |= (valid && (forced || (rk) < need)) ? (1u << j) : 0u; } while (0)
        SEL_BIT(0, rk0); SEL_BIT(1, rk1); SEL_BIT(2, rk2); SEL_BIT(3, rk3);
#undef SEL_BIT
        bits |= __shfl_xor(bits, 1); bits |= __shfl_xor(bits, 2); bits |= __shfl_xor(bits, 4);
        if (sub == 0) { smask[token] = bits; ((unsigned*)(a.ws + WS_SELMASK2))[(tok0 + token) * 2 + g] = bits; }
    }
#endif
    __syncthreads();
    const unsigned mymask = smask[itok];
    LOAD_Q();
#undef LOAD_Q
#ifndef NO_LOOP
    {
        const int nw = min(c + 1, 9);
        const bf16_t* Pb = P + (size_t)b * SEQ * PW;
#pragma unroll 1
        for (int seg = 0; seg < 2; ++seg) {
            const int nts = seg ? nw : c + 1, j0 = seg ? c - nw + 1 : 0;
            const bf16_t* Kb = Pb + (seg ? PC_KWIN : PC_KSLC) + g * 128; const bf16_t* Vb = Pb + (seg ? PC_VWIN : PC_VSLC) + g * 128;
            float m_reg = M_INIT, l_reg = 0.f;
#pragma unroll
            for (int d = 0; d < 4; ++d) o[d] = f32x16{};
            const int nsteps = (nts + 1) >> 1;
#define NSA_STAGE2(st_, sb_) do { const int ja_ = j0 + 2 * (st_); \
                stage_glds(Kb + (size_t)(64 * ja_) * PW, Vb + (size_t)(64 * ja_) * PW, PW, lds + (sb_) * 65536, lds + (sb_) * 65536 + 32768, wid, lane); \
                if (2 * (st_) + 1 < nts) stage_glds(Kb + (size_t)(64 * (ja_ + 1)) * PW, Vb + (size_t)(64 * (ja_ + 1)) * PW, PW, lds + (sb_) * 65536 + 16384, lds + (sb_) * 65536 + 49152, wid, lane); } while (0)
            NSA_STAGE2(0, 0);
            asm volatile("s_waitcnt vmcnt(0)" ::: "memory"); __syncthreads();
#pragma unroll 1
            for (int st = 0; st < nsteps; ++st) {
                const int sb = st & 1;
                if (st + 1 < nsteps) NSA_STAGE2(st + 1, sb ^ 1);
#pragma unroll 1
                for (int tt = 0; tt < 2; ++tt) {
                    const int it = 2 * st + tt, j = j0 + it;
                    if (it < nts) {
                        f32x16 p0, p1;
                        { const bool sel = seg ? true : (((mymask >> j) & 1u) != 0u);
                          const bool ranged = (j == c) || (seg && j == c - 8);
                          const int lo = (seg && j == c - 8) ? itok + 1 : 0, hb = (j == c) ? itok : 63;
                          qkt(p0, p1, lds + sb * 65536 + tt * 16384, qr, r32, hi, sel ? 0.f : -1e30f, ranged, lo, hb); }
                        const float alpha = sm_step(p0, p1, m_reg);
                        if (__any(alpha < 1.f)) { if (hi == 0) wsc[32 + r32] = alpha; asm volatile("s_waitcnt lgkmcnt(0)" ::: "memory");
#pragma unroll
                            for (int r = 0; r < 16; ++r) { const float al = wsc[32 + crow(r, hi)];
#pragma unroll
                                for (int d = 0; d < 4; ++d) o[d][r] *= al; } }
                        l_reg = l_reg * alpha + row_sum32(p0, p1);
                        pack_p(p0, p1, pa0, pa1, pa2, pa3);
                        pv_d0(o, vb0 + sb * 65536 + tt * 16384, pa0, pa1, pa2, pa3);
                    }
                }
                asm volatile("s_waitcnt vmcnt(0)" ::: "memory"); __syncthreads();
            }
#undef NSA_STAGE2
            const float cfm = (l_reg > 0.f ? 1.f / l_reg : 0.f) * sigmoid_f(gp[1 + seg]) * (seg ? ALPHA_WIN : ALPHA_SLC);
            if (hi == 0) wsc[r32] = cfm;
            asm volatile("s_waitcnt lgkmcnt(0)" ::: "memory");
            float cf[16];
#pragma unroll
            for (int r = 0; r < 16; ++r) cf[r] = wsc[crow(r, hi)];
            if (seg == 0) {
#pragma unroll
                for (int d = 0; d < 4; ++d)
#pragma unroll
                    for (int q = 0; q < 4; ++q) { f32x4 v = fsc[(d * 4 + q) * 64]; v[0] += o[d][4 * q] * cf[4 * q]; v[1] += o[d][4 * q + 1] * cf[4 * q + 1]; v[2] += o[d][4 * q + 2] * cf[4 * q + 2]; v[3] += o[d][4 * q + 3] * cf[4 * q + 3]; fsc[(d * 4 + q) * 64] = v; }
            } else {
                unsigned char* ost = lds + wid * 8192;
#pragma unroll
                for (int d = 0; d < 4; ++d)
#pragma unroll
                    for (int q = 0; q < 4; ++q) { const f32x4 v = fsc[(d * 4 + q) * 64];
#pragma unroll
                        for (int jj = 0; jj < 4; ++jj) { const int r = 4 * q + jj; *(bf16_t*)(ost + crow(r, hi) * 256 + (d * 32 + r32) * 2) = f2bf(v[jj] + o[d][r] * cf[r]); } }
                asm volatile("s_waitcnt lgkmcnt(0)" ::: "memory");
                unsigned char* gdst = (unsigned char*)(dst + (tok0 + 32 * th + (lane >> 4)) * DM + (g * 4 + hh) * 128) + (lane & 15) * 16;
#pragma unroll 1
                for (int i = 0; i < 8; ++i) { *(u32x4*)gdst = *(const u32x4*)(ost + (i * 4 + (lane >> 4)) * 256 + (lane & 15) * 16); gdst += 4 * DM * 2; }
            }
        }
    }
#endif
}

__device__ __forceinline__ void nsa_phase(const Args& a, unsigned char* lds, bf16_t* dst) {
    const int G = gridDim.x, k = blockIdx.x;
    for (int i = 0;; ++i) {
        if (i * G >= 512) break;
        const int s = (i & 1) ? (i + 1) * G - 1 - k : i * G + k;
        if (s >= 512) continue;
        const int c = 31 - (s >> 4), bg = s & 15;
        nsa_task(a, lds, bg >> 1, bg & 1, c, dst);
    }
}

constexpr int OTS = 132;
constexpr int RL_KROW = 0, RL_KTR = 32768, RL_VTR = 65536, RL_RT = 98304, RL_O = 0;

__device__ __forceinline__ void ret_stage(const bf16_t* Kp, const bf16_t* Vp, unsigned char* lds, int wid, int lane) {
#pragma unroll
    for (int i = 0; i < 4; ++i) { const int piece = wid * 4 + i;
        { const int R = piece * 4 + (lane >> 4), cs = (lane & 15) ^ (R & 7);
          __builtin_amdgcn_global_load_lds((const unsigned*)(Kp + (size_t)R * PW + cs * 8), (LAS unsigned*)(lds + RL_KROW + piece * 1024), 16, 0, 0); }
        { const int tile = piece >> 4, pc = piece & 15, sub = pc * 2 + (lane >> 5), kk = (sub >> 2) * 8 + ((lane & 31) >> 2), k = (kk & ~0xC) | ((kk & 4) << 1) | ((kk & 8) >> 1), cc = (sub & 3) * 32 + 8 * (lane & 3);
          const size_t so = (size_t)(tile * 64 + k) * PW + cc;
          __builtin_amdgcn_global_load_lds((const unsigned*)(Kp + so), (LAS unsigned*)(lds + RL_KTR + piece * 1024), 16, 0, 0);
          __builtin_amdgcn_global_load_lds((const unsigned*)(Vp + so), (LAS unsigned*)(lds + RL_VTR + piece * 1024), 16, 0, 0); } }
}
template <int KS> __device__ __forceinline__ void ret_state_step(f32x16& acc, int kb, int vb) {
    constexpr int OFF = (KS >> 2) * 16384 + (KS & 3) * 4096;
    const s16x4 al = tr_read<OFF>(kb), ah = tr_read<OFF + 2048>(kb), bl = tr_read<OFF>(vb), bh = tr_read<OFF + 2048>(vb);
    asm volatile("s_waitcnt lgkmcnt(0)" ::: "memory"); SBAR();
    acc = __builtin_amdgcn_mfma_f32_32x32x16_bf16((bf16x8){al[0], al[1], al[2], al[3], ah[0], ah[1], ah[2], ah[3]}, (bf16x8){bl[0], bl[1], bl[2], bl[3], bh[0], bh[1], bh[2], bh[3]}, acc, 0, 0, 0);
}
__device__ __forceinline__ void ret_state_tile(f32x16& acc, int kb, int vb) {
    ret_state_step<0>(acc, kb, vb); ret_state_step<1>(acc, kb, vb); ret_state_step<2>(acc, kb, vb); ret_state_step<3>(acc, kb, vb);
    ret_state_step<4>(acc, kb, vb); ret_state_step<5>(acc, kb, vb); ret_state_step<6>(acc, kb, vb); ret_state_step<7>(acc, kb, vb);
}

__device__ __forceinline__ void ret_task(const Args& a, unsigned char* lds, int b, int h, int half, bf16_t* dst) {
    unsigned char* ws = a.ws; const bf16_t* P = (const bf16_t*)(ws + WS_P) + (size_t)b * SEQ * PW;
    const float* gng = a.in[I_GNG] + h * 128; const float* gnb = a.in[I_GNB] + h * 128;
    int tid = threadIdx.x; asm volatile("" : "+v"(tid));
    const int wid = __builtin_amdgcn_readfirstlane(tid >> 6), lane = tid & 63, r32 = lane & 31, hi = lane >> 5;
    const int nb = wid & 3, mh = wid >> 2;
    const float gam = 1.f - exp2f(-5.f - (float)h), lgam = log2f(gam), g127 = exp2f(127.f * lgam);
    const int vbase = v_rd_base(lane);
    f32x16 Racc[2];
    Racc[0] = f32x16{}; Racc[1] = f32x16{};
    __syncthreads();
    for (int i = tid; i < 32768 / 16; i += NTHREADS) *(u32x4*)(lds + RL_RT + i * 16) = (u32x4){0u, 0u, 0u, 0u};
    for (int ch = 0; ch < (half ? SEQ / 128 : SEQ / 256); ++ch) {
        const bool full = !half || ch >= SEQ / 256;
        const bf16_t* Pc = P + (size_t)(ch * 128) * PW;
        __syncthreads();
        ret_stage(Pc + PC_RK + h * 128, Pc + PC_RV + h * 128, lds, wid, lane);
        bf16x8 qr[8];
        if (full) { const bf16_t* Qw = Pc + (size_t)(nb * 32 + r32) * PW + PC_RQ + h * 128 + hi * 8;
#pragma unroll
          for (int d0 = 0; d0 < 8; ++d0) qr[d0] = *(const bf16x8*)(Qw + d0 * 16); }
        else {
#pragma unroll
          for (int d0 = 0; d0 < 8; ++d0) qr[d0] = bf16x8{}; }
        asm volatile("s_waitcnt vmcnt(0)" ::: "memory"); __syncthreads();
        f32x16 o[4];
#pragma unroll
        for (int d = 0; d < 4; ++d) o[d] = f32x16{};
        if (full) {
        { bf16x8 qh[4];
#pragma unroll
          for (int k4 = 0; k4 < 4; ++k4) qh[k4] = mh ? qr[4 + k4] : qr[k4];
#pragma unroll
          for (int d0 = 0; d0 < 4; ++d0)
#pragma unroll
              for (int k4 = 0; k4 < 4; ++k4) { const int cb = ((4 * mh + k4) * 16 + hi * 8) * 2;
                  const bf16x8 bfr = *reinterpret_cast<const bf16x8*>(lds + RL_RT + KSWZ(32 * d0 + r32, cb));
                  o[d0] = __builtin_amdgcn_mfma_f32_32x32x16_bf16(qh[k4], bfr, o[d0], 0, 0, 0); } }
#pragma unroll
        for (int d = 0; d < 4; ++d)
#pragma unroll
            for (int r = 0; r < 16; ++r) o[d][r] *= gam;
        if (2 * mh <= nb) {
            f32x16 p0 = f32x16{}, p1 = f32x16{};
            const bool two = (2 * mh + 1 <= nb);
#pragma unroll
            for (int d0 = 0; d0 < 8; ++d0) { const int cb = (d0 * 16 + hi * 8) * 2;
                const bf16x8 k0 = *reinterpret_cast<const bf16x8*>(lds + RL_KROW + KSWZ(64 * mh + r32, cb));
                p0 = __builtin_amdgcn_mfma_f32_32x32x16_bf16(k0, qr[d0], p0, 0, 0, 0);
                if (two) { const bf16x8 k1 = *reinterpret_cast<const bf16x8*>(lds + RL_KROW + KSWZ(64 * mh + 32 + r32, cb));
                    p1 = __builtin_amdgcn_mfma_f32_32x32x16_bf16(k1, qr[d0], p1, 0, 0, 0); } }
            if (2 * mh == nb) {
#pragma unroll
                for (int r = 0; r < 16; ++r) { const unsigned keep = ~(unsigned)((r32 - crow(r, hi)) >> 31); p0[r] = __uint_as_float(__float_as_uint(p0[r]) & keep); } }
            if (2 * mh + 1 == nb) {
#pragma unroll
                for (int r = 0; r < 16; ++r) { const unsigned keep = ~(unsigned)((r32 - crow(r, hi)) >> 31); p1[r] = __uint_as_float(__float_as_uint(p1[r]) & keep); } }
            bf16x8 pa0, pa1, pa2, pa3;
            pack_p(p0, p1, pa0, pa1, pa2, pa3);
            pv_d0(o, (int)(uintptr_t)(lds + RL_VTR + mh * 16384) + vbase, pa0, pa1, pa2, pa3);
        }
        }
        { const int dt = wid & 3, et0 = 2 * (wid >> 2);
#pragma unroll
          for (int r = 0; r < 16; ++r) { Racc[0][r] *= gam; Racc[1][r] *= gam; }
          const int kb = (int)(uintptr_t)(lds + RL_KTR) + vbase + dt * 512;
          ret_state_tile(Racc[0], kb, (int)(uintptr_t)(lds + RL_VTR) + vbase + et0 * 512);
          ret_state_tile(Racc[1], kb, (int)(uintptr_t)(lds + RL_VTR) + vbase + (et0 + 1) * 512);
#pragma unroll
          for (int r = 0; r < 16; ++r) { Racc[0][r] *= g127; Racc[1][r] *= g127; } }
        __syncthreads();
        { const int dt = wid & 3, et0 = 2 * (wid >> 2);
#pragma unroll
          for (int t2 = 0; t2 < 2; ++t2)
#pragma unroll
              for (int q = 0; q < 4; ++q) { u32x2 w; w.x = cvtpk(Racc[t2][4 * q], Racc[t2][4 * q + 1]); w.y = cvtpk(Racc[t2][4 * q + 2], Racc[t2][4 * q + 3]);
                  *(u32x2*)(lds + RL_RT + KSWZ(32 * (et0 + t2) + r32, (32 * dt + 8 * q + 4 * hi) * 2)) = w; } }
        if (!full) continue;
        float* Ot = (float*)(lds + RL_O);
        if (mh == 0) {
#pragma unroll
            for (int d = 0; d < 4; ++d)
#pragma unroll
                for (int r = 0; r < 16; ++r) Ot[(32 * nb + crow(r, hi)) * OTS + 32 * d + r32] = o[d][r]; }
        __syncthreads();
        if (mh == 1) {
#pragma unroll
            for (int d = 0; d < 4; ++d)
#pragma unroll
                for (int r = 0; r < 16; ++r) Ot[(32 * nb + crow(r, hi)) * OTS + 32 * d + r32] += o[d][r]; }
        __syncthreads();
        { const int row = tid >> 2, sub = tid & 3; const size_t tok = (size_t)b * SEQ + ch * 128 + row;
          f32x4 v[8]; float s1 = 0.f;
#pragma unroll
          for (int i = 0; i < 8; ++i) { v[i] = *(const f32x4*)(Ot + row * OTS + sub * 32 + i * 4); s1 += (v[i][0] + v[i][1]) + (v[i][2] + v[i][3]); }
          s1 += __shfl_xor(s1, 1); s1 += __shfl_xor(s1, 2);
          const float mu = s1 * (1.f / 128.f); float s2 = 0.f;
#pragma unroll
          for (int i = 0; i < 8; ++i) { v[i] = v[i] - mu; s2 += (v[i][0] * v[i][0] + v[i][1] * v[i][1]) + (v[i][2] * v[i][2] + v[i][3] * v[i][3]); }
          s2 += __shfl_xor(s2, 1); s2 += __shfl_xor(s2, 2);
          const float rstd = rsqrtf(s2 * (1.f / 128.f) + GN_EPS);
          const bf16_t* gr = (const bf16_t*)(ws + WS_P) + tok * PW + PC_RG + h * 128 + sub * 32;
          bf16_t* op = dst + tok * DM + 1024 + h * 128 + sub * 32;
#pragma unroll
          for (int i8 = 0; i8 < 4; ++i8) { const u32x4 gw = *(const u32x4*)(gr + i8 * 8); float y[8];
#pragma unroll
              for (int j = 0; j < 8; ++j) { const int e = sub * 32 + i8 * 8 + j; const unsigned wv = j < 2 ? gw.x : (j < 4 ? gw.y : (j < 6 ? gw.z : gw.w));
                  const float gt = (j & 1) ? __uint_as_float(wv & 0xffff0000u) : __uint_as_float(wv << 16);
                  y[j] = silu_f(gt) * (v[i8 * 2 + (j >> 2)][j & 3] * rstd * gng[e] + gnb[e]); }
              u32x4 w; w.x = pk2(y[0], y[1]); w.y = pk2(y[2], y[3]); w.z = pk2(y[4], y[5]); w.w = pk2(y[6], y[7]);
              *(u32x4*)(op + i8 * 8) = w; } }
    }
}

constexpr int NPHASES = 10;
__device__ __forceinline__ void run_phase(int ph, const Args& a, unsigned char* lds, int rep = 0) {
    unsigned char* ws = a.ws;
    PG8_LAS unsigned char* l3 = (PG8_LAS unsigned char*)lds;
    const int G = gridDim.x, c = blockIdx.x;
    if (ph == 0) { p0_prepass(a, lds); }
    else if (ph == 1) {
        pg8::Gemm g{(const bf16_t*)(ws + WS_XB), (const bf16_t*)(ws + WS_WIN_T), T, NIN_PAD, DM}; pg8::StaticOrder S; S.init(T, NIN_PAD, G, c);
        LAS float* rsT = (LAS float*)(lds + LDS_TAB + 1024); LAS int* slotpm = (LAS int*)(lds + LDS_TAB);
        { const float* rowscale = (const float*)(ws + WS_ROWSCALE); pg8::Unit u;
          __syncthreads();
          for (int i = 0; S.next(i, u) && i < 14; ++i) { if (threadIdx.x == 0) slotpm[u.pm] = i; if (threadIdx.x < 256) rsT[i * 256 + threadIdx.x] = rowscale[u.pm * 256 + threadIdx.x]; }
          __syncthreads(); }
        EpiInProj E{(bf16_t*)(ws + WS_P), (float*)(ws + WS_GATES), rsT, slotpm};
        pg8::gemm_phase<EpiInProj, pg8::StaticOrder, true, false>(l3, g, S, E);
    }
    else if (ph == 2) { p2_finalize(a, lds, rep); }
    else if (ph == 3) {
        bf16_t* att = (bf16_t*)(ws + WS_ATT);
        { unsigned* qctr = (unsigned*)(ws + WS_CNT) + 64 + rep; int* slot = (int*)(lds + LDS_XBAR + 128);
          int idx;
#define Q_FETCH() do { __syncthreads(); if (threadIdx.x == 0) *slot = (int)atomicAdd(qctr, 1u); __syncthreads(); idx = __builtin_amdgcn_readfirstlane(*slot); } while (0)
          for (;;) { Q_FETCH(); if (idx >= 128) break;
              ret_task(a, lds, (idx & 63) >> 3, idx & 7, idx < 64 ? 1 : 0, att); }
#if defined(REP_ONLY) && REP_ONLY == 1
          if (rep) idx = 128 + 512;
#endif
          while (idx < 128 + 512) {
#if defined(REP_ONLY) && REP_ONLY == 2
              if (rep && idx < 128) { Q_FETCH(); continue; }
#endif
              { const int s = idx - 128, cc = 31 - (s >> 4), bg = s & 15; nsa_task(a, lds, bg >> 1, bg & 1, cc, att); }
              Q_FETCH(); }
#undef Q_FETCH
        }
#if defined(DBG_COMPARE) && DBG_COMPARE == 1
        nsa_naive(a, lds, (bf16_t*)(ws + WS_REF), 1024);
#elif defined(DBG_COMPARE) && DBG_COMPARE == 2
        ret_naive(a, lds, (bf16_t*)(ws + WS_REF), 1024, 0);
#endif
    }
    else if (ph == 4) {
#if defined(DBG_COMPARE) && DBG_COMPARE == 1
        dbg_compare(a, (const bf16_t*)(ws + WS_ATT), (const bf16_t*)(ws + WS_REF), 1024, 0, 1024, 0);
#elif defined(DBG_COMPARE) && DBG_COMPARE == 2
        dbg_compare(a, (const bf16_t*)(ws + WS_ATT), (const bf16_t*)(ws + WS_REF), 1024, 1024, 2048, 0);
#endif
        pg8::Gemm g{(const bf16_t*)(ws + WS_ATT), (const bf16_t*)(ws + WS_WOUT_T), T, DM, DM}; pg8::StaticOrder S; S.init(T, DM, G, c);
        EpiOutProj E{a.in[I_X], a.out, (bf16_t*)(ws + WS_H2)};
        pg8::gemm_phase<EpiOutProj, pg8::StaticOrder, true, true>(l3, g, S, E);
    }
    else if (ph == 5) { p7_route(a, lds, rep); }
    else if (ph == 6) { }
    else if (ph == 7) {
        MoeTab tab = moe_tab(lds); const int ntiles = moe_build_tab(tab, (const unsigned*)(ws + WS_ECNT));
        pg8::Gemm g{(const bf16_t*)(ws + WS_H2), (const bf16_t*)(ws + WS_WGU_T), T, NEXP * 1024, DM}; MoeOrder<4> S{G, c, ntiles, tab.tile_e};
        LAS float* rsT = (LAS float*)(lds + LDS_TAB + 4096 + 4096); LAS int* tslot = (LAS int*)(lds + LDS_TAB + 2048);
        EpiGateUp E{(bf16_t*)(ws + WS_HB), rsT, tslot};
        PG8_LAS unsigned* rowtab = (PG8_LAS unsigned*)(l3 + LDS_TAB + 4096);
        { const int* ltok = (const int*)(ws + WS_LTOK); const float* rs2 = (const float*)(ws + WS_RS2); pg8::Unit u;
          for (int i = 0; S.next(i, u) && i < 4; ++i) { const int e = tab.tile_e[u.pm], li0 = tab.tile_i[u.pm] * 256, n = tab.cnt[e];
              if (threadIdx.x == 0) tslot[u.pm] = i;
              for (int r = threadIdx.x; r < 256; r += NTHREADS) { const int li = li0 + r; const int tok = li < n ? (ltok[e * T + li] >> 1) : -1;
                  rowtab[i * 256 + r] = tok >= 0 ? (unsigned)tok * (unsigned)(DM * 2) : 0u; rsT[i * 256 + r] = tok >= 0 ? rs2[tok] : 0.f; } }
          __syncthreads(); }
        pg8::gemm_phase_g<EpiGateUp, MoeOrder<4>>(l3, g, S, E, rowtab);
    }
    else if (ph == 8) {
        MoeTab tab = moe_tab(lds); const int ntiles = moe_build_tab(tab, (const unsigned*)(ws + WS_ECNT));
        pg8::Gemm g{(const bf16_t*)(ws + WS_HB), (const bf16_t*)(ws + WS_WD_T), ntiles * 256, NEXP * DM, DEXP}; MoeOrder<8> S{G, c, ntiles, tab.tile_e};
        LAS int* tokT = (LAS int*)(lds + LDS_TAB + 4096); LAS float* wT = (LAS float*)(lds + LDS_TAB + 4096 + 6144); LAS int* tslot = (LAS int*)(lds + LDS_TAB + 2048);
        { const int* ltok = (const int*)(ws + WS_LTOK); const float* lw = (const float*)(ws + WS_LW); pg8::Unit u;
          for (int i = 0; S.next(i, u) && i < 6; ++i) { const int e = tab.tile_e[u.pm], li0 = tab.tile_i[u.pm] * 256, n = tab.cnt[e];
              if (threadIdx.x == 0) tslot[u.pm] = i;
              for (int r = threadIdx.x; r < 256; r += NTHREADS) { const int li = li0 + r; tokT[i * 256 + r] = li < n ? ltok[e * T + li] : -1; wT[i * 256 + r] = li < n ? lw[e * T + li] : 0.f; } }
          __syncthreads(); }
        EpiDown E{(bf16_t*)(ws + WS_Y), tokT, wT, tslot};
        pg8::gemm_phase<EpiDown, MoeOrder<8>, true, true>(l3, g, S, E);
    }
    else if (ph == 9) { p11_final(a); }
}

template <int PH> __global__ void __launch_bounds__(NTHREADS, 2) mega_one(Args a) {
    extern __shared__ __attribute__((aligned(16))) unsigned char lds[];
    run_phase(PH, a, lds);
}
__global__ void __launch_bounds__(NTHREADS, 2) mega_all(Args a) {
    extern __shared__ __attribute__((aligned(16))) unsigned char lds[];
#ifdef MK_COOP_SYNC0
    cg::grid_group grid = cg::this_grid();
#endif
    volatile LAS unsigned* xst = (volatile LAS unsigned*)(lds + LDS_XBAR);
    if (threadIdx.x == 0) { xst[0] = 0u; xst[1] = 0u; }
    __syncthreads();
#ifdef MK_COOP_SYNC0
    XcdBarrier xbar; xbar.bar = (unsigned*)(a.ws + WS_BAR); xbar.x = 0; xbar.st = xst;
#define MK_SEAM(k) do { if ((k) == 0) { grid.sync(); xbar = xcd_barrier_post((unsigned*)(a.ws + WS_BAR), xst); } else xcd_barrier(xbar); } while (0)
#else
    XcdBarrier xbar = xcd_barrier_post((unsigned*)(a.ws + WS_BAR), xst);
#define MK_SEAM(k) xcd_barrier(xbar)
#endif
#ifdef DBG_TIME_A
#define MK_STAMP(k) if (blockIdx.x == 0 && threadIdx.x == 0) ((unsigned long long*)(a.ws + WS_TS))[(k) + 1] = __builtin_amdgcn_s_memrealtime();
    if (blockIdx.x == 0 && threadIdx.x == 0) ((unsigned long long*)(a.ws + WS_TS))[0] = __builtin_amdgcn_s_memrealtime();
#else
#define MK_STAMP(k)
#endif
#ifdef REP_PHASE
#define MK_PHASE(k) if (a.ph_lo <= (k) && (k) < a.ph_hi) { run_phase((k), a, lds); MK_SEAM(k); if ((k) == REP_PHASE) { run_phase((k), a, lds, 1); MK_SEAM(1); } }
#else
#define MK_PHASE(k) if (a.ph_lo <= (k) && (k) < a.ph_hi) { run_phase((k), a, lds); if ((k) + 1 < a.ph_hi) MK_SEAM(k); MK_STAMP(k) }
#endif
    MK_PHASE(0) MK_PHASE(1) MK_PHASE(2) MK_PHASE(3) MK_PHASE(4) MK_PHASE(5) MK_PHASE(7) MK_PHASE(8) MK_PHASE(9)
#undef MK_PHASE
}
typedef void (*kern_t)(Args);
static kern_t phase_kernels[NPHASES] = { mega_one<0>, mega_one<1>, mega_one<2>, mega_one<3>, mega_one<4>, mega_one<5>, mega_one<6>, mega_one<7>, mega_one<8>, mega_one<9> };

#ifndef MK_MULTI
#define MK_MULTI 0
#endif
extern "C" void kernel_launch(void* const* d_in, const int* in_sizes, int n_in, void* d_out, int out_size, void* d_ws, size_t ws_size, hipStream_t stream) {
    static int grid = 0;
    if (grid == 0) {
        if (n_in != 19 || in_sizes[0] != T * DM || out_size != T * DM || ws_size < WS_END) {
            fprintf(stderr, "kernel_launch: shape mismatch n_in %d in0 %d out %d ws %zu (need %zu)\n", n_in, n_in > 0 ? in_sizes[0] : -1, out_size, ws_size, (size_t)WS_END); grid = -1; return; }
        int dev = 0, cus = 0, per_cu = 0;
        if (hipGetDevice(&dev) != hipSuccess || hipDeviceGetAttribute(&cus, hipDeviceAttributeMultiprocessorCount, dev) != hipSuccess) { grid = -1; return; }
        for (int ph = 0; ph < NPHASES; ++ph)
            if (hipFuncSetAttribute((const void*)phase_kernels[ph], hipFuncAttributeMaxDynamicSharedMemorySize, LDS_BYTES) != hipSuccess) { fprintf(stderr, "kernel_launch: hipFuncSetAttribute failed\n"); grid = -1; return; }
        if (hipFuncSetAttribute((const void*)mega_all, hipFuncAttributeMaxDynamicSharedMemorySize, LDS_BYTES) != hipSuccess) { fprintf(stderr, "kernel_launch: hipFuncSetAttribute(mega_all) failed\n"); grid = -1; return; }
        if (hipOccupancyMaxActiveBlocksPerMultiprocessor(&per_cu, (const void*)mega_all, NTHREADS, LDS_BYTES) != hipSuccess || per_cu < 1) { fprintf(stderr, "kernel_launch: occupancy query failed (%d)\n", per_cu); grid = -1; return; }
        grid = cus * per_cu;
        if (grid > 256) grid = 256;
        fprintf(stderr, "kernel_launch: cus %d per_cu %d grid %d\n", cus, per_cu, grid);
    }
    if (grid < 0) return;
    Args a{};
    for (int i = 0; i < 19; ++i) a.in[i] = (const float*)d_in[i];
    a.out = (float*)d_out; a.ws = (unsigned char*)d_ws;
#if MK_MULTI
    for (int ph = 0; ph < NPHASES; ++ph) {
        a.ph_lo = ph; a.ph_hi = ph + 1;
        hipLaunchKernelGGL(phase_kernels[ph], dim3(grid), dim3(NTHREADS), LDS_BYTES, stream, a);
    }
#else
    a.ph_lo = 0; a.ph_hi = NPHASES;
#ifndef MK_COOP_SYNC0
    if (hipMemsetAsync((char*)d_ws + WS_BAR, 0, XCD_BAR_WORDS * 4, stream) != hipSuccess) { fprintf(stderr, "kernel_launch: memset of the barrier words failed\n"); return; }
#endif
    void* kargs[] = {&a};
#ifdef MK_COOP_SYNC0
    hipError_t e = hipLaunchCooperativeKernel((const void*)mega_all, dim3(grid), dim3(NTHREADS), kargs, LDS_BYTES, stream);
    if (e != hipSuccess) fprintf(stderr, "kernel_launch: cooperative launch failed: %s (grid %d)\n", hipGetErrorString(e), grid);
#else
    (void)kargs;
    hipLaunchKernelGGL(mega_all, dim3(grid), dim3(NTHREADS), LDS_BYTES, stream, a);
#endif
#endif
}
```
